# Optimizing an MI355X kernel written in HIP

```python
import math
import jax, jax.numpy as jnp
from jax import lax
import numpy as np

D_MODEL = 1024
BATCH = 4
SEQ = 4096
DEPTH = 4

N_A_LAYERS = DEPTH // 2
N_B_LAYERS = DEPTH - N_A_LAYERS
CONV_WIDTH = 31
DIFF_HEADS = 8
DIFF_HEAD_DIM = 64
DIFF_V_DIM = 2 * DIFF_HEAD_DIM
ROT_DIM = DIFF_HEAD_DIM // 4
ROPE_THETA = 500000.0
Q_BLOCK = 128
MEM_TOKENS = 256
MEM_HEADS = 4
MEM_HEAD_DIM = D_MODEL // MEM_HEADS
FFN_HIDDEN = -(-(8 * D_MODEL) // (3 * 256)) * 256
RMS_EPS = 1e-6
LN_EPS = 1e-5
SUBLN_EPS = 1e-5

kernel_name = "yoco_conformer_conv_diff_attn_memory_trunk"


def rms_norm(x, g, eps=RMS_EPS):
    xf = x.astype(jnp.float32)
    y = xf * lax.rsqrt(jnp.mean(xf * xf, axis=-1, keepdims=True) + eps)
    return (y * g.astype(jnp.float32)).astype(x.dtype)


def layer_norm(x, g, b, eps=LN_EPS):
    xf = x.astype(jnp.float32)
    mu = jnp.mean(xf, axis=-1, keepdims=True)
    xc = xf - mu
    y = xc * lax.rsqrt(jnp.mean(xc * xc, axis=-1, keepdims=True) + eps)
    return (y * g.astype(jnp.float32) + b.astype(jnp.float32)).astype(x.dtype)


def rope_tables(positions):
    inv_freq = ROPE_THETA ** (-jnp.arange(0, ROT_DIM, 2, dtype=jnp.float32) / ROT_DIM)
    ang = positions.astype(jnp.float32)[..., None] * inv_freq
    return jnp.cos(ang), jnp.sin(ang)


def apply_partial_rope(t, cos, sin):
    half = ROT_DIM // 2
    tf = t.astype(jnp.float32)
    r1 = tf[..., :half]
    r2 = tf[..., half:ROT_DIM]
    c = cos[:, :, None, None, :]
    s = sin[:, :, None, None, :]
    out = jnp.concatenate([r1 * c - r2 * s, r1 * s + r2 * c, tf[..., ROT_DIM:]], axis=-1)
    return out.astype(t.dtype)


def conformer_conv(h, w_pw1, b_pw1, w_dw, b_dw, ln_g, ln_b, w_pw2, b_pw2):
    u = h @ w_pw1 + b_pw1
    a, gate = jnp.split(u, 2, axis=-1)
    u = a * jax.nn.sigmoid(gate)
    u = lax.conv_general_dilated(
        u, w_dw[:, None, :].astype(u.dtype), window_strides=(1,),
        padding=((CONV_WIDTH - 1, 0),),
        dimension_numbers=("NWC", "WIO", "NWC"),
        feature_group_count=D_MODEL) + b_dw
    u = jax.nn.silu(layer_norm(u, ln_g, ln_b))
    return u @ w_pw2 + b_pw2


def shared_kv(x, kv_norm, w_k, w_v, cos, sin):
    B, S, _ = x.shape
    h = rms_norm(x, kv_norm)
    k = apply_partial_rope((h @ w_k).reshape(B, S, DIFF_HEADS, 2, DIFF_HEAD_DIM), cos, sin)
    v = (h @ w_v).reshape(B, S, DIFF_HEADS, DIFF_V_DIM)
    return k, v


def diff_attention(h, k, v, cos, sin, w_q, lq1, lk1, lq2, lk2, subln_g, w_o, lambda_init):
    B, S, _ = h.shape
    q = apply_partial_rope((h @ w_q).reshape(B, S, DIFF_HEADS, 2, DIFF_HEAD_DIM), cos, sin)
    lam = (jnp.exp(jnp.sum(lq1.astype(jnp.float32) * lk1.astype(jnp.float32)))
           - jnp.exp(jnp.sum(lq2.astype(jnp.float32) * lk2.astype(jnp.float32)))
           + lambda_init)
    n_blocks = S // Q_BLOCK
    q_blocks = q.reshape(B, n_blocks, Q_BLOCK, DIFF_HEADS, 2, DIFF_HEAD_DIM).swapaxes(0, 1)
    k_pos = jnp.arange(S)
    scale = DIFF_HEAD_DIM ** -0.5

    def one_block(args):
        blk, qb = args
        q_pos = blk * Q_BLOCK + jnp.arange(Q_BLOCK)
        s = jnp.einsum('bqhcd,bkhcd->bhcqk', qb, k,
                       preferred_element_type=jnp.float32) * scale
        mask = k_pos[None, :] <= q_pos[:, None]
        p = jax.nn.softmax(jnp.where(mask, s, -jnp.inf), axis=-1)
        a = p[:, :, 0] - lam * p[:, :, 1]
        return jnp.einsum('bhqk,bkhe->bqhe', a.astype(v.dtype), v)

    o = lax.map(one_block, (jnp.arange(n_blocks), q_blocks))
    o = o.swapaxes(0, 1).reshape(B, S, DIFF_HEADS, DIFF_V_DIM)
    o = rms_norm(o, subln_g, SUBLN_EPS) * (1.0 - lambda_init)
    return o.reshape(B, S, DIFF_HEADS * DIFF_V_DIM) @ w_o


def memory_cross_attention(h, mem, w_q, w_k, w_v, w_o):
    B, S, _ = h.shape
    M = mem.shape[1]
    q = (h @ w_q).reshape(B, S, MEM_HEADS, MEM_HEAD_DIM)
    k = (mem @ w_k).reshape(B, M, MEM_HEADS, MEM_HEAD_DIM)
    v = (mem @ w_v).reshape(B, M, MEM_HEADS, MEM_HEAD_DIM)
    s = jnp.einsum('bshd,bmhd->bhsm', q, k, preferred_element_type=jnp.float32) * MEM_HEAD_DIM ** -0.5
    p = jax.nn.softmax(s, axis=-1)
    o = jnp.einsum('bhsm,bmhd->bshd', p.astype(v.dtype), v).reshape(B, S, D_MODEL)
    return o @ w_o


def swiglu(h, w_gate, w_up, w_down):
    return (jax.nn.silu(h @ w_gate) * (h @ w_up)) @ w_down


def setup_inputs(seed: int = 0) -> dict:
    key = jax.random.key(seed)
    ks = iter(jax.random.split(key, 40))
    f32 = jnp.float32

    def w(shape, fan_in):
        return jax.random.normal(next(ks), shape, f32) * (fan_in ** -0.5)

    def gain(shape):
        return 1.0 + 0.02 * jax.random.normal(next(ks), shape, f32)

    def small(shape, scale=0.01):
        return scale * jax.random.normal(next(ks), shape, f32)

    D, F, A, Bn = D_MODEL, FFN_HIDDEN, N_A_LAYERS, N_B_LAYERS
    QK = DIFF_HEADS * 2 * DIFF_HEAD_DIM
    VW = DIFF_HEADS * DIFF_V_DIM
    x = jax.random.normal(next(ks), (BATCH, SEQ, D), f32)
    mem = jax.random.normal(next(ks), (BATCH, MEM_TOKENS, D), f32)
    offset = jax.random.randint(next(ks), (BATCH, 1), 0, 1024, dtype=jnp.int32)
    positions = (offset + jnp.arange(SEQ, dtype=jnp.int32)[None, :]).astype(jnp.int32)
    return {
        "x": x, "mem": mem, "positions": positions,
        "norm_mix": gain((DEPTH, D)), "norm_mem": gain((DEPTH, D)),
        "norm_ffn": gain((DEPTH, D)), "norm_final": gain((D,)),
        "conv_w_pw1": w((A, D, 2 * D), D), "conv_b_pw1": small((A, 2 * D)),
        "conv_w_dw": w((A, CONV_WIDTH, D), CONV_WIDTH), "conv_b_dw": small((A, D)),
        "conv_ln_g": gain((A, D)), "conv_ln_b": small((A, D)),
        "conv_w_pw2": w((A, D, D), D), "conv_b_pw2": small((A, D)),
        "kv_norm": gain((D,)), "w_k_shared": w((D, QK), D), "w_v_shared": w((D, VW), D),
        "diff_w_q": w((Bn, D, QK), D),
        "diff_lambda_q1": small((Bn, DIFF_HEAD_DIM), 0.1), "diff_lambda_k1": small((Bn, DIFF_HEAD_DIM), 0.1),
        "diff_lambda_q2": small((Bn, DIFF_HEAD_DIM), 0.1), "diff_lambda_k2": small((Bn, DIFF_HEAD_DIM), 0.1),
        "diff_subln_g": gain((Bn, DIFF_V_DIM)), "diff_w_o": w((Bn, VW, D), VW),
        "mem_w_q": w((DEPTH, D, D), D), "mem_w_k": w((DEPTH, D, D), D),
        "mem_w_v": w((DEPTH, D, D), D), "mem_w_o": w((DEPTH, D, D), D),
        "ffn_w_gate": w((DEPTH, D, F), D), "ffn_w_up": w((DEPTH, D, F), D),
        "ffn_w_down": w((DEPTH, F, D), F),
    }


def reference(x, mem, positions, norm_mix, norm_mem, norm_ffn, norm_final,
              conv_w_pw1, conv_b_pw1, conv_w_dw, conv_b_dw, conv_ln_g, conv_ln_b,
              conv_w_pw2, conv_b_pw2, kv_norm, w_k_shared, w_v_shared,
              diff_w_q, diff_lambda_q1, diff_lambda_k1, diff_lambda_q2, diff_lambda_k2,
              diff_subln_g, diff_w_o, mem_w_q, mem_w_k, mem_w_v, mem_w_o,
              ffn_w_gate, ffn_w_up, ffn_w_down):
    cos, sin = rope_tables(positions)
    k_sh = None
    v_sh = None
    for i in range(DEPTH):
        if i < N_A_LAYERS:
            a = i
            h = rms_norm(x, norm_mix[i])
            x = x + conformer_conv(h, conv_w_pw1[a], conv_b_pw1[a], conv_w_dw[a], conv_b_dw[a],
                                   conv_ln_g[a], conv_ln_b[a], conv_w_pw2[a], conv_b_pw2[a])
        else:
            b = i - N_A_LAYERS
            if b == 0:
                k_sh, v_sh = shared_kv(x, kv_norm, w_k_shared, w_v_shared, cos, sin)
            lambda_init = 0.8 - 0.6 * math.exp(-0.3 * i)
            h = rms_norm(x, norm_mix[i])
            x = x + diff_attention(h, k_sh, v_sh, cos, sin, diff_w_q[b],
                                   diff_lambda_q1[b], diff_lambda_k1[b],
                                   diff_lambda_q2[b], diff_lambda_k2[b],
                                   diff_subln_g[b], diff_w_o[b], lambda_init)
        x = x + memory_cross_attention(rms_norm(x, norm_mem[i]), mem,
                                       mem_w_q[i], mem_w_k[i], mem_w_v[i], mem_w_o[i])
        x = x + swiglu(rms_norm(x, norm_ffn[i]), ffn_w_gate[i], ffn_w_up[i], ffn_w_down[i])
    return rms_norm(x, norm_final)
```

```cpp
#include <hip/hip_runtime.h>
#include <hip/hip_cooperative_groups.h>
#include <hip/hip_bf16.h>
#include <cstdio>
#include <cstdint>
#include <cmath>
namespace cg = cooperative_groups;

#ifndef MK_SPLIT
#define MK_SPLIT 0
#endif

#define LAS __attribute__((address_space(3)))
typedef unsigned short bf16_t;
typedef short bf16x8 __attribute__((ext_vector_type(8)));
typedef float f32x4 __attribute__((ext_vector_type(4)));
typedef float f32x2 __attribute__((ext_vector_type(2)));
typedef unsigned u32x4 __attribute__((ext_vector_type(4)));
typedef unsigned u32x2 __attribute__((ext_vector_type(2)));

constexpr int TR = 16384, DM = 1024, FF = 2816, SEQ = 4096, NBATCH = 4, NMEM = 256;
constexpr float RMS_EPS = 1e-6f, LN_EPS = 1e-5f, SUBLN_EPS = 1e-5f;
constexpr float LOG2E = 1.4426950408889634f;
constexpr float C2 = 0.125f * LOG2E;

constexpr size_t MiB = 1u << 20;
constexpr size_t WS_SS = 0;
constexpr size_t WS_COS = 1 * MiB;
constexpr size_t WS_SIN = 1 * MiB + 512 * 1024;
constexpr size_t WS_MEMB = 2 * MiB;
constexpr size_t WS_W = 4 * MiB;
constexpr size_t WS_WMIX = WS_W;
constexpr size_t WS_WQS = WS_W + 8 * MiB;
constexpr size_t WS_WOT = WS_W + 10 * MiB;
constexpr size_t WS_WGU = WS_W + 12 * MiB;
constexpr size_t WS_WD = WS_W + 24 * MiB;
constexpr size_t WS_BTS = 36 * MiB;
constexpr size_t WS_BTO = 44 * MiB;
constexpr size_t WS_KV = 52 * MiB;
constexpr size_t WS_XB = 68 * MiB;
constexpr size_t WS_R1 = 100 * MiB;
constexpr size_t WS_KSH = 132 * MiB;
constexpr size_t WS_VSH = 164 * MiB;
constexpr size_t WS_HB = 196 * MiB;
constexpr size_t WS_END = 284 * MiB;
static_assert(WS_KSH - WS_R1 == WS_VSH - WS_KSH, "q | k | v buffers equally spaced");

constexpr int LDS_STAGE = 131072, LDS_XCH = 131072, LDS_BYTES = 147456;

__device__ __forceinline__ unsigned cvt_pk_bf16(float lo, float hi) { unsigned r; asm volatile("v_cvt_pk_bf16_f32 %0, %1, %2" : "=v"(r) : "v"(lo), "v"(hi)); return r; }
__device__ __forceinline__ int opaque_tid() { int t = threadIdx.x; asm volatile("" : "+v"(t)); return t; }
__device__ __forceinline__ float bf_lo(unsigned u) { return __uint_as_float(u << 16); }
__device__ __forceinline__ float bf_hi(unsigned u) { return __uint_as_float(u & 0xffff0000u); }
__device__ __forceinline__ float wave_sum(float v) {
#pragma unroll
    for (int o = 1; o < 64; o <<= 1) v += __shfl_xor(v, o);
    return v;
}
__device__ __forceinline__ float fast_sigmoid(float x) { return __builtin_amdgcn_rcpf(1.0f + __builtin_amdgcn_exp2f(-x * LOG2E)); }
__device__ __forceinline__ float row_rs(const float* ss, int row) {
    const f32x4 a = *(const f32x4*)(ss + (size_t)row * 4);
    return rsqrtf(((a[0] + a[1]) + (a[2] + a[3])) * (1.0f / DM) + RMS_EPS);
}

namespace pg8 {
constexpr int BM = 256, BK = 64, HALF = 128, HTB = HALF * BK * 2, NXCD = 8, WGM = 8;
__host__ __device__ __forceinline__ int lds_byte(int r, int c) { const int st = (r >> 4) * 2 + (c >> 5), rr = r & 15, cc = c & 31, ob = rr * 64 + cc * 2; return st * 1024 + (ob ^ (((ob >> 9) & 1) << 5)); }
__host__ __device__ __forceinline__ void stage_rc(int b, int& R, int& C) { const int st = b / 1024, sb = b % 1024, swz = sb ^ (((sb >> 9) & 1) << 5); R = (st >> 1) * 16 + swz / 64; C = (st & 1) * 32 + (swz % 64) / 2; }
__host__ __device__ __forceinline__ int perm32(int rho) { const int n = rho >> 4, i = rho & 15; return 8 * (i >> 2) + 4 * n + (i & 3); }

struct Unit { int pm, pn, z; };
struct Gemm { const bf16_t* A; const bf16_t* Bt; int lda, ldb, K; long a_s1, a_s0, b_s1, b_s0, b_sb; int nz0; };
__device__ __forceinline__ const char* a_ptr(const Gemm& g, const Unit& u) { const int z1 = u.z / g.nz0, z0 = u.z % g.nz0; return (const char*)(g.A + z1 * g.a_s1 + z0 * g.a_s0 + (long)u.pm * BM * g.lda); }
__device__ __forceinline__ const char* b_ptr(const Gemm& g, const Unit& u) { const int z1 = u.z / g.nz0, z0 = u.z % g.nz0; return (const char*)(g.Bt + z1 * g.b_s1 + z0 * g.b_s0 + (long)(u.pm >> 4) * g.b_sb + (long)u.pn * BM * g.ldb); }

struct Order {
    int nM, nN, nz, nwg, G, c;
    __device__ void init(int nM_, int nN_, int nz_, int G_, int c_) { nM = nM_; nN = nN_; nz = nz_; nwg = nM * nN; G = G_; c = c_; }
    __device__ bool next(int i, Unit& u) const {
        const long L = (long)i * G + c; if (L >= (long)nwg * nz) return false;
        if (nz == 1) {
            int wgid = (int)L; { const int q = nwg / NXCD, r = nwg % NXCD, xcd = wgid % NXCD, off = wgid / NXCD; wgid = (xcd < r ? xcd * (q + 1) : r * (q + 1) + (xcd - r) * q) + off; }
            const int nig = WGM * nN, gid = wgid / nig, fm = gid * WGM, gsz = (nM - fm) < WGM ? (nM - fm) : WGM;
            u.pm = fm + ((wgid % nig) % gsz); u.pn = (wgid % nig) / gsz; u.z = 0;
        } else {
            const int l = (int)L; u.z = l / nwg; const int r = l % nwg; u.pm = r / nN; u.pn = r % nN;
        }
        return true;
    }
};

template <class Epi>
__device__ __forceinline__ void gemm_phase(LAS unsigned char* lds, const Gemm g, const Order& S, const Epi& E) {
    const int tid = opaque_tid(), wid = __builtin_amdgcn_readfirstlane(tid >> 6), lane = tid & 63, wr = wid >> 2, wc = wid & 3, fr = lane & 15, fq = lane >> 4;
    const int K = g.K, nt = K / BK;
    unsigned voffA[2], voffB[2];
#pragma unroll
    for (int i = 0; i < 2; ++i) { int R, C; stage_rc(tid * 16 + i * 8192, R, C); const int Rb = (R & ~31) + perm32(R & 31);
        voffA[i] = (unsigned)(R * g.lda + C) * 2u; voffB[i] = (unsigned)(Rb * g.ldb + C) * 2u; }
    const size_t kstep = (size_t)(BK * 2);
    const size_t hstepA = (size_t)HALF * g.lda * 2, hstepB = (size_t)HALF * g.ldb * 2;
    const unsigned ldsw = (unsigned)wid * 1024u;
    const int aoff = lds_byte(wr * 64 + fr, fq * 8), boff = lds_byte(wc * 32 + fr, fq * 8);
#define PG8_SA(b, h) (((b) * 2 + (h)) * HTB)
#define PG8_SB(b, h) ((4 + (b) * 2 + (h)) * HTB)
#define PG8_STAGE(bufoff, gbase, voff) do { _Pragma("unroll") for (int _i = 0; _i < 2; ++_i) \
        __builtin_amdgcn_global_load_lds((const unsigned*)((const char*)(gbase) + (voff)[_i]), (LAS unsigned*)(lds + (bufoff) + ldsw + _i * 8192), 16, 0, 0); } while (0)
#define PG8_LDA(dst, b, h) do { _Pragma("unroll") for (int m = 0; m < 4; ++m) _Pragma("unroll") for (int k = 0; k < 2; ++k) dst[m][k] = *(const LAS bf16x8*)(lds + PG8_SA(b, h) + aoff + m * 2048 + k * 1024); } while (0)
#define PG8_LDB(dst, b, h) do { _Pragma("unroll") for (int n = 0; n < 2; ++n) _Pragma("unroll") for (int k = 0; k < 2; ++k) dst[n][k] = *(const LAS bf16x8*)(lds + PG8_SB(b, h) + boff + n * 2048 + k * 1024); } while (0)
#define PG8_MMA(ai, bj, At, Bt) do { __builtin_amdgcn_s_setprio(1); _Pragma("unroll") for (int m = 0; m < 4; ++m) _Pragma("unroll") for (int n = 0; n < 2; ++n) _Pragma("unroll") for (int k = 0; k < 2; ++k) \
        acc[ai][bj][m][n] = __builtin_amdgcn_mfma_f32_16x16x32_bf16(Bt[n][k], At[m][k], acc[ai][bj][m][n], 0, 0, 0); __builtin_amdgcn_s_setprio(0); } while (0)
#define PG8_WAIT_V(n) asm volatile("s_waitcnt vmcnt(" #n ")" ::: "memory")
#define PG8_WAIT_L(n) asm volatile("s_waitcnt lgkmcnt(" #n ")" ::: "memory")
#define PG8_BAR __builtin_amdgcn_s_barrier()
#define PG8_SCHED __builtin_amdgcn_sched_barrier(0)
    Unit cur, nxt; int ui = 0;
    if (!S.next(0, cur)) return;
    f32x4 acc[2][2][4][2];
#pragma unroll
    for (int a = 0; a < 2; ++a)
#pragma unroll
        for (int b = 0; b < 2; ++b)
#pragma unroll
            for (int m = 0; m < 4; ++m)
#pragma unroll
                for (int n = 0; n < 2; ++n) acc[a][b][m][n] = (f32x4){0.f, 0.f, 0.f, 0.f};
    bf16x8 At[4][2], B0[2][2], B1[2][2];
    const char* cA = a_ptr(g, cur); const char* cB = b_ptr(g, cur);
    PG8_STAGE(PG8_SB(0, 0), cB, voffB); PG8_STAGE(PG8_SB(0, 1), cB + hstepB, voffB); PG8_STAGE(PG8_SA(0, 0), cA, voffA); PG8_STAGE(PG8_SA(0, 1), cA + hstepA, voffA);
    if (wr == 1) PG8_BAR;
    PG8_WAIT_V(2); PG8_BAR;
    PG8_STAGE(PG8_SB(1, 0), cB + kstep, voffB); PG8_STAGE(PG8_SA(1, 0), cA + kstep, voffA); PG8_STAGE(PG8_SB(1, 1), cB + hstepB + kstep, voffB);
    PG8_WAIT_V(6); PG8_BAR;
    for (;;) {
        const bool has_next = S.next(ui + 1, nxt);
        const char* nA = has_next ? a_ptr(g, nxt) : cA; const char* nB = has_next ? b_ptr(g, nxt) : cB;
        for (int t = 0; t < nt; t += 2) {
            const bool last = (t == nt - 2);
            const char* a1 = cA + (size_t)(t + 1) * kstep;
            const char* a2 = last ? nA : cA + (size_t)(t + 2) * kstep; const char* b2 = last ? nB : cB + (size_t)(t + 2) * kstep;
            const char* a3 = a2 + kstep; const char* b3 = b2 + kstep;
            PG8_LDB(B0, 0, 0); PG8_LDB(B1, 0, 1); PG8_SCHED; PG8_LDA(At, 0, 0); PG8_STAGE(PG8_SA(1, 1), a1 + hstepA, voffA);
            PG8_WAIT_V(8); PG8_WAIT_L(0); PG8_BAR; PG8_MMA(0, 0, At, B0); PG8_MMA(0, 1, At, B1); PG8_BAR; PG8_SCHED;
            PG8_LDA(At, 0, 1); PG8_STAGE(PG8_SB(0, 0), b2, voffB); PG8_STAGE(PG8_SB(0, 1), b2 + hstepB, voffB); PG8_STAGE(PG8_SA(0, 0), a2, voffA);
            PG8_WAIT_V(8); PG8_WAIT_L(0); PG8_BAR; PG8_MMA(1, 0, At, B0); PG8_MMA(1, 1, At, B1); PG8_BAR; PG8_SCHED;
            PG8_LDB(B0, 1, 0); PG8_LDB(B1, 1, 1); PG8_SCHED; PG8_LDA(At, 1, 0); PG8_STAGE(PG8_SA(0, 1), a2 + hstepA, voffA);
            PG8_WAIT_V(8); PG8_WAIT_L(0); PG8_BAR; PG8_MMA(0, 0, At, B0); PG8_MMA(0, 1, At, B1); PG8_BAR; PG8_SCHED;
            PG8_LDA(At, 1, 1); PG8_STAGE(PG8_SB(1, 0), b3, voffB); PG8_STAGE(PG8_SB(1, 1), b3 + hstepB, voffB); PG8_STAGE(PG8_SA(1, 0), a3, voffA);
            PG8_WAIT_V(8); PG8_WAIT_L(0); PG8_BAR; PG8_MMA(1, 0, At, B0); PG8_MMA(1, 1, At, B1); PG8_BAR; PG8_SCHED;
        }
        if (wr == 0) PG8_BAR;
        E(acc, cur, wr, wc, fr, fq, lds);
        if (!has_next) break;
#pragma unroll
        for (int a = 0; a < 2; ++a)
#pragma unroll
            for (int b = 0; b < 2; ++b)
#pragma unroll
                for (int m = 0; m < 4; ++m)
#pragma unroll
                    for (int n = 0; n < 2; ++n) acc[a][b][m][n] = (f32x4){0.f, 0.f, 0.f, 0.f};
        cur = nxt; cA = nA; cB = nB; ++ui;
        if (wr == 1) PG8_BAR;
    }
    PG8_WAIT_V(0);
    PG8_BAR;
#undef PG8_SA
#undef PG8_SB
#undef PG8_STAGE
#undef PG8_LDA
#undef PG8_LDB
#undef PG8_MMA
#undef PG8_WAIT_V
#undef PG8_WAIT_L
#undef PG8_BAR
#undef PG8_SCHED
}

typedef f32x4 Acc[2][2][4][2];

struct EpiPlain {
    bf16_t* O; int ldc; long c_s1, c_s0; int nz0;
    __device__ __forceinline__ void operator()(Acc& acc, const Unit& u, int wr, int wc, int fr, int fq, LAS unsigned char*) const {
        const int z1 = u.z / nz0, z0 = u.z % nz0;
        bf16_t* base = O + z1 * c_s1 + z0 * c_s0;
        const int row0 = u.pm * BM + wr * 64 + fr, col0 = u.pn * BM + wc * 32 + 8 * fq;
#pragma unroll
        for (int ai = 0; ai < 2; ++ai)
#pragma unroll
            for (int m = 0; m < 4; ++m) { bf16_t* rowp = base + (size_t)(row0 + ai * HALF + m * 16) * ldc + col0;
#pragma unroll
                for (int bj = 0; bj < 2; ++bj) { const f32x4 v0 = acc[ai][bj][m][0], v1 = acc[ai][bj][m][1];
                    u32x4 w; w.x = cvt_pk_bf16(v0[0], v0[1]); w.y = cvt_pk_bf16(v0[2], v0[3]); w.z = cvt_pk_bf16(v1[0], v1[1]); w.w = cvt_pk_bf16(v1[2], v1[3]);
                    *(u32x4*)(rowp + bj * HALF) = w; } }
    }
};

template <int MODE> struct EpiGated {
    bf16_t* O; int ldc; const float* ss; const float* bias; int bias_half;
    __device__ __forceinline__ void operator()(Acc& acc, const Unit& u, int wr, int wc, int fr, int fq, LAS unsigned char*) const {
        const int row0 = u.pm * BM + wr * 64 + fr, col0 = u.pn * HALF + wc * 32 + 8 * fq;
        f32x4 ba[2], bg[2];
#pragma unroll
        for (int n = 0; n < 2; ++n) { if (MODE == 0) { ba[n] = *(const f32x4*)(bias + col0 + 4 * n); bg[n] = *(const f32x4*)(bias + bias_half + col0 + 4 * n); } else { ba[n] = (f32x4){0.f, 0.f, 0.f, 0.f}; bg[n] = ba[n]; } }
#pragma unroll
        for (int ai = 0; ai < 2; ++ai)
#pragma unroll
            for (int m = 0; m < 4; ++m) { const int row = row0 + ai * HALF + m * 16; const float rs = row_rs(ss, row);
                float o[8];
#pragma unroll
                for (int n = 0; n < 2; ++n) { const f32x4 va = acc[ai][0][m][n] * rs + ba[n], vg = acc[ai][1][m][n] * rs + bg[n];
#pragma unroll
                    for (int j = 0; j < 4; ++j) o[4 * n + j] = (MODE == 0) ? va[j] * fast_sigmoid(vg[j]) : va[j] * fast_sigmoid(va[j]) * vg[j]; }
                u32x4 w; w.x = cvt_pk_bf16(o[0], o[1]); w.y = cvt_pk_bf16(o[2], o[3]); w.z = cvt_pk_bf16(o[4], o[5]); w.w = cvt_pk_bf16(o[6], o[7]);
                *(u32x4*)(O + (size_t)row * ldc + col0) = w; }
    }
};

struct EpiResid {
    const float* xsrc; float* xdst; bf16_t* xb; float* ss; const float* bias;
    __device__ __forceinline__ void operator()(Acc& acc, const Unit& u, int wr, int wc, int fr, int fq, LAS unsigned char* lds) const {
        LAS float* X = (LAS float*)(lds + LDS_XCH);
        const int row0 = u.pm * BM + wr * 64 + fr, col0 = u.pn * BM + wc * 32 + 8 * fq;
        f32x4 bv[2][2];
#pragma unroll
        for (int bj = 0; bj < 2; ++bj)
#pragma unroll
            for (int n = 0; n < 2; ++n) bv[bj][n] = bias ? *(const f32x4*)(bias + col0 + bj * HALF + 4 * n) : (f32x4){0.f, 0.f, 0.f, 0.f};
#pragma unroll
        for (int ai = 0; ai < 2; ++ai)
#pragma unroll
            for (int m = 0; m < 4; ++m) { const int row = row0 + ai * HALF + m * 16; const size_t ro = (size_t)row * DM + col0; float sq = 0.f;
#pragma unroll
                for (int bj = 0; bj < 2; ++bj) {
                    const f32x4 x0 = *(const f32x4*)(xsrc + ro + bj * HALF), x1 = *(const f32x4*)(xsrc + ro + bj * HALF + 4);
                    const f32x4 v0 = acc[ai][bj][m][0] + bv[bj][0] + x0, v1 = acc[ai][bj][m][1] + bv[bj][1] + x1;
                    *(f32x4*)(xdst + ro + bj * HALF) = v0; *(f32x4*)(xdst + ro + bj * HALF + 4) = v1;
                    u32x4 w; w.x = cvt_pk_bf16(v0[0], v0[1]); w.y = cvt_pk_bf16(v0[2], v0[3]); w.z = cvt_pk_bf16(v1[0], v1[1]); w.w = cvt_pk_bf16(v1[2], v1[3]);
                    *(u32x4*)(xb + ro + bj * HALF) = w;
                    sq += (v0[0] * v0[0] + v0[1] * v0[1]) + (v0[2] * v0[2] + v0[3] * v0[3]) + (v1[0] * v1[0] + v1[1] * v1[1]) + (v1[2] * v1[2] + v1[3] * v1[3]); }
                sq += __shfl_xor(sq, 16); sq += __shfl_xor(sq, 32);
                if (fq == 0) X[(ai * HALF + wr * 64 + m * 16 + fr) * 4 + wc] = sq; }
        asm volatile("s_waitcnt lgkmcnt(0)" ::: "memory"); __builtin_amdgcn_s_barrier(); asm volatile("" ::: "memory");
        { const int t = opaque_tid(); if (t < 256) { const f32x4 v = *(const LAS f32x4*)(X + t * 4); ss[(size_t)(u.pm * BM + t) * 4 + u.pn] = (v[0] + v[1]) + (v[2] + v[3]); } }
    }
};

struct EpiSoftmax {
    bf16_t* P; const float* ss;
    __device__ __forceinline__ void operator()(Acc& acc, const Unit& u, int wr, int wc, int fr, int fq, LAS unsigned char* lds) const {
        LAS f32x2* X = (LAS f32x2*)(lds + LDS_XCH);
        float mloc[2][4];
#pragma unroll
        for (int ai = 0; ai < 2; ++ai)
#pragma unroll
            for (int m = 0; m < 4; ++m) { const int r = ai * HALF + wr * 64 + m * 16 + fr; const float rs = row_rs(ss, u.pm * BM + r);
                float mx = -INFINITY;
#pragma unroll
                for (int bj = 0; bj < 2; ++bj)
#pragma unroll
                    for (int n = 0; n < 2; ++n) { f32x4 v = acc[ai][bj][m][n] * rs; acc[ai][bj][m][n] = v; mx = fmaxf(mx, fmaxf(fmaxf(v[0], v[1]), fmaxf(v[2], v[3]))); }
                mx = fmaxf(mx, __shfl_xor(mx, 16)); mx = fmaxf(mx, __shfl_xor(mx, 32));
                float sum = 0.f;
#pragma unroll
                for (int bj = 0; bj < 2; ++bj)
#pragma unroll
                    for (int n = 0; n < 2; ++n) { f32x4 v = acc[ai][bj][m][n];
#pragma unroll
                        for (int j = 0; j < 4; ++j) { v[j] = __builtin_amdgcn_exp2f(v[j] - mx); sum += v[j]; }
                        acc[ai][bj][m][n] = v; }
                sum += __shfl_xor(sum, 16); sum += __shfl_xor(sum, 32);
                if (fq == 0) X[r * 4 + wc] = (f32x2){mx, sum};
                mloc[ai][m] = mx; }
        asm volatile("s_waitcnt lgkmcnt(0)" ::: "memory"); __builtin_amdgcn_s_barrier(); asm volatile("" ::: "memory");
        const int col0 = u.pn * BM + wc * 32 + 8 * fq;
#pragma unroll
        for (int ai = 0; ai < 2; ++ai)
#pragma unroll
            for (int m = 0; m < 4; ++m) { const int r = ai * HALF + wr * 64 + m * 16 + fr;
                const f32x2 a = X[r * 4 + 0], b = X[r * 4 + 1], c = X[r * 4 + 2], d = X[r * 4 + 3];
                const float M = fmaxf(fmaxf(a[0], b[0]), fmaxf(c[0], d[0]));
                const float L = a[1] * __builtin_amdgcn_exp2f(a[0] - M) + b[1] * __builtin_amdgcn_exp2f(b[0] - M) + c[1] * __builtin_amdgcn_exp2f(c[0] - M) + d[1] * __builtin_amdgcn_exp2f(d[0] - M);
                const float f = __builtin_amdgcn_exp2f(mloc[ai][m] - M) / L;
                bf16_t* rowp = P + (size_t)(u.pm * BM + r) * DM + col0;
#pragma unroll
                for (int bj = 0; bj < 2; ++bj) { const f32x4 v0 = acc[ai][bj][m][0] * f, v1 = acc[ai][bj][m][1] * f;
                    u32x4 w; w.x = cvt_pk_bf16(v0[0], v0[1]); w.y = cvt_pk_bf16(v0[2], v0[3]); w.z = cvt_pk_bf16(v1[0], v1[1]); w.w = cvt_pk_bf16(v1[2], v1[3]);
                    *(u32x4*)(rowp + bj * HALF) = w; } }
        asm volatile("s_waitcnt lgkmcnt(0)" ::: "memory"); __builtin_amdgcn_s_barrier(); asm volatile("" ::: "memory");
    }
};

struct EpiQKV {
    bf16_t* Q; size_t sel_stride; const float* ss; const float* cs; const float* sn;
    __device__ __forceinline__ void operator()(Acc& acc, const Unit& u, int wr, int wc, int fr, int fq, LAS unsigned char*) const {
        const int sel = u.pn >> 2; bf16_t* dst = Q + (size_t)sel * sel_stride;
        const float scl = sel == 0 ? C2 : 1.0f;
        const bool rot = (sel < 2) && ((wc & 1) == 0) && (fq < 2);
        const int row0 = u.pm * BM + wr * 64 + fr, col0 = (u.pn & 3) * BM + wc * 32 + 8 * fq;
#pragma unroll
        for (int ai = 0; ai < 2; ++ai)
#pragma unroll
            for (int m = 0; m < 4; ++m) { const int row = row0 + ai * HALF + m * 16; const float rs = row_rs(ss, row) * scl;
                f32x4 c4 = (f32x4){1.f, 1.f, 1.f, 1.f}, s4 = (f32x4){0.f, 0.f, 0.f, 0.f};
                if (rot) { c4 = *(const f32x4*)(cs + (size_t)row * 8 + 4 * fq); s4 = *(const f32x4*)(sn + (size_t)row * 8 + 4 * fq); }
                bf16_t* rowp = dst + (size_t)row * DM + col0;
#pragma unroll
                for (int bj = 0; bj < 2; ++bj) { const f32x4 a0 = acc[ai][bj][m][0] * rs, a1 = acc[ai][bj][m][1] * rs;
                    f32x4 v0, v1;
                    v0[0] = a0[0] * c4[0] - a0[1] * s4[0]; v0[1] = a0[0] * s4[0] + a0[1] * c4[0];
                    v0[2] = a0[2] * c4[1] - a0[3] * s4[1]; v0[3] = a0[2] * s4[1] + a0[3] * c4[1];
                    v1[0] = a1[0] * c4[2] - a1[1] * s4[2]; v1[1] = a1[0] * s4[2] + a1[1] * c4[2];
                    v1[2] = a1[2] * c4[3] - a1[3] * s4[3]; v1[3] = a1[2] * s4[3] + a1[3] * c4[3];
                    u32x4 w; w.x = cvt_pk_bf16(v0[0], v0[1]); w.y = cvt_pk_bf16(v0[2], v0[3]); w.z = cvt_pk_bf16(v1[0], v1[1]); w.w = cvt_pk_bf16(v1[2], v1[3]);
                    *(u32x4*)(rowp + bj * HALF) = w; } }
    }
};
}

namespace attn_body {
using bf16 = __hip_bfloat16;
using s16x4 = __attribute__((ext_vector_type(4))) short;
using f32x16 = __attribute__((ext_vector_type(16))) float;
constexpr int PITCH = 1024;
constexpr int NW = 8, QBLK = 32, QB = QBLK * NW, KVBLK = 64;
__device__ __forceinline__ int crow(int r, int hi) { return (r & 3) + 8 * (r >> 2) + 4 * hi; }
#define SBAR() __builtin_amdgcn_sched_barrier(0)
__device__ __forceinline__ void cmask(f32x16& p0, f32x16& p1, int jb, int qrel, int hi) {
  const float NEG = -INFINITY; int kb = 64 * jb + 4 * hi;
  #pragma unroll
  for (int r = 0; r < 16; ++r) { int kv = kb + (r & 3) + 8 * (r >> 2); if (kv > qrel) p0[r] = NEG; if (kv + 32 > qrel) p1[r] = NEG; }
}
constexpr int NSLOT = 3, SLOTB = 8192;
constexpr int LDS_K = 0, LDS_V = NSLOT * SLOTB, LDS_WS = 2 * NSLOT * SLOTB, LDS_OST = LDS_WS + NW * 64 * 4, LDS_ATT_BYTES = LDS_OST + NW * 4096;
__device__ __forceinline__ void glds16(const void* gsrc, unsigned lds_dst) { unsigned keep;
  asm volatile("s_mov_b32 %0, m0\n\ts_mov_b32 m0, %2\n\ts_nop 0\n\tglobal_load_lds_dwordx4 %1, off\n\ts_mov_b32 m0, %0" : "=&s"(keep) : "v"(gsrc), "s"(lds_dst) : "memory"); }
__device__ __forceinline__ float max3f(float a, float b, float c) { float r; asm("v_max3_f32 %0, %1, %2, %3" : "=v"(r) : "v"(a), "v"(b), "v"(c)); return r; }
__device__ __forceinline__ float max2f(float a, float b) { float r; asm("v_max_f32_e32 %0, %1, %2" : "=v"(r) : "v"(a), "v"(b)); return r; }
__device__ __forceinline__ float fadd_s(float a, float b) { float r; asm("v_add_f32_e32 %0, %1, %2" : "=v"(r) : "v"(a), "v"(b)); return r; }
__device__ __forceinline__ float fsub_s(float a, float b) { float r; asm("v_sub_f32_e32 %0, %1, %2" : "=v"(r) : "v"(a), "v"(b)); return r; }
typedef float f32x2_t __attribute__((ext_vector_type(2))); typedef __bf16 bf16x2_t __attribute__((ext_vector_type(2)));
__device__ __forceinline__ unsigned cvtpk_s(float lo, float hi) { f32x2_t v = {lo, hi}; bf16x2_t b = __builtin_convertvector(v, bf16x2_t); return __builtin_bit_cast(unsigned, b); }
#define WAIT_BAR(N) asm volatile("s_waitcnt vmcnt(" #N ") lgkmcnt(0)\n\ts_barrier" ::: "memory")

__device__ __forceinline__ void qkt(f32x16& p0, f32x16& p1, const char* Kslot, const bf16x8* qr, const f32x16& negm, int r32, int hi) {
  const char* kb = Kslot + hi * 1024 + r32 * 16;
  #pragma unroll
  for (int d0 = 0; d0 < 4; ++d0) {
    const bf16x8 b0 = *reinterpret_cast<const bf16x8*>(kb + d0 * 2048);
    const bf16x8 b1 = *reinterpret_cast<const bf16x8*>(kb + d0 * 2048 + 512);
    if (d0 == 0) { p0 = __builtin_amdgcn_mfma_f32_32x32x16_bf16(b0, qr[0], negm, 0, 0, 0); p1 = __builtin_amdgcn_mfma_f32_32x32x16_bf16(b1, qr[0], negm, 0, 0, 0); }
    else { p0 = __builtin_amdgcn_mfma_f32_32x32x16_bf16(b0, qr[d0], p0, 0, 0, 0); p1 = __builtin_amdgcn_mfma_f32_32x32x16_bf16(b1, qr[d0], p1, 0, 0, 0); } }
}
typedef __attribute__((address_space(3))) const char* lds_cptr;
typedef short v4i16_t __attribute__((ext_vector_type(4)));
__device__ __forceinline__ void kload8(bf16x8* kf, lds_cptr kp) {
  kf[0] = *(const __attribute__((address_space(3))) bf16x8*)(kp);        kf[1] = *(const __attribute__((address_space(3))) bf16x8*)(kp + 512);
  kf[2] = *(const __attribute__((address_space(3))) bf16x8*)(kp + 2048); kf[3] = *(const __attribute__((address_space(3))) bf16x8*)(kp + 2560);
  kf[4] = *(const __attribute__((address_space(3))) bf16x8*)(kp + 4096); kf[5] = *(const __attribute__((address_space(3))) bf16x8*)(kp + 4608);
  kf[6] = *(const __attribute__((address_space(3))) bf16x8*)(kp + 6144); kf[7] = *(const __attribute__((address_space(3))) bf16x8*)(kp + 6656);
}
__device__ __forceinline__ void kload2(bf16x8* kf, lds_cptr kp, int j) { kf[2 * j] = *(const __attribute__((address_space(3))) bf16x8*)(kp + j * 2048); kf[2 * j + 1] = *(const __attribute__((address_space(3))) bf16x8*)(kp + j * 2048 + 512); }
__device__ __forceinline__ s16x4 vtr(lds_cptr p) { return __builtin_bit_cast(s16x4, __builtin_amdgcn_ds_read_tr16_b64_v4i16((__attribute__((address_space(3))) v4i16_t*)p)); }
__device__ __forceinline__ float rowmax(const f32x16& p0, const f32x16& p1) {
  float a = max3f(p0[0], p0[1], p1[0]), b = max3f(p0[2], p0[3], p1[1]); a = max3f(a, p1[2], p1[3]);
  #pragma unroll
  for (int r = 4; r < 16; r += 4) { a = max3f(a, p0[r], p0[r + 1]); b = max3f(b, p0[r + 2], p0[r + 3]); a = max3f(a, p1[r], p1[r + 1]); b = max3f(b, p1[r + 2], p1[r + 3]); }
  const float m = max2f(a, b);
  auto rr = __builtin_amdgcn_permlane32_swap(__float_as_uint(m), __float_as_uint(m), false, false);
  return max2f(__uint_as_float(rr[0]), __uint_as_float(rr[1]));
}
__device__ __forceinline__ void pv(f32x16* o, int vb, bf16x8 pa0, bf16x8 pa1, bf16x8 pa2, bf16x8 pa3) {
  #pragma unroll
  for (int d0 = 0; d0 < 2; ++d0) { s16x4 lo[4], hi[4];
    #pragma unroll
    for (int ks = 0; ks < 4; ++ks) {
      asm volatile("ds_read_b64_tr_b16 %0,%1 offset:%c2" : "=&v"(lo[ks]) : "v"(vb), "i"(d0 * 4096 + ks * 1024) : "memory");
      asm volatile("ds_read_b64_tr_b16 %0,%1 offset:%c2" : "=&v"(hi[ks]) : "v"(vb), "i"(d0 * 4096 + ks * 1024 + 512) : "memory"); }
    asm volatile("s_waitcnt lgkmcnt(0)" ::: "memory"); SBAR();
    #define PK(k) (bf16x8){lo[k][0], lo[k][1], lo[k][2], lo[k][3], hi[k][0], hi[k][1], hi[k][2], hi[k][3]}
    o[d0] = __builtin_amdgcn_mfma_f32_32x32x16_bf16(pa0, PK(0), o[d0], 0, 0, 0);
    o[d0] = __builtin_amdgcn_mfma_f32_32x32x16_bf16(pa1, PK(1), o[d0], 0, 0, 0);
    o[d0] = __builtin_amdgcn_mfma_f32_32x32x16_bf16(pa2, PK(2), o[d0], 0, 0, 0);
    o[d0] = __builtin_amdgcn_mfma_f32_32x32x16_bf16(pa3, PK(3), o[d0], 0, 0, 0);
    #undef PK
  }
}

template<int THRL> __device__ __forceinline__ void attn_unit(int b, int qcol, int kcol, int vcol, int ocol, int qb, const bf16* Q, const bf16* __restrict__ K, const bf16* __restrict__ V, bf16* O, char* shm) {
  constexpr int DMP = PITCH;
  const int tid = opaque_tid(), lane = tid & 63, r32 = lane & 31, hi = lane >> 5; const int wid = __builtin_amdgcn_readfirstlane(tid >> 6);
  const long rowbase = (long)b * SEQ; const int q0 = qb * QB;
  const bf16* Qw = Q + (rowbase + q0 + wid * QBLK) * DMP + qcol;
  const bf16* Kh = K + rowbase * DMP + kcol, *Vh = V + rowbase * DMP + vcol;
  const unsigned lds0 = (unsigned)(uintptr_t)shm;
  float* wsf = (float*)(shm + LDS_WS) + wid * 64;
  const bf16* ksrc = Kh + (long)lane * DMP + wid * 8;
  const bf16* vsrc = Vh + (long)(16 * (wid & 3) + (lane >> 2)) * DMP + (wid >> 2) * 32 + (lane & 3) * 8;
  const unsigned kdst = lds0 + LDS_K + wid * 1024, vdst = lds0 + LDS_V + wid * 1024;
  #define DMA_K(t, slot) glds16(ksrc + (long)(t) * KVBLK * DMP, (unsigned)__builtin_amdgcn_readfirstlane(kdst + (slot)))
  #define DMA_V(t, slot) glds16(vsrc + (long)(t) * KVBLK * DMP, (unsigned)__builtin_amdgcn_readfirstlane(vdst + (slot)))
  const int vb0 = (int)(lds0 + LDS_V) + ((lane >> 4) & 1) * 32 + (lane & 3) * 8 + (4 * hi + ((lane & 15) >> 2)) * 64;
  const char* Kbase = shm + LDS_K; bf16x8 kf[8];
  const lds_cptr shm3 = (lds_cptr)shm; const lds_cptr kp0 = shm3 + LDS_K + hi * 1024 + r32 * 16; const lds_cptr vp0 = shm3 + LDS_V + ((lane >> 4) & 1) * 32 + (lane & 3) * 8 + (4 * hi + ((lane & 15) >> 2)) * 64;
  const int NT = (q0 + QB) / KVBLK;
  DMA_K(0, 0); DMA_V(0, 0); DMA_K(1, SLOTB);
  bf16x8 qr[4];
  #pragma unroll
  for (int d0 = 0; d0 < 4; ++d0) qr[d0] = *reinterpret_cast<const bf16x8*>(&Qw[(long)r32 * DMP + d0 * 16 + hi * 8]);
  float mhat = 0.f, l_reg = 0.f; f32x16 o[2]; o[0] = f32x16{}; o[1] = f32x16{}; f32x16 negm = f32x16{}; asm volatile("" : "+v"(negm));
  const int qrel = wid * QBLK + r32;
  #define CMASK(P0, P1, t) do { int jb_ = (t) - (NT - 4); if (jb_ >= 0) cmask(P0, P1, jb_, qrel, hi); } while (0)
  bool resc = false;
  #define START(P0, P1) do { const float rm = rowmax(P0, P1); resc = false; \
    { const float dl = rm; mhat = fadd_s(mhat, dl); \
      _Pragma("unroll") for (int r = 0; r < 16; ++r) { P0[r] = fsub_s(P0[r], dl); P1[r] = fsub_s(P1[r], dl); } \
      _Pragma("unroll") for (int r = 0; r < 16; ++r) negm[r] = -mhat; asm volatile("" : "+v"(negm)); } \
    _Pragma("unroll") for (int r = 0; r < 16; ++r) P0[r] = __builtin_amdgcn_exp2f(P0[r]); } while (0)
  #define RESC() do { if (resc) { asm volatile("s_waitcnt lgkmcnt(0)" ::: "memory"); \
      _Pragma("unroll") for (int d_ = 0; d_ < 2; ++d_) _Pragma("unroll") for (int r = 0; r < 16; ++r) o[d_][r] *= wsf[crow(r, hi)]; } } while (0)
  f32x16 pA0, pA1, pB0, pB1;
  int sl_prev = 0, sl_cur = 0, sl_next = SLOTB;
  #define ROT() do { sl_prev = sl_cur; sl_cur = sl_next; sl_next = (sl_next == (NSLOT - 1) * SLOTB) ? 0 : sl_next + SLOTB; } while (0)
  DMA_K(2, 2 * SLOTB);
  WAIT_BAR(3);
  qkt(pA0, pA1, Kbase, qr, negm, r32, hi); asm volatile("s_nop 15\n\ts_nop 7" : "+v"(pA0), "+v"(pA1)); CMASK(pA0, pA1, 0);
  START(pA0, pA1);
  _Pragma("unroll") for (int r = 0; r < 16; ++r) pA1[r] = __builtin_amdgcn_exp2f(pA1[r]);
  WAIT_BAR(0);
  DMA_K(3, 0); DMA_V(1, SLOTB);
  ROT();
  kload8(kf, kp0 + sl_cur);
  WAIT_BAR(2);
  s16x4 vlo[8], vhi[8]; u32x4 pw0, pw1, pw2, pw3;
  #define PKW(P, B) cvtpk_s(P[B], P[B + 1])
  #define PAF(k) __builtin_bit_cast(bf16x8, pw##k)
  #define VFR(i) (bf16x8){vlo[i][0], vlo[i][1], vlo[i][2], vlo[i][3], vhi[i][0], vhi[i][1], vhi[i][2], vhi[i][3]}
  #define PIN(x) asm volatile("" : "+v"(x))
  #define MX3(a, b, c) __builtin_fmaxf(__builtin_fmaxf((a), (b)), (c))
  #define GAPA(MF, A0, A1, A2, A3, W0, W1, PW) do { MF; sacc += A0; sacc += A1; sacc += A2; sacc += A3; PIN(sacc); W0; W1; PIN(PW); SBAR(); } while (0)
  #define EX(v) __builtin_amdgcn_exp2f(v)
  #define GAPB(MF, X, B) do { MF; X[B] = EX(X[B]); X[B + 1] = EX(X[B + 1]); X[B + 2] = EX(X[B + 2]); X[B + 3] = EX(X[B + 3]); PIN(X); SBAR(); } while (0)
  #define VRD(i) do { vlo[i] = vtr(vp_ + (((i) >> 2) * 4096 + ((i) & 3) * 1024)); vhi[i] = vtr(vp_ + (((i) >> 2) * 4096 + ((i) & 3) * 1024 + 512)); } while (0)
  #define KRD(G, j) do { if (G) { kload2(kf, kp0 + sl_next, j); SBAR(); } } while (0)
  #define STEP(C0, C1, P0, P1, t, GK, GV, GL) do { SBAR(); \
    const lds_cptr vp_ = vp0 + sl_prev; \
    VRD(0); SBAR(); float sacc = (P0[0] + P0[1]); \
    GAPA(C0 = __builtin_amdgcn_mfma_f32_32x32x16_bf16(kf[0], qr[0], negm, 0, 0, 0), P0[2], P0[3], P0[4], P0[5],     pw0[0] = PKW(P0, 0), pw0[1] = PKW(P0, 2), pw0); \
    VRD(4); SBAR(); GAPA(C1 = __builtin_amdgcn_mfma_f32_32x32x16_bf16(kf[1], qr[0], negm, 0, 0, 0), P0[6], P0[7], P0[8], P0[9],     pw0[2] = PKW(P0, 4), pw0[3] = PKW(P0, 6), pw0); \
    VRD(1); SBAR(); GAPA(C0 = __builtin_amdgcn_mfma_f32_32x32x16_bf16(kf[2], qr[1], C0, 0, 0, 0),   P0[10], P0[11], P0[12], P0[13], pw1[0] = PKW(P0, 8), pw1[1] = PKW(P0, 10), pw1); \
    VRD(5); SBAR(); GAPA(C1 = __builtin_amdgcn_mfma_f32_32x32x16_bf16(kf[3], qr[1], C1, 0, 0, 0),   P0[14], P0[15], P1[0], P1[1],   pw1[2] = PKW(P0, 12), pw1[3] = PKW(P0, 14), pw1); \
    VRD(2); SBAR(); GAPA(C0 = __builtin_amdgcn_mfma_f32_32x32x16_bf16(kf[4], qr[2], C0, 0, 0, 0),   P1[2], P1[3], P1[4], P1[5],     pw2[0] = PKW(P1, 0), pw2[1] = PKW(P1, 2), pw2); \
    VRD(6); SBAR(); GAPA(C1 = __builtin_amdgcn_mfma_f32_32x32x16_bf16(kf[5], qr[2], C1, 0, 0, 0),   P1[6], P1[7], P1[8], P1[9],     pw2[2] = PKW(P1, 4), pw2[3] = PKW(P1, 6), pw2); \
    VRD(3); SBAR(); GAPA(C0 = __builtin_amdgcn_mfma_f32_32x32x16_bf16(kf[6], qr[3], C0, 0, 0, 0),   P1[10], P1[11], P1[12], P1[13], pw3[0] = PKW(P1, 8), pw3[1] = PKW(P1, 10), pw3); \
    VRD(7); SBAR(); GAPA(C1 = __builtin_amdgcn_mfma_f32_32x32x16_bf16(kf[7], qr[3], C1, 0, 0, 0),   P1[14], P1[15], 0.f, 0.f,       pw3[2] = PKW(P1, 12), pw3[3] = PKW(P1, 14), pw3); \
    l_reg += sacc; \
    if (GK) { DMA_K((t) + 3, sl_cur); } if (GV) { DMA_V((t) + 1, sl_next); } \
    CMASK(C0, C1, t); \
    { float a = MX3(C0[0], C0[1], C1[0]), b = MX3(C0[2], C0[3], C1[1]); a = MX3(a, C1[2], C1[3]); \
      _Pragma("unroll") for (int r = 4; r < 16; r += 4) { a = MX3(a, C0[r], C0[r + 1]); b = MX3(b, C0[r + 2], C0[r + 3]); a = MX3(a, C1[r], C1[r + 1]); b = MX3(b, C1[r + 2], C1[r + 3]); } \
      float rm = __builtin_fmaxf(a, b); { auto rr = __builtin_amdgcn_permlane32_swap(__float_as_uint(rm), __float_as_uint(rm), false, false); rm = __builtin_fmaxf(__uint_as_float(rr[0]), __uint_as_float(rr[1])); } \
      resc = false; \
      if (__builtin_expect(__any(rm > (float)THRL), 0)) { const float dl = __builtin_fmaxf(rm, 0.f); mhat += dl; \
        _Pragma("unroll") for (int r = 0; r < 16; ++r) { C0[r] -= dl; C1[r] -= dl; } \
        _Pragma("unroll") for (int r = 0; r < 16; ++r) negm[r] = -mhat; asm volatile("" : "+v"(negm)); \
        const float f = __builtin_amdgcn_exp2f(-dl); l_reg *= f; if (hi == 0) wsf[r32] = f; resc = true; } } \
    SBAR(); \
    GAPB(o[0] = __builtin_amdgcn_mfma_f32_32x32x16_bf16(PAF(0), VFR(0), o[0], 0, 0, 0), C0, 0); \
    GAPB(o[1] = __builtin_amdgcn_mfma_f32_32x32x16_bf16(PAF(0), VFR(4), o[1], 0, 0, 0), C0, 4); \
    KRD(GL, 0); GAPB(o[0] = __builtin_amdgcn_mfma_f32_32x32x16_bf16(PAF(1), VFR(1), o[0], 0, 0, 0), C0, 8); \
    KRD(GL, 1); GAPB(o[1] = __builtin_amdgcn_mfma_f32_32x32x16_bf16(PAF(1), VFR(5), o[1], 0, 0, 0), C0, 12); \
    KRD(GL, 2); GAPB(o[0] = __builtin_amdgcn_mfma_f32_32x32x16_bf16(PAF(2), VFR(2), o[0], 0, 0, 0), C1, 0); \
    KRD(GL, 3); GAPB(o[1] = __builtin_amdgcn_mfma_f32_32x32x16_bf16(PAF(2), VFR(6), o[1], 0, 0, 0), C1, 4); \
    GAPB(o[0] = __builtin_amdgcn_mfma_f32_32x32x16_bf16(PAF(3), VFR(3), o[0], 0, 0, 0), C1, 8); \
    GAPB(o[1] = __builtin_amdgcn_mfma_f32_32x32x16_bf16(PAF(3), VFR(7), o[1], 0, 0, 0), C1, 12); \
    } while (0)
  int t = 1;
  #undef CMASK
  #define CMASK(P0, P1, t) do {} while (0)
  for (; t + 5 < NT; t += 2) {
    STEP(pB0, pB1, pA0, pA1, t, true, true, true);     WAIT_BAR(2); RESC(); ROT();
    STEP(pA0, pA1, pB0, pB1, t + 1, true, true, true); WAIT_BAR(2); RESC(); ROT();
  }
  #undef CMASK
  #define CMASK(P0, P1, t) do { int jb_ = (t) - (NT - 4); if (jb_ >= 0) cmask(P0, P1, jb_, qrel, hi); } while (0)
  #define ENDW(tt) do { if ((tt) + 3 < NT) { WAIT_BAR(2); } else if ((tt) + 2 < NT) { WAIT_BAR(1); } else { WAIT_BAR(0); } } while (0)
  for (; t + 1 < NT; t += 2) {
    STEP(pB0, pB1, pA0, pA1, t, (t + 3 < NT), (t + 1 < NT), (t + 1 < NT));         ENDW(t);     RESC(); ROT();
    STEP(pA0, pA1, pB0, pB1, t + 1, (t + 4 < NT), (t + 2 < NT), (t + 2 < NT));     ENDW(t + 1); RESC(); ROT();
  }
  STEP(pB0, pB1, pA0, pA1, NT - 1, false, false, false); RESC();
  { float sacc = pB0[0] + pB0[1]; _Pragma("unroll") for (int r = 2; r < 16; ++r) sacc += pB0[r]; _Pragma("unroll") for (int r = 0; r < 16; ++r) sacc += pB1[r]; l_reg += sacc;
    pw0 = (u32x4){PKW(pB0, 0), PKW(pB0, 2), PKW(pB0, 4), PKW(pB0, 6)}; pw1 = (u32x4){PKW(pB0, 8), PKW(pB0, 10), PKW(pB0, 12), PKW(pB0, 14)}; pw2 = (u32x4){PKW(pB1, 0), PKW(pB1, 2), PKW(pB1, 4), PKW(pB1, 6)}; pw3 = (u32x4){PKW(pB1, 8), PKW(pB1, 10), PKW(pB1, 12), PKW(pB1, 14)};
    SBAR(); pv(o, vb0 + sl_cur, PAF(0), PAF(1), PAF(2), PAF(3)); }
  #undef PKW
  #undef PAF
  #undef VFR
  #undef PIN
  #undef MX3
  #undef GAPA
  #undef GAPB
  #undef EX
  #undef VRD
  #undef KRD
  #undef STEP
  #undef ENDW
  { auto rr = __builtin_amdgcn_permlane32_swap(__float_as_uint(l_reg), __float_as_uint(l_reg), false, false); l_reg = __uint_as_float(rr[0]) + __uint_as_float(rr[1]); }
  if (hi == 0) wsf[32 + r32] = l_reg; asm volatile("s_waitcnt lgkmcnt(0)" ::: "memory");
  float rli[16];
  #pragma unroll
  for (int r = 0; r < 16; ++r) rli[r] = __builtin_amdgcn_rcpf(wsf[32 + crow(r, hi)]);
  bf16* Ow = O + (rowbase + q0 + wid * QBLK) * DMP + ocol;
  { bf16* stg = (bf16*)(shm + LDS_OST) + wid * 2048;
    #pragma unroll
    for (int r = 0; r < 16; ++r) { const int orow = crow(r, hi);
      #pragma unroll
      for (int d0 = 0; d0 < 2; ++d0) stg[orow * 64 + d0 * 32 + r32] = __float2bfloat16(o[d0][r] * rli[r]); }
    asm volatile("s_waitcnt lgkmcnt(0)" ::: "memory");
    #pragma unroll
    for (int i = 0; i < 4; ++i) { const int row = i * 8 + (lane >> 3), ch = lane & 7; const u32x4 v = *(const u32x4*)(stg + row * 64 + ch * 8); *(u32x4*)(Ow + (long)row * DMP + ch * 8) = v; } }
  asm volatile("s_waitcnt lgkmcnt(0)\n\ts_barrier" ::: "memory");
  #undef DMA_K
  #undef DMA_V
  #undef CMASK
  #undef START
  #undef RESC
  #undef ROT
}
#undef SBAR
#undef WAIT_BAR
}

__device__ __forceinline__ int map_row(int n, int mode, int arg) {
    if (mode == 1) return (n >> 7) * 256 + arg * 128 + (n & 127);
    if (mode == 2) { const int d = n & 63; if (d < 16) { const int dp = d < 8 ? 2 * d : 2 * (d - 8) + 1; return n - d + dp; } return n; }
    return n;
}
__device__ __forceinline__ void cvt_item(const float* W, int ldw, int K, int ncols, bf16_t* WT, const float* g, float scale, int mode, int arg, LAS float* scr, int item, int lane) {
    const int nblk = ncols / 32, kb = item / nblk, nb = item % nblk, k0 = 64 * kb, n0 = 32 * nb;
#pragma unroll 8
    for (int i = 0; i < 32; ++i) { const int kk = 2 * i + (lane >> 5); const float gs = g ? g[k0 + kk] * scale : scale; scr[kk * 33 + (lane & 31)] = W[(size_t)(k0 + kk) * ldw + n0 + (lane & 31)] * gs; }
    asm volatile("s_waitcnt lgkmcnt(0)" ::: "memory");
    const int c = lane & 7;
#pragma unroll
    for (int j = 0; j < 4; ++j) { const int n = (lane >> 3) + 8 * j; const LAS float* s = scr + (8 * c) * 33 + n;
        u32x4 o; o.x = cvt_pk_bf16(s[0 * 33], s[1 * 33]); o.y = cvt_pk_bf16(s[2 * 33], s[3 * 33]); o.z = cvt_pk_bf16(s[4 * 33], s[5 * 33]); o.w = cvt_pk_bf16(s[6 * 33], s[7 * 33]);
        *(u32x4*)(WT + (size_t)map_row(n0 + n, mode, arg) * K + k0 + 8 * c) = o; }
    asm volatile("s_waitcnt lgkmcnt(0)" ::: "memory");
}

struct Args { const void* in[34]; int ph_lo, ph_hi; };
__device__ __forceinline__ const void* ldarg(const Args& a, int k) { asm volatile("" : "+s"(k)); return a.in[k]; }
#define FARG(k) ((const float*)ldarg(args, k))
#define WSP(off) ((bf16_t*)((unsigned char*)ldarg(args, 33) + (off)))

__device__ __forceinline__ void convert_layer(const Args& args, int l, LAS float* scr, int gw, int NGW, int lane, int gtid, int NGT) {
    const int I1K = 16 * 32;
    const int IGU = 16 * (FF / 32), IDN = (FF / 64) * 32;
    const int total = 4 * I1K + I1K + 2 * IGU + IDN;
    for (int it = gw; it < total; it += NGW) {
        int r = it;
#define CVT(Wp, ldw, K, ncols, WTp, gp, sc, mode, arg) { const int ni = ((K) / 64) * ((ncols) / 32); if (r >= 0 && r < ni) cvt_item(Wp, ldw, K, ncols, WTp, gp, sc, mode, arg, scr, r, lane); r -= ni; }
        if (l < 2) {
            CVT(FARG(7) + (size_t)l * DM * 2 * DM, 2 * DM, DM, DM, WSP(WS_WMIX), FARG(3) + l * DM, 1.f, 1, 0);
            CVT(FARG(7) + (size_t)l * DM * 2 * DM + DM, 2 * DM, DM, DM, WSP(WS_WMIX), FARG(3) + l * DM, 1.f, 1, 1);
            CVT(FARG(13) + (size_t)l * DM * DM, DM, DM, DM, WSP(WS_WMIX) + (size_t)2 * DM * DM, nullptr, 1.f, 0, 0);
            r -= I1K;
        } else {
            const int b = l - 2;
            CVT(FARG(18) + (size_t)b * DM * DM, DM, DM, DM, WSP(WS_WMIX), FARG(3) + l * DM, 1.f, 2, 0);
            CVT(FARG(24) + (size_t)b * DM * DM, DM, DM, DM, WSP(WS_WMIX) + (size_t)3 * DM * DM, nullptr, 1.f, 0, 0);
            if (l == 2) {
                CVT(FARG(16), DM, DM, DM, WSP(WS_WMIX) + (size_t)DM * DM, FARG(15), 1.f, 2, 0);
                CVT(FARG(17), DM, DM, DM, WSP(WS_WMIX) + (size_t)2 * DM * DM, FARG(15), 1.f, 0, 0);
            } else r -= 2 * I1K;
        }
        CVT(FARG(28) + (size_t)l * DM * DM, DM, DM, DM, WSP(WS_WOT), nullptr, 1.f, 0, 0);
        CVT(FARG(29) + (size_t)l * DM * FF, FF, DM, FF, WSP(WS_WGU), FARG(5) + l * DM, 1.f, 1, 0);
        CVT(FARG(30) + (size_t)l * DM * FF, FF, DM, FF, WSP(WS_WGU), FARG(5) + l * DM, 1.f, 1, 1);
        CVT(FARG(31) + (size_t)l * FF * DM, DM, FF, DM, WSP(WS_WD), nullptr, 1.f, 0, 0);
#undef CVT
    }
    { const float* wq = FARG(25) + (size_t)l * DM * DM; bf16_t* o = WSP(WS_WQS); const float* norm_mem = FARG(4) + l * DM;
      for (int i = gtid; i < DM * DM / 8; i += NGT) { const int k = i >> 7; const float gs = norm_mem[k] * (0.0625f * LOG2E);
          const f32x4 v0 = *(const f32x4*)(wq + (size_t)i * 8) * gs, v1 = *(const f32x4*)(wq + (size_t)i * 8 + 4) * gs;
          u32x4 w; w.x = cvt_pk_bf16(v0[0], v0[1]); w.y = cvt_pk_bf16(v0[2], v0[3]); w.z = cvt_pk_bf16(v1[0], v1[1]); w.w = cvt_pk_bf16(v1[2], v1[3]);
          *(u32x4*)(o + (size_t)i * 8) = w; } }
}

__device__ __forceinline__ void conv_phase(const bf16_t* Gin, bf16_t* CV, const float* wdw, const float* bdw, const float* lng, const float* lnb, LAS unsigned char* lds, int G, int c) {
    constexpr int CT = 16;
    const int tid = opaque_tid(), lane = tid & 63, wid = tid >> 6, ch = 2 * tid;
    LAS float* red = (LAS float*)lds;
    LAS float* st = (LAS float*)(lds + 4096);
    float w0[31], w1[31];
#pragma unroll
    for (int j = 0; j < 31; ++j) { const f32x2 w = *(const f32x2*)(wdw + j * DM + ch); w0[j] = w[0]; w1[j] = w[1]; }
    const f32x2 bd = *(const f32x2*)(bdw + ch), gg = *(const f32x2*)(lng + ch), bb = *(const f32x2*)(lnb + ch);
    for (int unit = c; unit < TR / CT; unit += G) {
        const int row0 = unit * CT, t0 = row0 & (SEQ - 1);
        unsigned v[CT + 30];
#pragma unroll
        for (int j = 0; j < CT + 30; ++j) { const bool ok = (t0 - 30 + j) >= 0; v[j] = ok ? *(const unsigned*)(Gin + (size_t)(row0 - 30 + j) * DM + ch) : 0u; }
        float u0[CT], u1[CT];
#pragma unroll
        for (int t = 0; t < CT; ++t) { float a0 = bd[0], a1 = bd[1];
#pragma unroll
            for (int j = 0; j < 31; ++j) { a0 += w0[j] * bf_lo(v[t + j]); a1 += w1[j] * bf_hi(v[t + j]); }
            u0[t] = a0; u1[t] = a1; }
#pragma unroll
        for (int t = 0; t < CT; ++t) { float s = u0[t] + u1[t], q = u0[t] * u0[t] + u1[t] * u1[t]; s = wave_sum(s); q = wave_sum(q);
            if (lane == 0) { red[(wid * CT + t) * 2] = s; red[(wid * CT + t) * 2 + 1] = q; } }
        __syncthreads();
        if (tid < CT) { float s = 0.f, q = 0.f;
#pragma unroll
            for (int w = 0; w < 8; ++w) { s += red[(w * CT + tid) * 2]; q += red[(w * CT + tid) * 2 + 1]; }
            const float mean = s * (1.0f / DM), var = q * (1.0f / DM) - mean * mean;
            st[tid * 2] = mean; st[tid * 2 + 1] = rsqrtf(fmaxf(var, 0.f) + LN_EPS); }
        __syncthreads();
#pragma unroll
        for (int t = 0; t < CT; ++t) { const float mean = st[t * 2], rstd = st[t * 2 + 1];
            float y0 = (u0[t] - mean) * rstd * gg[0] + bb[0], y1 = (u1[t] - mean) * rstd * gg[1] + bb[1];
            y0 *= fast_sigmoid(y0); y1 *= fast_sigmoid(y1);
            *(unsigned*)(CV + (size_t)(row0 + t) * DM + ch) = cvt_pk_bf16(y0, y1); }
        __syncthreads();
    }
}

__global__ void __launch_bounds__(512, 2) yoco_fwd(Args args) {
    extern __shared__ __attribute__((aligned(16))) unsigned char lds_raw[];
    LAS unsigned char* lds = (LAS unsigned char*)lds_raw;
    cg::grid_group grid = cg::this_grid();
    const int G = gridDim.x, bx = blockIdx.x;
#define THIN_IDS const int tid = opaque_tid(), lane = tid & 63, wave = __builtin_amdgcn_readfirstlane(tid >> 6); const int gw = bx * 8 + wave, NGW = G * 8, gtid = bx * 512 + tid, NGT = G * 512; LAS float* scr = (LAS float*)(lds + wave * 16384); (void)lane; (void)gw; (void)NGW; (void)gtid; (void)NGT; (void)scr;
#define XRES ((float*)ldarg(args, 32))
#define SSP  ((float*)WSP(WS_SS))
#define HB   WSP(WS_HB)

    const int lo = args.ph_lo, hi = args.ph_hi;
    int ph = 0;
#define PH_BEGIN if (ph >= lo && ph < hi) {
#define PH_END   if (ph + 1 < hi) grid.sync(); } ++ph;

    PH_BEGIN
    {   THIN_IDS
        const float* x = FARG(0); const float* mem = FARG(1); const int* pos = (const int*)ldarg(args, 2);
        float* xres = XRES; float* ss = SSP; bf16_t* xb = WSP(WS_XB); bf16_t* memb = WSP(WS_MEMB);
        for (int m = gw; m < TR + NBATCH * NMEM; m += NGW) {
            const bool isx = m < TR; const float* src = isx ? x + (size_t)m * DM : mem + (size_t)(m - TR) * DM; bf16_t* dst = isx ? xb + (size_t)m * DM : memb + (size_t)(m - TR) * DM;
            float sq = 0.f;
#pragma unroll
            for (int j = 0; j < 4; ++j) { const f32x4 v = *((const f32x4*)src + lane + 64 * j); sq += (v[0] * v[0] + v[1] * v[1]) + (v[2] * v[2] + v[3] * v[3]);
                u32x2 w; w.x = cvt_pk_bf16(v[0], v[1]); w.y = cvt_pk_bf16(v[2], v[3]); *((u32x2*)dst + lane + 64 * j) = w;
                if (isx) *((f32x4*)(xres + (size_t)m * DM) + lane + 64 * j) = v; }
            sq = wave_sum(sq);
            if (isx && lane < 4) ss[(size_t)m * 4 + lane] = lane == 0 ? sq : 0.f;
        }
        float* cosT = (float*)WSP(WS_COS); float* sinT = (float*)WSP(WS_SIN);
        for (int i = gtid; i < TR * 8; i += NGT) { const int row = i >> 3, k = i & 7; const float inv = powf(500000.0f, -(float)(2 * k) / 16.0f); const float ang = (float)pos[row] * inv;
            cosT[i] = cosf(ang); sinT[i] = sinf(ang); }
        for (int it = gw; it < 8 * 512; it += NGW) { const int j = it >> 9, l = j >> 1, kv = j & 1;
            cvt_item(FARG(kv ? 27 : 26) + (size_t)l * DM * DM, DM, DM, DM, HB + (size_t)j * DM * DM, nullptr, 1.f, 0, 0, scr, it & 511, lane); }
        convert_layer(args, 0, scr, gw, NGW, lane, gtid, NGT);
    }
    PH_END

    PH_BEGIN
    {   pg8::Gemm g{WSP(WS_MEMB), HB, DM, DM, DM, 0, (long)NMEM * DM, (long)DM * DM, 0, 0, 4};
        pg8::Order S; S.init(1, 4, 32, G, bx);
        pg8::EpiPlain E{WSP(WS_KV), DM, (long)4 * NMEM * DM, (long)NMEM * DM, 4};
        pg8::gemm_phase(lds, g, S, E);
    }
    PH_END

    for (int l = 0; l < 4; ++l) {
        if (l > 0) { PH_BEGIN THIN_IDS convert_layer(args, l, scr, gw, NGW, lane, gtid, NGT); PH_END }
        const bool is_conv = l < 2;

        PH_BEGIN
        if (is_conv) {
            pg8::Gemm g{WSP(WS_XB), WSP(WS_WMIX), DM, DM, DM, 0, 0, 0, 0, 0, 1}; pg8::Order S; S.init(TR / 256, 8, 1, G, bx);
            pg8::EpiGated<0> E{WSP(WS_R1), DM, SSP, FARG(8) + l * 2 * DM, DM};
            pg8::gemm_phase(lds, g, S, E);
        } else {
            pg8::Gemm g{WSP(WS_XB), WSP(WS_WMIX), DM, DM, DM, 0, 0, 0, 0, 0, 1}; pg8::Order S; S.init(TR / 256, l == 2 ? 12 : 4, 1, G, bx);
            pg8::EpiQKV E{WSP(WS_R1), (size_t)(WS_KSH - WS_R1) / 2, SSP, (const float*)WSP(WS_COS), (const float*)WSP(WS_SIN)};
            pg8::gemm_phase(lds, g, S, E);
        }
        {
            pg8::Gemm g1{WSP(WS_KV) + (size_t)(l * 2 + 0) * 4 * NMEM * DM, WSP(WS_WQS), DM, DM, 256, (long)NMEM * DM, 256, 0, 256, 0, 4}; pg8::Order S1; S1.init(1, 4, 16, G, bx);
            pg8::EpiPlain E1{WSP(WS_BTS), DM, (long)DM * DM, (long)256 * DM, 4};
            pg8::gemm_phase(lds, g1, S1, E1);
            pg8::Gemm g2{WSP(WS_WOT), WSP(WS_KV) + (size_t)(l * 2 + 1) * 4 * NMEM * DM, DM, DM, 256, 0, 256, (long)NMEM * DM, 256, 0, 4}; pg8::Order S2; S2.init(4, 1, 16, G, G - 1 - bx);
            pg8::EpiPlain E2{WSP(WS_BTO), DM, (long)DM * DM, 256, 4};
            pg8::gemm_phase(lds, g2, S2, E2);
        }
        PH_END

        PH_BEGIN
        if (is_conv) {
#ifndef NO_CONV
            conv_phase(WSP(WS_R1), HB, FARG(9) + l * 31 * DM, FARG(10) + l * DM, FARG(11) + l * DM, FARG(12) + l * DM, lds, G, bx);
#endif
        } else {
#ifndef NO_ATTN
            const attn_body::bf16* qd = (const attn_body::bf16*)WSP(WS_R1); const attn_body::bf16* kd = (const attn_body::bf16*)WSP(WS_KSH); const attn_body::bf16* vd = (const attn_body::bf16*)WSP(WS_VSH);
            attn_body::bf16* od = (attn_body::bf16*)HB;
            for (int r = 0;; ++r) { const int p = (r & 1) ? (G - 1 - bx) : bx; const int idx = r * G + p; if (idx >= 2048) break;
                const int qb = 15 - (idx >> 7), j = idx & 127, b = j >> 5, h = (j >> 2) & 7, comp = (j >> 1) & 1, vh = j & 1;
                attn_body::attn_unit<8>(b, h * 128 + comp * 64, h * 128 + comp * 64, h * 128 + vh * 64, h * 128 + vh * 64, qb, qd, kd, vd, od + (size_t)comp * TR * DM, (char*)lds_raw); }
#endif
        }
        PH_END

        if (!is_conv) {
            PH_BEGIN
            THIN_IDS
            const int b = l - 2;
            const float lambda_init = 0.8f - 0.6f * expf(-0.3f * (float)l);
            const float d1 = wave_sum(FARG(19)[b * 64 + lane] * FARG(20)[b * 64 + lane]);
            const float d2 = wave_sum(FARG(21)[b * 64 + lane] * FARG(22)[b * 64 + lane]);
            const float lam = expf(d1) - expf(d2) + lambda_init;
            const float* sg = FARG(23) + b * 128 + (lane & 15) * 8;
            const f32x4 g0 = *(const f32x4*)sg * (1.0f - lambda_init), g1 = *(const f32x4*)(sg + 4) * (1.0f - lambda_init);
            const bf16_t* o0 = HB; const bf16_t* o1 = HB + (size_t)TR * DM; bf16_t* r1 = WSP(WS_R1);
            for (int i = gw * 4 + (lane >> 4); i < TR * 8; i += NGW * 4) { const size_t off = (size_t)(i >> 3) * DM + (i & 7) * 128 + (lane & 15) * 8;
                const u32x4 a = *(const u32x4*)(o0 + off), c = *(const u32x4*)(o1 + off);
                float o[8]; float sq = 0.f;
#pragma unroll
                for (int j = 0; j < 4; ++j) { o[2 * j] = bf_lo(a[j]) - lam * bf_lo(c[j]); o[2 * j + 1] = bf_hi(a[j]) - lam * bf_hi(c[j]); sq += o[2 * j] * o[2 * j] + o[2 * j + 1] * o[2 * j + 1]; }
                sq += __shfl_xor(sq, 1); sq += __shfl_xor(sq, 2); sq += __shfl_xor(sq, 4); sq += __shfl_xor(sq, 8);
                const float rs = rsqrtf(sq * (1.0f / 128.0f) + SUBLN_EPS);
                u32x4 w; w.x = cvt_pk_bf16(o[0] * rs * g0[0], o[1] * rs * g0[1]); w.y = cvt_pk_bf16(o[2] * rs * g0[2], o[3] * rs * g0[3]);
                w.z = cvt_pk_bf16(o[4] * rs * g1[0], o[5] * rs * g1[1]); w.w = cvt_pk_bf16(o[6] * rs * g1[2], o[7] * rs * g1[3]);
                *(u32x4*)(r1 + off) = w; }
            PH_END
        }

        PH_BEGIN
        {   pg8::Gemm g{is_conv ? HB : WSP(WS_R1), WSP(WS_WMIX) + (size_t)(is_conv ? 2 : 3) * DM * DM, DM, DM, DM, 0, 0, 0, 0, 0, 1}; pg8::Order S; S.init(TR / 256, 4, 1, G, bx);
            pg8::EpiResid E{XRES, XRES, WSP(WS_XB), SSP, is_conv ? FARG(14) + l * DM : nullptr};
            pg8::gemm_phase(lds, g, S, E);
        }
        PH_END

        PH_BEGIN
        {   pg8::Gemm g{WSP(WS_XB), WSP(WS_BTS), DM, DM, DM, 0, 0, 0, 0, (long)DM * DM, 1}; pg8::Order S; S.init(TR / 256, 4, 1, G, bx);
            pg8::EpiSoftmax E{WSP(WS_R1), SSP};
            pg8::gemm_phase(lds, g, S, E);
        }
        PH_END

        PH_BEGIN
        {   pg8::Gemm g{WSP(WS_R1), WSP(WS_BTO), DM, DM, DM, 0, 0, 0, 0, (long)DM * DM, 1}; pg8::Order S; S.init(TR / 256, 4, 1, G, bx);
            pg8::EpiResid E{XRES, XRES, WSP(WS_XB), SSP, nullptr};
            pg8::gemm_phase(lds, g, S, E);
        }
        PH_END

        PH_BEGIN
        {   pg8::Gemm g{WSP(WS_XB), WSP(WS_WGU), DM, DM, DM, 0, 0, 0, 0, 0, 1}; pg8::Order S; S.init(TR / 256, 2 * FF / 256, 1, G, bx);
            pg8::EpiGated<1> E{HB, FF, SSP, nullptr, 0};
            pg8::gemm_phase(lds, g, S, E);
        }
        PH_END

        PH_BEGIN
        {   pg8::Gemm g{HB, WSP(WS_WD), FF, FF, FF, 0, 0, 0, 0, 0, 1}; pg8::Order S; S.init(TR / 256, 4, 1, G, bx);
            pg8::EpiResid E{XRES, XRES, WSP(WS_XB), SSP, nullptr};
            pg8::gemm_phase(lds, g, S, E);
        }
        PH_END
    }

    PH_BEGIN
    {   THIN_IDS
        const float* gfin = FARG(6); float* xres = XRES;
        for (int m = gw; m < TR; m += NGW) { f32x4* xr = (f32x4*)(xres + (size_t)m * DM) + lane; f32x4 v[4]; float sq = 0.f;
#pragma unroll
            for (int j = 0; j < 4; ++j) { v[j] = xr[64 * j]; sq += (v[j][0] * v[j][0] + v[j][1] * v[j][1]) + (v[j][2] * v[j][2] + v[j][3] * v[j][3]); }
            const float rs = rsqrtf(wave_sum(sq) * (1.0f / DM) + RMS_EPS);
#pragma unroll
            for (int j = 0; j < 4; ++j) xr[64 * j] = v[j] * rs * *((const f32x4*)gfin + lane + 64 * j); }
    }
    PH_END
#undef PH_BEGIN
#undef PH_END
}

extern "C" void kernel_launch(void* const* d_in, const int* in_sizes, int n_in, void* d_out, int out_size, void* d_ws, size_t ws_size, hipStream_t stream) {
    static int grid = 0;
    if (grid == 0) {
        if (n_in != 32 || out_size != TR * DM || ws_size < WS_END) { fprintf(stderr, "kernel_launch: unexpected shapes (n_in %d out %d ws %zu)\n", n_in, out_size, ws_size); grid = -1; return; }
        int dev = 0, cus = 0, per_cu = 0;
        hipGetDevice(&dev); hipDeviceGetAttribute(&cus, hipDeviceAttributeMultiprocessorCount, dev);
        if (hipFuncSetAttribute((const void*)yoco_fwd, hipFuncAttributeMaxDynamicSharedMemorySize, LDS_BYTES) != hipSuccess) { fprintf(stderr, "kernel_launch: hipFuncSetAttribute failed\n"); grid = -1; return; }
        if (hipOccupancyMaxActiveBlocksPerMultiprocessor(&per_cu, (const void*)yoco_fwd, 512, LDS_BYTES) != hipSuccess || per_cu < 1) { fprintf(stderr, "kernel_launch: occupancy query gave %d\n", per_cu); per_cu = 1; (void)hipGetLastError(); }
        grid = cus * per_cu;
    }
    if (grid < 0) return;
    Args a{};
    for (int i = 0; i < 32; ++i) a.in[i] = d_in[i];
    a.in[32] = d_out; a.in[33] = d_ws;
    const int NPH = 2 + 7 + 8 + 9 + 9 + 1;
#if MK_SPLIT
    for (int p = 0; p < NPH; ++p) { a.ph_lo = p; a.ph_hi = p + 1; hipLaunchKernelGGL(yoco_fwd, dim3(grid), dim3(512), LDS_BYTES, stream, a); }
#else
    a.ph_lo = 0; a.ph_hi = NPH;
    void* kargs[] = {&a};
    hipError_t e = hipLaunchCooperativeKernel((const void*)yoco_fwd, dim3(grid), dim3(512), kargs, LDS_BYTES, stream);
    if (e != hipSuccess) fprintf(stderr, "kernel_launch: cooperative launch failed: %s (grid %d)\n", hipGetErrorString(e), grid);
#endif
}
```

```cpp
#include <hip/hip_runtime.h>
#include <hip/hip_cooperative_groups.h>
#include <hip/hip_bf16.h>
#include <cstdio>
#include <cstdint>
#include <cmath>
namespace cg = cooperative_groups;

#ifndef MK_SPLIT
#define MK_SPLIT 0
#endif

#define LAS __attribute__((address_space(3)))
typedef unsigned short bf16_t;
typedef short bf16x8 __attribute__((ext_vector_type(8)));
typedef float f32x4 __attribute__((ext_vector_type(4)));
typedef float f32x2 __attribute__((ext_vector_type(2)));
typedef unsigned u32x4 __attribute__((ext_vector_type(4)));
typedef unsigned u32x2 __attribute__((ext_vector_type(2)));

constexpr int TR = 16384, DM = 1024, FF = 2816, SEQ = 4096, NBATCH = 4, NMEM = 256;
constexpr float RMS_EPS = 1e-6f, LN_EPS = 1e-5f, SUBLN_EPS = 1e-5f;
constexpr float LOG2E = 1.4426950408889634f;
constexpr float C2 = 0.125f * LOG2E;

constexpr size_t MiB = 1u << 20;
constexpr size_t WS_SS = 0;
constexpr size_t WS_BAR = 512 * 1024;
constexpr size_t WS_COS = 1 * MiB;
constexpr size_t WS_SIN = 1 * MiB + 512 * 1024;
constexpr size_t WS_MEMB = 2 * MiB;
constexpr size_t WS_W = 4 * MiB;
constexpr size_t WS_WMIX = WS_W;
constexpr size_t WS_WQS = WS_W + 8 * MiB;
constexpr size_t WS_WOT = WS_W + 10 * MiB;
constexpr size_t WS_WGU = WS_W + 12 * MiB;
constexpr size_t WS_WD = WS_W + 24 * MiB;
constexpr size_t WS_BTS = 36 * MiB;
constexpr size_t WS_BTO = 44 * MiB;
constexpr size_t WS_KV = 52 * MiB;
constexpr size_t WS_XB = 68 * MiB;
constexpr size_t WS_R1 = 100 * MiB;
constexpr size_t WS_KSH = 132 * MiB;
constexpr size_t WS_VSH = 164 * MiB;
constexpr size_t WS_HB = 196 * MiB;
constexpr size_t WS_END = 284 * MiB;
static_assert(WS_KSH - WS_R1 == WS_VSH - WS_KSH, "q | k | v buffers equally spaced");

constexpr int LDS_STAGE = 131072, LDS_XCH = 131072, LDS_BARST = 139520, LDS_BYTES = 147456;

__device__ __forceinline__ unsigned cvt_pk_bf16(float lo, float hi) { unsigned r; asm volatile("v_cvt_pk_bf16_f32 %0, %1, %2" : "=v"(r) : "v"(lo), "v"(hi)); return r; }
__device__ __forceinline__ int opaque_tid() { int t = threadIdx.x; asm volatile("" : "+v"(t)); return t; }
__device__ __forceinline__ float bf_lo(unsigned u) { return __uint_as_float(u << 16); }
__device__ __forceinline__ float bf_hi(unsigned u) { return __uint_as_float(u & 0xffff0000u); }
__device__ __forceinline__ float wave_sum(float v) {
#pragma unroll
    for (int o = 1; o < 64; o <<= 1) v += __shfl_xor(v, o);
    return v;
}
__device__ __forceinline__ float fast_sigmoid(float x) { return __builtin_amdgcn_rcpf(1.0f + __builtin_amdgcn_exp2f(-x * LOG2E)); }
__device__ __forceinline__ float row_rs(const float* ss, int row) {
    const f32x4 a = *(const f32x4*)(ss + (size_t)row * 4);
    return rsqrtf(((a[0] + a[1]) + (a[2] + a[3])) * (1.0f / DM) + RMS_EPS);
}

namespace pg8 {
constexpr int BM = 256, BK = 64, HALF = 128, HTB = HALF * BK * 2, NXCD = 8, WGM = 8;
__host__ __device__ __forceinline__ int lds_byte(int r, int c) { const int st = (r >> 4) * 2 + (c >> 5), rr = r & 15, cc = c & 31, ob = rr * 64 + cc * 2; return st * 1024 + (ob ^ (((ob >> 9) & 1) << 5)); }
__host__ __device__ __forceinline__ void stage_rc(int b, int& R, int& C) { const int st = b / 1024, sb = b % 1024, swz = sb ^ (((sb >> 9) & 1) << 5); R = (st >> 1) * 16 + swz / 64; C = (st & 1) * 32 + (swz % 64) / 2; }
__host__ __device__ __forceinline__ int perm32(int rho) { const int n = rho >> 4, i = rho & 15; return 8 * (i >> 2) + 4 * n + (i & 3); }

struct Unit { int pm, pn, z; };
struct Gemm { const bf16_t* A; const bf16_t* Bt; int lda, ldb, K; long a_s1, a_s0, b_s1, b_s0, b_sb; int nz0; };
__device__ __forceinline__ const char* a_ptr(const Gemm& g, const Unit& u) { const int z1 = u.z / g.nz0, z0 = u.z % g.nz0; return (const char*)(g.A + z1 * g.a_s1 + z0 * g.a_s0 + (long)u.pm * BM * g.lda); }
__device__ __forceinline__ const char* b_ptr(const Gemm& g, const Unit& u) { const int z1 = u.z / g.nz0, z0 = u.z % g.nz0; return (const char*)(g.Bt + z1 * g.b_s1 + z0 * g.b_s0 + (long)(u.pm >> 4) * g.b_sb + (long)u.pn * BM * g.ldb); }

struct Order {
    int nM, nN, nz, nwg, G, c;
    __device__ void init(int nM_, int nN_, int nz_, int G_, int c_) { nM = nM_; nN = nN_; nz = nz_; nwg = nM * nN; G = G_; c = c_; }
    __device__ bool next(int i, Unit& u) const {
        const long L = (long)i * G + c; if (L >= (long)nwg * nz) return false;
        if (nz == 1) {
            int wgid = (int)L; { const int q = nwg / NXCD, r = nwg % NXCD, xcd = wgid % NXCD, off = wgid / NXCD; wgid = (xcd < r ? xcd * (q + 1) : r * (q + 1) + (xcd - r) * q) + off; }
            const int nig = WGM * nN, gid = wgid / nig, fm = gid * WGM, gsz = (nM - fm) < WGM ? (nM - fm) : WGM;
            u.pm = fm + ((wgid % nig) % gsz); u.pn = (wgid % nig) / gsz; u.z = 0;
        } else {
            const int l = (int)L; u.z = l / nwg; const int r = l % nwg; u.pm = r / nN; u.pn = r % nN;
        }
        return true;
    }
};

template <class Epi>
__device__ __forceinline__ void gemm_phase(LAS unsigned char* lds, const Gemm g, const Order& S, const Epi& E) {
    const int tid = opaque_tid(), wid = __builtin_amdgcn_readfirstlane(tid >> 6), lane = tid & 63, wr = wid >> 2, wc = wid & 3, fr = lane & 15, fq = lane >> 4;
    const int K = g.K, nt = K / BK;
    unsigned voffA[2], voffB[2];
#pragma unroll
    for (int i = 0; i < 2; ++i) { int R, C; stage_rc(tid * 16 + i * 8192, R, C); const int Rb = (R & ~31) + perm32(R & 31);
        voffA[i] = (unsigned)(R * g.lda + C) * 2u; voffB[i] = (unsigned)(Rb * g.ldb + C) * 2u; }
    const size_t kstep = (size_t)(BK * 2);
    const size_t hstepA = (size_t)HALF * g.lda * 2, hstepB = (size_t)HALF * g.ldb * 2;
    const unsigned ldsw = (unsigned)wid * 1024u;
    const int aoff = lds_byte(wr * 64 + fr, fq * 8), boff = lds_byte(wc * 32 + fr, fq * 8);
#define PG8_SA(b, h) (((b) * 2 + (h)) * HTB)
#define PG8_SB(b, h) ((4 + (b) * 2 + (h)) * HTB)
#define PG8_STAGE(bufoff, gbase, voff) do { _Pragma("unroll") for (int _i = 0; _i < 2; ++_i) \
        __builtin_amdgcn_global_load_lds((const unsigned*)((const char*)(gbase) + (voff)[_i]), (LAS unsigned*)(lds + (bufoff) + ldsw + _i * 8192), 16, 0, 0); } while (0)
#define PG8_LDA(dst, b, h) do { _Pragma("unroll") for (int m = 0; m < 4; ++m) _Pragma("unroll") for (int k = 0; k < 2; ++k) dst[m][k] = *(const LAS bf16x8*)(lds + PG8_SA(b, h) + aoff + m * 2048 + k * 1024); } while (0)
#define PG8_LDB(dst, b, h) do { _Pragma("unroll") for (int n = 0; n < 2; ++n) _Pragma("unroll") for (int k = 0; k < 2; ++k) dst[n][k] = *(const LAS bf16x8*)(lds + PG8_SB(b, h) + boff + n * 2048 + k * 1024); } while (0)
#define PG8_MMA(ai, bj, At, Bt) do { __builtin_amdgcn_s_setprio(1); _Pragma("unroll") for (int m = 0; m < 4; ++m) _Pragma("unroll") for (int n = 0; n < 2; ++n) _Pragma("unroll") for (int k = 0; k < 2; ++k) \
        acc[ai][bj][m][n] = __builtin_amdgcn_mfma_f32_16x16x32_bf16(Bt[n][k], At[m][k], acc[ai][bj][m][n], 0, 0, 0); __builtin_amdgcn_s_setprio(0); } while (0)
#define PG8_WAIT_V(n) asm volatile("s_waitcnt vmcnt(" #n ")" ::: "memory")
#define PG8_WAIT_L(n) asm volatile("s_waitcnt lgkmcnt(" #n ")" ::: "memory")
#define PG8_BAR __builtin_amdgcn_s_barrier()
#define PG8_SCHED __builtin_amdgcn_sched_barrier(0)
    Unit cur, nxt; int ui = 0;
    if (!S.next(0, cur)) return;
    f32x4 acc[2][2][4][2];
#pragma unroll
    for (int a = 0; a < 2; ++a)
#pragma unroll
        for (int b = 0; b < 2; ++b)
#pragma unroll
            for (int m = 0; m < 4; ++m)
#pragma unroll
                for (int n = 0; n < 2; ++n) acc[a][b][m][n] = (f32x4){0.f, 0.f, 0.f, 0.f};
    bf16x8 At[4][2], B0[2][2], B1[2][2];
    const char* cA = a_ptr(g, cur); const char* cB = b_ptr(g, cur);
    PG8_STAGE(PG8_SB(0, 0), cB, voffB); PG8_STAGE(PG8_SB(0, 1), cB + hstepB, voffB); PG8_STAGE(PG8_SA(0, 0), cA, voffA); PG8_STAGE(PG8_SA(0, 1), cA + hstepA, voffA);
    if (wr == 1) PG8_BAR;
    PG8_WAIT_V(2); PG8_BAR;
    PG8_STAGE(PG8_SB(1, 0), cB + kstep, voffB); PG8_STAGE(PG8_SA(1, 0), cA + kstep, voffA); PG8_STAGE(PG8_SB(1, 1), cB + hstepB + kstep, voffB);
    PG8_WAIT_V(6); PG8_BAR;
    for (;;) {
        const bool has_next = S.next(ui + 1, nxt);
        const char* nA = has_next ? a_ptr(g, nxt) : cA; const char* nB = has_next ? b_ptr(g, nxt) : cB;
        for (int t = 0; t < nt; t += 2) {
            const bool last = (t == nt - 2);
            const char* a1 = cA + (size_t)(t + 1) * kstep;
            const char* a2 = last ? nA : cA + (size_t)(t + 2) * kstep; const char* b2 = last ? nB : cB + (size_t)(t + 2) * kstep;
            const char* a3 = a2 + kstep; const char* b3 = b2 + kstep;
            PG8_LDB(B0, 0, 0); PG8_LDB(B1, 0, 1); PG8_SCHED; PG8_LDA(At, 0, 0); PG8_STAGE(PG8_SA(1, 1), a1 + hstepA, voffA);
            PG8_WAIT_V(8); PG8_WAIT_L(0); PG8_BAR; PG8_MMA(0, 0, At, B0); PG8_MMA(0, 1, At, B1); PG8_BAR; PG8_SCHED;
            PG8_LDA(At, 0, 1); PG8_STAGE(PG8_SB(0, 0), b2, voffB); PG8_STAGE(PG8_SB(0, 1), b2 + hstepB, voffB); PG8_STAGE(PG8_SA(0, 0), a2, voffA);
            PG8_WAIT_V(8); PG8_WAIT_L(0); PG8_BAR; PG8_MMA(1, 0, At, B0); PG8_MMA(1, 1, At, B1); PG8_BAR; PG8_SCHED;
            PG8_LDB(B0, 1, 0); PG8_LDB(B1, 1, 1); PG8_SCHED; PG8_LDA(At, 1, 0); PG8_STAGE(PG8_SA(0, 1), a2 + hstepA, voffA);
            PG8_WAIT_V(8); PG8_WAIT_L(0); PG8_BAR; PG8_MMA(0, 0, At, B0); PG8_MMA(0, 1, At, B1); PG8_BAR; PG8_SCHED;
            PG8_LDA(At, 1, 1); PG8_STAGE(PG8_SB(1, 0), b3, voffB); PG8_STAGE(PG8_SB(1, 1), b3 + hstepB, voffB); PG8_STAGE(PG8_SA(1, 0), a3, voffA);
            PG8_WAIT_V(8); PG8_WAIT_L(0); PG8_BAR; PG8_MMA(1, 0, At, B0); PG8_MMA(1, 1, At, B1); PG8_BAR; PG8_SCHED;
        }
        if (wr == 0) PG8_BAR;
        E(acc, cur, wr, wc, fr, fq, lds);
        if (!has_next) break;
#pragma unroll
        for (int a = 0; a < 2; ++a)
#pragma unroll
            for (int b = 0; b < 2; ++b)
#pragma unroll
                for (int m = 0; m < 4; ++m)
#pragma unroll
                    for (int n = 0; n < 2; ++n) acc[a][b][m][n] = (f32x4){0.f, 0.f, 0.f, 0.f};
        cur = nxt; cA = nA; cB = nB; ++ui;
        if (wr == 1) PG8_BAR;
    }
    PG8_WAIT_V(0);
    PG8_BAR;
#undef PG8_SA
#undef PG8_SB
#undef PG8_STAGE
#undef PG8_LDA
#undef PG8_LDB
#undef PG8_MMA
#undef PG8_WAIT_V
#undef PG8_WAIT_L
#undef PG8_BAR
#undef PG8_SCHED
}

typedef f32x4 Acc[2][2][4][2];

struct EpiPlain {
    bf16_t* O; int ldc; long c_s1, c_s0; int nz0;
    __device__ __forceinline__ void operator()(Acc& acc, const Unit& u, int wr, int wc, int fr, int fq, LAS unsigned char*) const {
        const int z1 = u.z / nz0, z0 = u.z % nz0;
        bf16_t* base = O + z1 * c_s1 + z0 * c_s0;
        const int row0 = u.pm * BM + wr * 64 + fr, col0 = u.pn * BM + wc * 32 + 8 * fq;
#pragma unroll
        for (int ai = 0; ai < 2; ++ai)
#pragma unroll
            for (int m = 0; m < 4; ++m) { bf16_t* rowp = base + (size_t)(row0 + ai * HALF + m * 16) * ldc + col0;
#pragma unroll
                for (int bj = 0; bj < 2; ++bj) { const f32x4 v0 = acc[ai][bj][m][0], v1 = acc[ai][bj][m][1];
                    u32x4 w; w.x = cvt_pk_bf16(v0[0], v0[1]); w.y = cvt_pk_bf16(v0[2], v0[3]); w.z = cvt_pk_bf16(v1[0], v1[1]); w.w = cvt_pk_bf16(v1[2], v1[3]);
                    *(u32x4*)(rowp + bj * HALF) = w; } }
    }
};

template <int MODE> struct EpiGated {
    bf16_t* O; int ldc; const float* ss; const float* bias; int bias_half;
    __device__ __forceinline__ void operator()(Acc& acc, const Unit& u, int wr, int wc, int fr, int fq, LAS unsigned char*) const {
        const int row0 = u.pm * BM + wr * 64 + fr, col0 = u.pn * HALF + wc * 32 + 8 * fq;
        f32x4 ba[2], bg[2];
#pragma unroll
        for (int n = 0; n < 2; ++n) { if (MODE == 0) { ba[n] = *(const f32x4*)(bias + col0 + 4 * n); bg[n] = *(const f32x4*)(bias + bias_half + col0 + 4 * n); } else { ba[n] = (f32x4){0.f, 0.f, 0.f, 0.f}; bg[n] = ba[n]; } }
#pragma unroll
        for (int ai = 0; ai < 2; ++ai)
#pragma unroll
            for (int m = 0; m < 4; ++m) { const int row = row0 + ai * HALF + m * 16; const float rs = row_rs(ss, row);
                float o[8];
#pragma unroll
                for (int n = 0; n < 2; ++n) { const f32x4 va = acc[ai][0][m][n] * rs + ba[n], vg = acc[ai][1][m][n] * rs + bg[n];
#pragma unroll
                    for (int j = 0; j < 4; ++j) o[4 * n + j] = (MODE == 0) ? va[j] * fast_sigmoid(vg[j]) : va[j] * fast_sigmoid(va[j]) * vg[j]; }
                u32x4 w; w.x = cvt_pk_bf16(o[0], o[1]); w.y = cvt_pk_bf16(o[2], o[3]); w.z = cvt_pk_bf16(o[4], o[5]); w.w = cvt_pk_bf16(o[6], o[7]);
                *(u32x4*)(O + (size_t)row * ldc + col0) = w; }
    }
};

struct EpiResid {
    const float* xsrc; float* xdst; bf16_t* xb; float* ss; const float* bias;
    __device__ __forceinline__ void operator()(Acc& acc, const Unit& u, int wr, int wc, int fr, int fq, LAS unsigned char* lds) const {
        LAS float* X = (LAS float*)(lds + LDS_XCH);
        const int row0 = u.pm * BM + wr * 64 + fr, col0 = u.pn * BM + wc * 32 + 8 * fq;
        f32x4 bv[2][2];
#pragma unroll
        for (int bj = 0; bj < 2; ++bj)
#pragma unroll
            for (int n = 0; n < 2; ++n) bv[bj][n] = bias ? *(const f32x4*)(bias + col0 + bj * HALF + 4 * n) : (f32x4){0.f, 0.f, 0.f, 0.f};
#pragma unroll
        for (int ai = 0; ai < 2; ++ai)
#pragma unroll
            for (int m = 0; m < 4; ++m) { const int row = row0 + ai * HALF + m * 16; const size_t ro = (size_t)row * DM + col0; float sq = 0.f;
#pragma unroll
                for (int bj = 0; bj < 2; ++bj) {
                    const f32x4 x0 = *(const f32x4*)(xsrc + ro + bj * HALF), x1 = *(const f32x4*)(xsrc + ro + bj * HALF + 4);
                    const f32x4 v0 = acc[ai][bj][m][0] + bv[bj][0] + x0, v1 = acc[ai][bj][m][1] + bv[bj][1] + x1;
                    *(f32x4*)(xdst + ro + bj * HALF) = v0; *(f32x4*)(xdst + ro + bj * HALF + 4) = v1;
                    u32x4 w; w.x = cvt_pk_bf16(v0[0], v0[1]); w.y = cvt_pk_bf16(v0[2], v0[3]); w.z = cvt_pk_bf16(v1[0], v1[1]); w.w = cvt_pk_bf16(v1[2], v1[3]);
                    *(u32x4*)(xb + ro + bj * HALF) = w;
                    sq += (v0[0] * v0[0] + v0[1] * v0[1]) + (v0[2] * v0[2] + v0[3] * v0[3]) + (v1[0] * v1[0] + v1[1] * v1[1]) + (v1[2] * v1[2] + v1[3] * v1[3]); }
                sq += __shfl_xor(sq, 16); sq += __shfl_xor(sq, 32);
                if (fq == 0) X[(ai * HALF + wr * 64 + m * 16 + fr) * 4 + wc] = sq; }
        asm volatile("s_waitcnt lgkmcnt(0)" ::: "memory"); __builtin_amdgcn_s_barrier(); asm volatile("" ::: "memory");
        { const int t = opaque_tid(); if (t < 256) { const f32x4 v = *(const LAS f32x4*)(X + t * 4); ss[(size_t)(u.pm * BM + t) * 4 + u.pn] = (v[0] + v[1]) + (v[2] + v[3]); } }
    }
};

struct EpiSoftmax {
    bf16_t* P; const float* ss;
    __device__ __forceinline__ void operator()(Acc& acc, const Unit& u, int wr, int wc, int fr, int fq, LAS unsigned char* lds) const {
        LAS f32x2* X = (LAS f32x2*)(lds + LDS_XCH);
        float mloc[2][4];
#pragma unroll
        for (int ai = 0; ai < 2; ++ai)
#pragma unroll
            for (int m = 0; m < 4; ++m) { const int r = ai * HALF + wr * 64 + m * 16 + fr; const float rs = row_rs(ss, u.pm * BM + r);
                float mx = -INFINITY;
#pragma unroll
                for (int bj = 0; bj < 2; ++bj)
#pragma unroll
                    for (int n = 0; n < 2; ++n) { f32x4 v = acc[ai][bj][m][n] * rs; acc[ai][bj][m][n] = v; mx = fmaxf(mx, fmaxf(fmaxf(v[0], v[1]), fmaxf(v[2], v[3]))); }
                mx = fmaxf(mx, __shfl_xor(mx, 16)); mx = fmaxf(mx, __shfl_xor(mx, 32));
                float sum = 0.f;
#pragma unroll
                for (int bj = 0; bj < 2; ++bj)
#pragma unroll
                    for (int n = 0; n < 2; ++n) { f32x4 v = acc[ai][bj][m][n];
#pragma unroll
                        for (int j = 0; j < 4; ++j) { v[j] = __builtin_amdgcn_exp2f(v[j] - mx); sum += v[j]; }
                        acc[ai][bj][m][n] = v; }
                sum += __shfl_xor(sum, 16); sum += __shfl_xor(sum, 32);
                if (fq == 0) X[r * 4 + wc] = (f32x2){mx, sum};
                mloc[ai][m] = mx; }
        asm volatile("s_waitcnt lgkmcnt(0)" ::: "memory"); __builtin_amdgcn_s_barrier(); asm volatile("" ::: "memory");
        const int col0 = u.pn * BM + wc * 32 + 8 * fq;
#pragma unroll
        for (int ai = 0; ai < 2; ++ai)
#pragma unroll
            for (int m = 0; m < 4; ++m) { const int r = ai * HALF + wr * 64 + m * 16 + fr;
                const f32x2 a = X[r * 4 + 0], b = X[r * 4 + 1], c = X[r * 4 + 2], d = X[r * 4 + 3];
                const float M = fmaxf(fmaxf(a[0], b[0]), fmaxf(c[0], d[0]));
                const float L = a[1] * __builtin_amdgcn_exp2f(a[0] - M) + b[1] * __builtin_amdgcn_exp2f(b[0] - M) + c[1] * __builtin_amdgcn_exp2f(c[0] - M) + d[1] * __builtin_amdgcn_exp2f(d[0] - M);
                const float f = __builtin_amdgcn_exp2f(mloc[ai][m] - M) / L;
                bf16_t* rowp = P + (size_t)(u.pm * BM + r) * DM + col0;
#pragma unroll
                for (int bj = 0; bj < 2; ++bj) { const f32x4 v0 = acc[ai][bj][m][0] * f, v1 = acc[ai][bj][m][1] * f;
                    u32x4 w; w.x = cvt_pk_bf16(v0[0], v0[1]); w.y = cvt_pk_bf16(v0[2], v0[3]); w.z = cvt_pk_bf16(v1[0], v1[1]); w.w = cvt_pk_bf16(v1[2], v1[3]);
                    *(u32x4*)(rowp + bj * HALF) = w; } }
        asm volatile("s_waitcnt lgkmcnt(0)" ::: "memory"); __builtin_amdgcn_s_barrier(); asm volatile("" ::: "memory");
    }
};

struct EpiQKV {
    bf16_t* Q; size_t sel_stride; const float* ss; const float* cs; const float* sn;
    __device__ __forceinline__ void operator()(Acc& acc, const Unit& u, int wr, int wc, int fr, int fq, LAS unsigned char*) const {
        const int sel = u.pn >> 2; bf16_t* dst = Q + (size_t)sel * sel_stride;
        const float scl = sel == 0 ? C2 : 1.0f;
        const bool rot = (sel < 2) && ((wc & 1) == 0) && (fq < 2);
        const int row0 = u.pm * BM + wr * 64 + fr, col0 = (u.pn & 3) * BM + wc * 32 + 8 * fq;
#pragma unroll
        for (int ai = 0; ai < 2; ++ai)
#pragma unroll
            for (int m = 0; m < 4; ++m) { const int row = row0 + ai * HALF + m * 16; const float rs = row_rs(ss, row) * scl;
                f32x4 c4 = (f32x4){1.f, 1.f, 1.f, 1.f}, s4 = (f32x4){0.f, 0.f, 0.f, 0.f};
                if (rot) { c4 = *(const f32x4*)(cs + (size_t)row * 8 + 4 * fq); s4 = *(const f32x4*)(sn + (size_t)row * 8 + 4 * fq); }
                bf16_t* rowp = dst + (size_t)row * DM + col0;
#pragma unroll
                for (int bj = 0; bj < 2; ++bj) { const f32x4 a0 = acc[ai][bj][m][0] * rs, a1 = acc[ai][bj][m][1] * rs;
                    f32x4 v0, v1;
                    v0[0] = a0[0] * c4[0] - a0[1] * s4[0]; v0[1] = a0[0] * s4[0] + a0[1] * c4[0];
                    v0[2] = a0[2] * c4[1] - a0[3] * s4[1]; v0[3] = a0[2] * s4[1] + a0[3] * c4[1];
                    v1[0] = a1[0] * c4[2] - a1[1] * s4[2]; v1[1] = a1[0] * s4[2] + a1[1] * c4[2];
                    v1[2] = a1[2] * c4[3] - a1[3] * s4[3]; v1[3] = a1[2] * s4[3] + a1[3] * c4[3];
                    u32x4 w; w.x = cvt_pk_bf16(v0[0], v0[1]); w.y = cvt_pk_bf16(v0[2], v0[3]); w.z = cvt_pk_bf16(v1[0], v1[1]); w.w = cvt_pk_bf16(v1[2], v1[3]);
                    *(u32x4*)(rowp + bj * HALF) = w; } }
    }
};
}

namespace attn_body {
using bf16 = __hip_bfloat16;
using s16x4 = __attribute__((ext_vector_type(4))) short;
using f32x16 = __attribute__((ext_vector_type(16))) float;
constexpr int PITCH = 1024;
constexpr int NW = 8, QBLK = 32, QB = QBLK * NW, KVBLK = 64;
__device__ __forceinline__ int crow(int r, int hi) { return (r & 3) + 8 * (r >> 2) + 4 * hi; }
#define SBAR() __builtin_amdgcn_sched_barrier(0)
__device__ __forceinline__ void cmask(f32x16& p0, f32x16& p1, int jb, int qrel, int hi) {
  const float NEG = -INFINITY; int kb = 64 * jb + 4 * hi;
  #pragma unroll
  for (int r = 0; r < 16; ++r) { int kv = kb + (r & 3) + 8 * (r >> 2); if (kv > qrel) p0[r] = NEG; if (kv + 32 > qrel) p1[r] = NEG; }
}
constexpr int NSLOT = 3, SLOTB = 8192;
constexpr int LDS_K = 0, LDS_V = NSLOT * SLOTB, LDS_WS = 2 * NSLOT * SLOTB, LDS_OST = LDS_WS + NW * 64 * 4, LDS_ATT_BYTES = LDS_OST + NW * 4096;
__device__ __forceinline__ void glds16(const void* gsrc, unsigned lds_dst) { unsigned keep;
  asm volatile("s_mov_b32 %0, m0\n\ts_mov_b32 m0, %2\n\ts_nop 0\n\tglobal_load_lds_dwordx4 %1, off\n\ts_mov_b32 m0, %0" : "=&s"(keep) : "v"(gsrc), "s"(lds_dst) : "memory"); }
__device__ __forceinline__ float max3f(float a, float b, float c) { float r; asm("v_max3_f32 %0, %1, %2, %3" : "=v"(r) : "v"(a), "v"(b), "v"(c)); return r; }
__device__ __forceinline__ float max2f(float a, float b) { float r; asm("v_max_f32_e32 %0, %1, %2" : "=v"(r) : "v"(a), "v"(b)); return r; }
__device__ __forceinline__ float fadd_s(float a, float b) { float r; asm("v_add_f32_e32 %0, %1, %2" : "=v"(r) : "v"(a), "v"(b)); return r; }
__device__ __forceinline__ float fsub_s(float a, float b) { float r; asm("v_sub_f32_e32 %0, %1, %2" : "=v"(r) : "v"(a), "v"(b)); return r; }
typedef float f32x2_t __attribute__((ext_vector_type(2))); typedef __bf16 bf16x2_t __attribute__((ext_vector_type(2)));
__device__ __forceinline__ unsigned cvtpk_s(float lo, float hi) { f32x2_t v = {lo, hi}; bf16x2_t b = __builtin_convertvector(v, bf16x2_t); return __builtin_bit_cast(unsigned, b); }
#define WAIT_BAR(N) asm volatile("s_waitcnt vmcnt(" #N ") lgkmcnt(0)\n\ts_barrier" ::: "memory")

__device__ __forceinline__ void qkt(f32x16& p0, f32x16& p1, const char* Kslot, const bf16x8* qr, const f32x16& negm, int r32, int hi) {
  const char* kb = Kslot + hi * 1024 + r32 * 16;
  #pragma unroll
  for (int d0 = 0; d0 < 4; ++d0) {
    const bf16x8 b0 = *reinterpret_cast<const bf16x8*>(kb + d0 * 2048);
    const bf16x8 b1 = *reinterpret_cast<const bf16x8*>(kb + d0 * 2048 + 512);
    if (d0 == 0) { p0 = __builtin_amdgcn_mfma_f32_32x32x16_bf16(b0, qr[0], negm, 0, 0, 0); p1 = __builtin_amdgcn_mfma_f32_32x32x16_bf16(b1, qr[0], negm, 0, 0, 0); }
    else { p0 = __builtin_amdgcn_mfma_f32_32x32x16_bf16(b0, qr[d0], p0, 0, 0, 0); p1 = __builtin_amdgcn_mfma_f32_32x32x16_bf16(b1, qr[d0], p1, 0, 0, 0); } }
}
typedef __attribute__((address_space(3))) const char* lds_cptr;
typedef short v4i16_t __attribute__((ext_vector_type(4)));
__device__ __forceinline__ void kload8(bf16x8* kf, lds_cptr kp) {
  kf[0] = *(const __attribute__((address_space(3))) bf16x8*)(kp);        kf[1] = *(const __attribute__((address_space(3))) bf16x8*)(kp + 512);
  kf[2] = *(const __attribute__((address_space(3))) bf16x8*)(kp + 2048); kf[3] = *(const __attribute__((address_space(3))) bf16x8*)(kp + 2560);
  kf[4] = *(const __attribute__((address_space(3))) bf16x8*)(kp + 4096); kf[5] = *(const __attribute__((address_space(3))) bf16x8*)(kp + 4608);
  kf[6] = *(const __attribute__((address_space(3))) bf16x8*)(kp + 6144); kf[7] = *(const __attribute__((address_space(3))) bf16x8*)(kp + 6656);
}
__device__ __forceinline__ void kload2(bf16x8* kf, lds_cptr kp, int j) { kf[2 * j] = *(const __attribute__((address_space(3))) bf16x8*)(kp + j * 2048); kf[2 * j + 1] = *(const __attribute__((address_space(3))) bf16x8*)(kp + j * 2048 + 512); }
__device__ __forceinline__ s16x4 vtr(lds_cptr p) { return __builtin_bit_cast(s16x4, __builtin_amdgcn_ds_read_tr16_b64_v4i16((__attribute__((address_space(3))) v4i16_t*)p)); }
__device__ __forceinline__ float rowmax(const f32x16& p0, const f32x16& p1) {
  float a = max3f(p0[0], p0[1], p1[0]), b = max3f(p0[2], p0[3], p1[1]); a = max3f(a, p1[2], p1[3]);
  #pragma unroll
  for (int r = 4; r < 16; r += 4) { a = max3f(a, p0[r], p0[r + 1]); b = max3f(b, p0[r + 2], p0[r + 3]); a = max3f(a, p1[r], p1[r + 1]); b = max3f(b, p1[r + 2], p1[r + 3]); }
  const float m = max2f(a, b);
  auto rr = __builtin_amdgcn_permlane32_swap(__float_as_uint(m), __float_as_uint(m), false, false);
  return max2f(__uint_as_float(rr[0]), __uint_as_float(rr[1]));
}
__device__ __forceinline__ void pv(f32x16* o, int vb, bf16x8 pa0, bf16x8 pa1, bf16x8 pa2, bf16x8 pa3) {
  #pragma unroll
  for (int d0 = 0; d0 < 2; ++d0) { s16x4 lo[4], hi[4];
    #pragma unroll
    for (int ks = 0; ks < 4; ++ks) {
      asm volatile("ds_read_b64_tr_b16 %0,%1 offset:%c2" : "=&v"(lo[ks]) : "v"(vb), "i"(d0 * 4096 + ks * 1024) : "memory");
      asm volatile("ds_read_b64_tr_b16 %0,%1 offset:%c2" : "=&v"(hi[ks]) : "v"(vb), "i"(d0 * 4096 + ks * 1024 + 512) : "memory"); }
    asm volatile("s_waitcnt lgkmcnt(0)" ::: "memory"); SBAR();
    #define PK(k) (bf16x8){lo[k][0], lo[k][1], lo[k][2], lo[k][3], hi[k][0], hi[k][1], hi[k][2], hi[k][3]}
    o[d0] = __builtin_amdgcn_mfma_f32_32x32x16_bf16(pa0, PK(0), o[d0], 0, 0, 0);
    o[d0] = __builtin_amdgcn_mfma_f32_32x32x16_bf16(pa1, PK(1), o[d0], 0, 0, 0);
    o[d0] = __builtin_amdgcn_mfma_f32_32x32x16_bf16(pa2, PK(2), o[d0], 0, 0, 0);
    o[d0] = __builtin_amdgcn_mfma_f32_32x32x16_bf16(pa3, PK(3), o[d0], 0, 0, 0);
    #undef PK
  }
}

template<int THRL> __device__ __forceinline__ void attn_unit(int b, int qcol, int kcol, int vcol, int ocol, int qb, const bf16* Q, const bf16* __restrict__ K, const bf16* __restrict__ V, bf16* O, char* shm) {
  constexpr int DMP = PITCH;
  const int tid = opaque_tid(), lane = tid & 63, r32 = lane & 31, hi = lane >> 5; const int wid = __builtin_amdgcn_readfirstlane(tid >> 6);
  const long rowbase = (long)b * SEQ; const int q0 = qb * QB;
  const bf16* Qw = Q + (rowbase + q0 + wid * QBLK) * DMP + qcol;
  const bf16* Kh = K + rowbase * DMP + kcol, *Vh = V + rowbase * DMP + vcol;
  const unsigned lds0 = (unsigned)(uintptr_t)shm;
  float* wsf = (float*)(shm + LDS_WS) + wid * 64;
  const bf16* ksrc = Kh + (long)lane * DMP + wid * 8;
  const bf16* vsrc = Vh + (long)(16 * (wid & 3) + (lane >> 2)) * DMP + (wid >> 2) * 32 + (lane & 3) * 8;
  const unsigned kdst = lds0 + LDS_K + wid * 1024, vdst = lds0 + LDS_V + wid * 1024;
  #define DMA_K(t, slot) glds16(ksrc + (long)(t) * KVBLK * DMP, (unsigned)__builtin_amdgcn_readfirstlane(kdst + (slot)))
  #define DMA_V(t, slot) glds16(vsrc + (long)(t) * KVBLK * DMP, (unsigned)__builtin_amdgcn_readfirstlane(vdst + (slot)))
  const int vb0 = (int)(lds0 + LDS_V) + ((lane >> 4) & 1) * 32 + (lane & 3) * 8 + (4 * hi + ((lane & 15) >> 2)) * 64;
  const char* Kbase = shm + LDS_K; bf16x8 kf[8];
  const lds_cptr shm3 = (lds_cptr)shm; const lds_cptr kp0 = shm3 + LDS_K + hi * 1024 + r32 * 16; const lds_cptr vp0 = shm3 + LDS_V + ((lane >> 4) & 1) * 32 + (lane & 3) * 8 + (4 * hi + ((lane & 15) >> 2)) * 64;
  const int NT = (q0 + QB) / KVBLK;
  DMA_K(0, 0); DMA_V(0, 0); DMA_K(1, SLOTB);
  bf16x8 qr[4];
  #pragma unroll
  for (int d0 = 0; d0 < 4; ++d0) qr[d0] = *reinterpret_cast<const bf16x8*>(&Qw[(long)r32 * DMP + d0 * 16 + hi * 8]);
  float mhat = 0.f, l_reg = 0.f; f32x16 o[2]; o[0] = f32x16{}; o[1] = f32x16{}; f32x16 negm = f32x16{}; asm volatile("" : "+v"(negm));
  const int qrel = wid * QBLK + r32;
  #define CMASK(P0, P1, t) do { int jb_ = (t) - (NT - 4); if (jb_ >= 0) cmask(P0, P1, jb_, qrel, hi); } while (0)
  bool resc = false;
  #define START(P0, P1) do { const float rm = rowmax(P0, P1); resc = false; \
    { const float dl = rm; mhat = fadd_s(mhat, dl); \
      _Pragma("unroll") for (int r = 0; r < 16; ++r) { P0[r] = fsub_s(P0[r], dl); P1[r] = fsub_s(P1[r], dl); } \
      _Pragma("unroll") for (int r = 0; r < 16; ++r) negm[r] = -mhat; asm volatile("" : "+v"(negm)); } \
    _Pragma("unroll") for (int r = 0; r < 16; ++r) P0[r] = __builtin_amdgcn_exp2f(P0[r]); } while (0)
  #define RESC() do { if (resc) { asm volatile("s_waitcnt lgkmcnt(0)" ::: "memory"); \
      _Pragma("unroll") for (int d_ = 0; d_ < 2; ++d_) _Pragma("unroll") for (int r = 0; r < 16; ++r) o[d_][r] *= wsf[crow(r, hi)]; } } while (0)
  f32x16 pA0, pA1, pB0, pB1;
  int sl_prev = 0, sl_cur = 0, sl_next = SLOTB;
  #define ROT() do { sl_prev = sl_cur; sl_cur = sl_next; sl_next = (sl_next == (NSLOT - 1) * SLOTB) ? 0 : sl_next + SLOTB; } while (0)
  DMA_K(2, 2 * SLOTB);
  WAIT_BAR(3);
  qkt(pA0, pA1, Kbase, qr, negm, r32, hi); asm volatile("s_nop 15\n\ts_nop 7" : "+v"(pA0), "+v"(pA1)); CMASK(pA0, pA1, 0);
  START(pA0, pA1);
  _Pragma("unroll") for (int r = 0; r < 16; ++r) pA1[r] = __builtin_amdgcn_exp2f(pA1[r]);
  WAIT_BAR(0);
  DMA_K(3, 0); DMA_V(1, SLOTB);
  ROT();
  kload8(kf, kp0 + sl_cur);
  WAIT_BAR(2);
  s16x4 vlo[8], vhi[8]; u32x4 pw0, pw1, pw2, pw3;
  #define PKW(P, B) cvtpk_s(P[B], P[B + 1])
  #define PAF(k) __builtin_bit_cast(bf16x8, pw##k)
  #define VFR(i) (bf16x8){vlo[i][0], vlo[i][1], vlo[i][2], vlo[i][3], vhi[i][0], vhi[i][1], vhi[i][2], vhi[i][3]}
  #define PIN(x) asm volatile("" : "+v"(x))
  #define MX3(a, b, c) __builtin_fmaxf(__builtin_fmaxf((a), (b)), (c))
  #define GAPA(MF, A0, A1, A2, A3, W0, W1, PW) do { MF; sacc += A0; sacc += A1; sacc += A2; sacc += A3; PIN(sacc); W0; W1; PIN(PW); SBAR(); } while (0)
  #define EX(v) __builtin_amdgcn_exp2f(v)
  #define GAPB(MF, X, B) do { MF; X[B] = EX(X[B]); X[B + 1] = EX(X[B + 1]); X[B + 2] = EX(X[B + 2]); X[B + 3] = EX(X[B + 3]); PIN(X); SBAR(); } while (0)
  #define VRD(i) do { vlo[i] = vtr(vp_ + (((i) >> 2) * 4096 + ((i) & 3) * 1024)); vhi[i] = vtr(vp_ + (((i) >> 2) * 4096 + ((i) & 3) * 1024 + 512)); } while (0)
  #define KRD(G, j) do { if (G) { kload2(kf, kp0 + sl_next, j); SBAR(); } } while (0)
  #define STEP(C0, C1, P0, P1, t, GK, GV, GL) do { SBAR(); \
    const lds_cptr vp_ = vp0 + sl_prev; \
    VRD(0); SBAR(); float sacc = (P0[0] + P0[1]); \
    GAPA(C0 = __builtin_amdgcn_mfma_f32_32x32x16_bf16(kf[0], qr[0], negm, 0, 0, 0), P0[2], P0[3], P0[4], P0[5],     pw0[0] = PKW(P0, 0), pw0[1] = PKW(P0, 2), pw0); \
    VRD(4); SBAR(); GAPA(C1 = __builtin_amdgcn_mfma_f32_32x32x16_bf16(kf[1], qr[0], negm, 0, 0, 0), P0[6], P0[7], P0[8], P0[9],     pw0[2] = PKW(P0, 4), pw0[3] = PKW(P0, 6), pw0); \
    VRD(1); SBAR(); GAPA(C0 = __builtin_amdgcn_mfma_f32_32x32x16_bf16(kf[2], qr[1], C0, 0, 0, 0),   P0[10], P0[11], P0[12], P0[13], pw1[0] = PKW(P0, 8), pw1[1] = PKW(P0, 10), pw1); \
    VRD(5); SBAR(); GAPA(C1 = __builtin_amdgcn_mfma_f32_32x32x16_bf16(kf[3], qr[1], C1, 0, 0, 0),   P0[14], P0[15], P1[0], P1[1],   pw1[2] = PKW(P0, 12), pw1[3] = PKW(P0, 14), pw1); \
    VRD(2); SBAR(); GAPA(C0 = __builtin_amdgcn_mfma_f32_32x32x16_bf16(kf[4], qr[2], C0, 0, 0, 0),   P1[2], P1[3], P1[4], P1[5],     pw2[0] = PKW(P1, 0), pw2[1] = PKW(P1, 2), pw2); \
    VRD(6); SBAR(); GAPA(C1 = __builtin_amdgcn_mfma_f32_32x32x16_bf16(kf[5], qr[2], C1, 0, 0, 0),   P1[6], P1[7], P1[8], P1[9],     pw2[2] = PKW(P1, 4), pw2[3] = PKW(P1, 6), pw2); \
    VRD(3); SBAR(); GAPA(C0 = __builtin_amdgcn_mfma_f32_32x32x16_bf16(kf[6], qr[3], C0, 0, 0, 0),   P1[10], P1[11], P1[12], P1[13], pw3[0] = PKW(P1, 8), pw3[1] = PKW(P1, 10), pw3); \
    VRD(7); SBAR(); GAPA(C1 = __builtin_amdgcn_mfma_f32_32x32x16_bf16(kf[7], qr[3], C1, 0, 0, 0),   P1[14], P1[15], 0.f, 0.f,       pw3[2] = PKW(P1, 12), pw3[3] = PKW(P1, 14), pw3); \
    l_reg += sacc; \
    if (GK) { DMA_K((t) + 3, sl_cur); } if (GV) { DMA_V((t) + 1, sl_next); } \
    CMASK(C0, C1, t); \
    { float a = MX3(C0[0], C0[1], C1[0]), b = MX3(C0[2], C0[3], C1[1]); a = MX3(a, C1[2], C1[3]); \
      _Pragma("unroll") for (int r = 4; r < 16; r += 4) { a = MX3(a, C0[r], C0[r + 1]); b = MX3(b, C0[r + 2], C0[r + 3]); a = MX3(a, C1[r], C1[r + 1]); b = MX3(b, C1[r + 2], C1[r + 3]); } \
      float rm = __builtin_fmaxf(a, b); { auto rr = __builtin_amdgcn_permlane32_swap(__float_as_uint(rm), __float_as_uint(rm), false, false); rm = __builtin_fmaxf(__uint_as_float(rr[0]), __uint_as_float(rr[1])); } \
      resc = false; \
      if (__builtin_expect(__any(rm > (float)THRL), 0)) { const float dl = __builtin_fmaxf(rm, 0.f); mhat += dl; \
        _Pragma("unroll") for (int r = 0; r < 16; ++r) { C0[r] -= dl; C1[r] -= dl; } \
        _Pragma("unroll") for (int r = 0; r < 16; ++r) negm[r] = -mhat; asm volatile("" : "+v"(negm)); \
        const float f = __builtin_amdgcn_exp2f(-dl); l_reg *= f; if (hi == 0) wsf[r32] = f; resc = true; } } \
    SBAR(); \
    GAPB(o[0] = __builtin_amdgcn_mfma_f32_32x32x16_bf16(PAF(0), VFR(0), o[0], 0, 0, 0), C0, 0); \
    GAPB(o[1] = __builtin_amdgcn_mfma_f32_32x32x16_bf16(PAF(0), VFR(4), o[1], 0, 0, 0), C0, 4); \
    KRD(GL, 0); GAPB(o[0] = __builtin_amdgcn_mfma_f32_32x32x16_bf16(PAF(1), VFR(1), o[0], 0, 0, 0), C0, 8); \
    KRD(GL, 1); GAPB(o[1] = __builtin_amdgcn_mfma_f32_32x32x16_bf16(PAF(1), VFR(5), o[1], 0, 0, 0), C0, 12); \
    KRD(GL, 2); GAPB(o[0] = __builtin_amdgcn_mfma_f32_32x32x16_bf16(PAF(2), VFR(2), o[0], 0, 0, 0), C1, 0); \
    KRD(GL, 3); GAPB(o[1] = __builtin_amdgcn_mfma_f32_32x32x16_bf16(PAF(2), VFR(6), o[1], 0, 0, 0), C1, 4); \
    GAPB(o[0] = __builtin_amdgcn_mfma_f32_32x32x16_bf16(PAF(3), VFR(3), o[0], 0, 0, 0), C1, 8); \
    GAPB(o[1] = __builtin_amdgcn_mfma_f32_32x32x16_bf16(PAF(3), VFR(7), o[1], 0, 0, 0), C1, 12); \
    } while (0)
  int t = 1;
  #undef CMASK
  #define CMASK(P0, P1, t) do {} while (0)
  for (; t + 5 < NT; t += 2) {
    STEP(pB0, pB1, pA0, pA1, t, true, true, true);     WAIT_BAR(2); RESC(); ROT();
    STEP(pA0, pA1, pB0, pB1, t + 1, true, true, true); WAIT_BAR(2); RESC(); ROT();
  }
  #undef CMASK
  #define CMASK(P0, P1, t) do { int jb_ = (t) - (NT - 4); if (jb_ >= 0) cmask(P0, P1, jb_, qrel, hi); } while (0)
  #define ENDW(tt) do { if ((tt) + 3 < NT) { WAIT_BAR(2); } else if ((tt) + 2 < NT) { WAIT_BAR(1); } else { WAIT_BAR(0); } } while (0)
  for (; t + 1 < NT; t += 2) {
    STEP(pB0, pB1, pA0, pA1, t, (t + 3 < NT), (t + 1 < NT), (t + 1 < NT));         ENDW(t);     RESC(); ROT();
    STEP(pA0, pA1, pB0, pB1, t + 1, (t + 4 < NT), (t + 2 < NT), (t + 2 < NT));     ENDW(t + 1); RESC(); ROT();
  }
  STEP(pB0, pB1, pA0, pA1, NT - 1, false, false, false); RESC();
  { float sacc = pB0[0] + pB0[1]; _Pragma("unroll") for (int r = 2; r < 16; ++r) sacc += pB0[r]; _Pragma("unroll") for (int r = 0; r < 16; ++r) sacc += pB1[r]; l_reg += sacc;
    pw0 = (u32x4){PKW(pB0, 0), PKW(pB0, 2), PKW(pB0, 4), PKW(pB0, 6)}; pw1 = (u32x4){PKW(pB0, 8), PKW(pB0, 10), PKW(pB0, 12), PKW(pB0, 14)}; pw2 = (u32x4){PKW(pB1, 0), PKW(pB1, 2), PKW(pB1, 4), PKW(pB1, 6)}; pw3 = (u32x4){PKW(pB1, 8), PKW(pB1, 10), PKW(pB1, 12), PKW(pB1, 14)};
    SBAR(); pv(o, vb0 + sl_cur, PAF(0), PAF(1), PAF(2), PAF(3)); }
  #undef PKW
  #undef PAF
  #undef VFR
  #undef PIN
  #undef MX3
  #undef GAPA
  #undef GAPB
  #undef EX
  #undef VRD
  #undef KRD
  #undef STEP
  #undef ENDW
  { auto rr = __builtin_amdgcn_permlane32_swap(__float_as_uint(l_reg), __float_as_uint(l_reg), false, false); l_reg = __uint_as_float(rr[0]) + __uint_as_float(rr[1]); }
  if (hi == 0) wsf[32 + r32] = l_reg; asm volatile("s_waitcnt lgkmcnt(0)" ::: "memory");
  float rli[16];
  #pragma unroll
  for (int r = 0; r < 16; ++r) rli[r] = __builtin_amdgcn_rcpf(wsf[32 + crow(r, hi)]);
  bf16* Ow = O + (rowbase + q0 + wid * QBLK) * DMP + ocol;
  { bf16* stg = (bf16*)(shm + LDS_OST) + wid * 2048;
    #pragma unroll
    for (int r = 0; r < 16; ++r) { const int orow = crow(r, hi);
      #pragma unroll
      for (int d0 = 0; d0 < 2; ++d0) stg[orow * 64 + d0 * 32 + r32] = __float2bfloat16(o[d0][r] * rli[r]); }
    asm volatile("s_waitcnt lgkmcnt(0)" ::: "memory");
    #pragma unroll
    for (int i = 0; i < 4; ++i) { const int row = i * 8 + (lane >> 3), ch = lane & 7; const u32x4 v = *(const u32x4*)(stg + row * 64 + ch * 8); *(u32x4*)(Ow + (long)row * DMP + ch * 8) = v; } }
  asm volatile("s_waitcnt lgkmcnt(0)\n\ts_barrier" ::: "memory");
  #undef DMA_K
  #undef DMA_V
  #undef CMASK
  #undef START
  #undef RESC
  #undef ROT
}
#undef SBAR
#undef WAIT_BAR
}

#define XB_TMO      128
#define XB_XCNT(j)  (256  + 64 * (j))
#define XB_XSUB(j)  (1280 + 64 * (j))
#define XB_XGEN(j)  (2304 + 64 * (j))
#define XB_TOP      3328
#define XB_TOPGEN   3392
#define XCD_BAR_WORDS 3456
#define XB_SPIN_CAP (1u << 18)
__device__ __forceinline__ unsigned xb_ld(unsigned* p)              { return __hip_atomic_load(p, __ATOMIC_RELAXED, __HIP_MEMORY_SCOPE_AGENT); }
__device__ __forceinline__ unsigned xb_add(unsigned* p, unsigned v) { return __hip_atomic_fetch_add(p, v, __ATOMIC_RELAXED, __HIP_MEMORY_SCOPE_AGENT); }
__device__ __forceinline__ unsigned xb_xcc_id() { return (unsigned)__builtin_amdgcn_s_getreg((3 << 11) | 20) & 0xFu; }
#define XB_SPIN(cond, bar) do { unsigned _sp = 0; while (cond) { __builtin_amdgcn_s_sleep(1); \
    if ((++_sp & 255u) == 0u) { if (xb_ld(&(bar)[XB_TMO])) break; if (_sp > XB_SPIN_CAP) { atomicAdd(&(bar)[XB_TMO], 1u); break; } } } } while (0)
struct XcdBarrier { unsigned* bar; unsigned x; volatile LAS unsigned* st; };
__device__ __forceinline__ XcdBarrier xcd_barrier_post(unsigned* bar, volatile LAS unsigned* st) {
    XcdBarrier b; b.bar = bar; b.x = xb_xcc_id(); b.st = st;
    if (threadIdx.x == 0) (void)xb_add(&bar[XB_XCNT(b.x)], 1u);
    return b;
}
__device__ __forceinline__ void xcd_barrier_complete(unsigned* bar, unsigned x, unsigned& nloc, unsigned& nx) {
    const unsigned G = gridDim.x * gridDim.y * gridDim.z;
    unsigned sum, cnt, mine, sp = 0u;
    for (;;) {
        sum = 0u; cnt = 0u; mine = 0u;
#pragma unroll
        for (unsigned j = 0; j < 16; ++j) { const unsigned c = xb_ld(&bar[XB_XCNT(j)]); sum += c; cnt += (c > 0u) ? 1u : 0u; mine = (j == x) ? c : mine; }
        if (sum == G) break;
        __builtin_amdgcn_s_sleep(1);
        if ((++sp & 255u) == 0u) { if (xb_ld(&bar[XB_TMO])) break; if (sp > XB_SPIN_CAP) { atomicAdd(&bar[XB_TMO], 1u); break; } }
    }
    nloc = mine > 0u ? mine : 1u; nx = cnt > 0u ? cnt : 1u;
}
__device__ __forceinline__ void xcd_barrier(const XcdBarrier& b) {
    asm volatile("s_waitcnt vmcnt(0)" ::: "memory");
    __syncthreads();
    if (threadIdx.x == 0) {
        unsigned* bar = b.bar;
        __builtin_amdgcn_s_waitcnt(0);
        unsigned nloc = b.st[0], nx = b.st[1];
        if (nloc == 0u) { xcd_barrier_complete(bar, b.x, nloc, nx); b.st[0] = nloc; b.st[1] = nx; }
        const unsigned old = xb_add(&bar[XB_XSUB(b.x)], 1u);
        const unsigned gen = old / nloc;
        if (old + 1u == (gen + 1u) * nloc) {
            __builtin_amdgcn_fence(__ATOMIC_RELEASE, "agent");
            asm volatile("s_waitcnt vmcnt(0)" ::: "memory");
            const unsigned og = xb_add(&bar[XB_TOP], 1u);
            const unsigned tg = og / nx;
            if (og + 1u == (tg + 1u) * nx) xb_add(&bar[XB_TOPGEN], 1u);
            else XB_SPIN(xb_ld(&bar[XB_TOPGEN]) == tg, bar);
            __builtin_amdgcn_fence(__ATOMIC_ACQUIRE, "agent");
            xb_add(&bar[XB_XGEN(b.x)], 1u);
            asm volatile("s_waitcnt vmcnt(0)" ::: "memory");
        } else {
            XB_SPIN(xb_ld(&bar[XB_XGEN(b.x)]) == gen, bar);
            __builtin_amdgcn_fence(__ATOMIC_ACQUIRE, "agent");
            asm volatile("s_waitcnt vmcnt(0)" ::: "memory");
        }
    }
    __syncthreads();
}

__device__ __forceinline__ int map_row(int n, int mode, int arg) {
    if (mode == 1) return (n >> 7) * 256 + arg * 128 + (n & 127);
    if (mode == 2) { const int d = n & 63; if (d < 16) { const int dp = d < 8 ? 2 * d : 2 * (d - 8) + 1; return n - d + dp; } return n; }
    return n;
}
__device__ __forceinline__ void cvt_item(const float* W, int ldw, int K, int ncols, bf16_t* WT, const float* g, float scale, int mode, int arg, LAS float* scr, int item, int lane) {
    const int nblk = ncols / 64, kb = item / nblk, nb = item % nblk, k0 = 64 * kb, n0 = 64 * nb;
#pragma unroll 8
    for (int i = 0; i < 16; ++i) { const int kk = 4 * i + (lane >> 4); const float gs = g ? g[k0 + kk] * scale : scale;
        const f32x4 v = *(const f32x4*)(W + (size_t)(k0 + kk) * ldw + n0 + (lane & 15) * 4) * gs;
        LAS float* d = scr + kk * 65 + (lane & 15) * 4; d[0] = v[0]; d[1] = v[1]; d[2] = v[2]; d[3] = v[3]; }
    asm volatile("s_waitcnt lgkmcnt(0)" ::: "memory");
    const int c = lane & 7;
#pragma unroll
    for (int j = 0; j < 8; ++j) { const int n = (lane >> 3) + 8 * j; const LAS float* s = scr + (8 * c) * 65 + n;
        u32x4 o; o.x = cvt_pk_bf16(s[0 * 65], s[1 * 65]); o.y = cvt_pk_bf16(s[2 * 65], s[3 * 65]); o.z = cvt_pk_bf16(s[4 * 65], s[5 * 65]); o.w = cvt_pk_bf16(s[6 * 65], s[7 * 65]);
        *(u32x4*)(WT + (size_t)map_row(n0 + n, mode, arg) * K + k0 + 8 * c) = o; }
    asm volatile("s_waitcnt lgkmcnt(0)" ::: "memory");
}

struct Args { const void* in[34]; int ph_lo, ph_hi; };
__device__ __forceinline__ const void* ldarg(const Args& a, int k) { asm volatile("" : "+s"(k)); return a.in[k]; }
#define FARG(k) ((const float*)ldarg(args, k))
#define WSP(off) ((bf16_t*)((unsigned char*)ldarg(args, 33) + (off)))

__device__ __forceinline__ void convert_layer(const Args& args, int l, LAS float* scr, int gw, int NGW, int lane, int gtid, int NGT) {
    const int I1K = 16 * 16;
    const int IGU = 16 * (FF / 64), IDN = (FF / 64) * 16;
    const int total = 4 * I1K + I1K + 2 * IGU + IDN;
    for (int it = gw; it < total; it += NGW) {
        int r = it;
#define CVT(Wp, ldw, K, ncols, WTp, gp, sc, mode, arg) { const int ni = ((K) / 64) * ((ncols) / 64); if (r >= 0 && r < ni) cvt_item(Wp, ldw, K, ncols, WTp, gp, sc, mode, arg, scr, r, lane); r -= ni; }
        if (l < 2) {
            CVT(FARG(7) + (size_t)l * DM * 2 * DM, 2 * DM, DM, DM, WSP(WS_WMIX), FARG(3) + l * DM, 1.f, 1, 0);
            CVT(FARG(7) + (size_t)l * DM * 2 * DM + DM, 2 * DM, DM, DM, WSP(WS_WMIX), FARG(3) + l * DM, 1.f, 1, 1);
            CVT(FARG(13) + (size_t)l * DM * DM, DM, DM, DM, WSP(WS_WMIX) + (size_t)2 * DM * DM, nullptr, 1.f, 0, 0);
            r -= I1K;
        } else {
            const int b = l - 2;
            CVT(FARG(18) + (size_t)b * DM * DM, DM, DM, DM, WSP(WS_WMIX), FARG(3) + l * DM, 1.f, 2, 0);
            CVT(FARG(24) + (size_t)b * DM * DM, DM, DM, DM, WSP(WS_WMIX) + (size_t)3 * DM * DM, nullptr, 1.f, 0, 0);
            if (l == 2) {
                CVT(FARG(16), DM, DM, DM, WSP(WS_WMIX) + (size_t)DM * DM, FARG(15), 1.f, 2, 0);
                CVT(FARG(17), DM, DM, DM, WSP(WS_WMIX) + (size_t)2 * DM * DM, FARG(15), 1.f, 0, 0);
            } else r -= 2 * I1K;
        }
        CVT(FARG(28) + (size_t)l * DM * DM, DM, DM, DM, WSP(WS_WOT), nullptr, 1.f, 0, 0);
        CVT(FARG(29) + (size_t)l * DM * FF, FF, DM, FF, WSP(WS_WGU), FARG(5) + l * DM, 1.f, 1, 0);
        CVT(FARG(30) + (size_t)l * DM * FF, FF, DM, FF, WSP(WS_WGU), FARG(5) + l * DM, 1.f, 1, 1);
        CVT(FARG(31) + (size_t)l * FF * DM, DM, FF, DM, WSP(WS_WD), nullptr, 1.f, 0, 0);
#undef CVT
    }
    { const float* wq = FARG(25) + (size_t)l * DM * DM; bf16_t* o = WSP(WS_WQS); const float* norm_mem = FARG(4) + l * DM;
      for (int i = gtid; i < DM * DM / 8; i += NGT) { const int k = i >> 7; const float gs = norm_mem[k] * (0.0625f * LOG2E);
          const f32x4 v0 = *(const f32x4*)(wq + (size_t)i * 8) * gs, v1 = *(const f32x4*)(wq + (size_t)i * 8 + 4) * gs;
          u32x4 w; w.x = cvt_pk_bf16(v0[0], v0[1]); w.y = cvt_pk_bf16(v0[2], v0[3]); w.z = cvt_pk_bf16(v1[0], v1[1]); w.w = cvt_pk_bf16(v1[2], v1[3]);
          *(u32x4*)(o + (size_t)i * 8) = w; } }
}

__device__ __forceinline__ void conv_phase(const bf16_t* Gin, bf16_t* CV, const float* wdw, const float* bdw, const float* lng, const float* lnb, LAS unsigned char* lds, int G, int c) {
    constexpr int CT = 16;
    const int tid = opaque_tid(), lane = tid & 63, wid = tid >> 6, ch = 2 * tid;
    LAS float* red = (LAS float*)lds;
    LAS float* st = (LAS float*)(lds + 4096);
    float w0[31], w1[31];
#pragma unroll
    for (int j = 0; j < 31; ++j) { const f32x2 w = *(const f32x2*)(wdw + j * DM + ch); w0[j] = w[0]; w1[j] = w[1]; }
    const f32x2 bd = *(const f32x2*)(bdw + ch), gg = *(const f32x2*)(lng + ch), bb = *(const f32x2*)(lnb + ch);
    for (int unit = c; unit < TR / CT; unit += G) {
        const int row0 = unit * CT, t0 = row0 & (SEQ - 1);
        unsigned v[CT + 30];
#pragma unroll
        for (int j = 0; j < CT + 30; ++j) { const bool ok = (t0 - 30 + j) >= 0; v[j] = ok ? *(const unsigned*)(Gin + (size_t)(row0 - 30 + j) * DM + ch) : 0u; }
        float u0[CT], u1[CT];
#pragma unroll
        for (int t = 0; t < CT; ++t) { float a0 = bd[0], a1 = bd[1];
#pragma unroll
            for (int j = 0; j < 31; ++j) { a0 += w0[j] * bf_lo(v[t + j]); a1 += w1[j] * bf_hi(v[t + j]); }
            u0[t] = a0; u1[t] = a1; }
#pragma unroll
        for (int t = 0; t < CT; ++t) { float s = u0[t] + u1[t], q = u0[t] * u0[t] + u1[t] * u1[t]; s = wave_sum(s); q = wave_sum(q);
            if (lane == 0) { red[(wid * CT + t) * 2] = s; red[(wid * CT + t) * 2 + 1] = q; } }
        __syncthreads();
        if (tid < CT) { float s = 0.f, q = 0.f;
#pragma unroll
            for (int w = 0; w < 8; ++w) { s += red[(w * CT + tid) * 2]; q += red[(w * CT + tid) * 2 + 1]; }
            const float mean = s * (1.0f / DM), var = q * (1.0f / DM) - mean * mean;
            st[tid * 2] = mean; st[tid * 2 + 1] = rsqrtf(fmaxf(var, 0.f) + LN_EPS); }
        __syncthreads();
#pragma unroll
        for (int t = 0; t < CT; ++t) { const float mean = st[t * 2], rstd = st[t * 2 + 1];
            float y0 = (u0[t] - mean) * rstd * gg[0] + bb[0], y1 = (u1[t] - mean) * rstd * gg[1] + bb[1];
            y0 *= fast_sigmoid(y0); y1 *= fast_sigmoid(y1);
            *(unsigned*)(CV + (size_t)(row0 + t) * DM + ch) = cvt_pk_bf16(y0, y1); }
        __syncthreads();
    }
}

__global__ void __launch_bounds__(512, 2) yoco_fwd(Args args) {
    extern __shared__ __attribute__((aligned(16))) unsigned char lds_raw[];
    LAS unsigned char* lds = (LAS unsigned char*)lds_raw;
    cg::grid_group grid = cg::this_grid();
    const int G = gridDim.x, bx = blockIdx.x;
#define THIN_IDS const int tid = opaque_tid(), lane = tid & 63, wave = __builtin_amdgcn_readfirstlane(tid >> 6); const int gw = bx * 8 + wave, NGW = G * 8, gtid = bx * 512 + tid, NGT = G * 512; LAS float* scr = (LAS float*)(lds + wave * 16640); (void)lane; (void)gw; (void)NGW; (void)gtid; (void)NGT; (void)scr;
#define XRES ((float*)ldarg(args, 32))
#define SSP  ((float*)WSP(WS_SS))
#define HB   WSP(WS_HB)

    { const int t0 = opaque_tid(); if (t0 < 4) ((LAS unsigned*)(lds + LDS_BARST))[t0] = 0u; }
    __syncthreads();
    const XcdBarrier xbar = xcd_barrier_post((unsigned*)WSP(WS_BAR), (volatile LAS unsigned*)(lds + LDS_BARST));
    const int lo = args.ph_lo, hi = args.ph_hi;
    int ph = 0;
#define PH_BEGIN if (ph >= lo && ph < hi) {
#define PH_END   if (ph + 1 < hi) { if (ph == 0) grid.sync(); else xcd_barrier(xbar); } } ++ph;

    PH_BEGIN
    {   THIN_IDS
        const float* x = FARG(0); const float* mem = FARG(1); const int* pos = (const int*)ldarg(args, 2);
        float* xres = XRES; float* ss = SSP; bf16_t* xb = WSP(WS_XB); bf16_t* memb = WSP(WS_MEMB);
        for (int m = gw; m < TR + NBATCH * NMEM; m += NGW) {
            const bool isx = m < TR; const float* src = isx ? x + (size_t)m * DM : mem + (size_t)(m - TR) * DM; bf16_t* dst = isx ? xb + (size_t)m * DM : memb + (size_t)(m - TR) * DM;
            float sq = 0.f;
#pragma unroll
            for (int j = 0; j < 4; ++j) { const f32x4 v = *((const f32x4*)src + lane + 64 * j); sq += (v[0] * v[0] + v[1] * v[1]) + (v[2] * v[2] + v[3] * v[3]);
                u32x2 w; w.x = cvt_pk_bf16(v[0], v[1]); w.y = cvt_pk_bf16(v[2], v[3]); *((u32x2*)dst + lane + 64 * j) = w;
                if (isx) *((f32x4*)(xres + (size_t)m * DM) + lane + 64 * j) = v; }
            sq = wave_sum(sq);
            if (isx && lane < 4) ss[(size_t)m * 4 + lane] = lane == 0 ? sq : 0.f;
        }
        float* cosT = (float*)WSP(WS_COS); float* sinT = (float*)WSP(WS_SIN);
        for (int i = gtid; i < TR * 8; i += NGT) { const int row = i >> 3, k = i & 7; const float inv = powf(500000.0f, -(float)(2 * k) / 16.0f); const float ang = (float)pos[row] * inv;
            cosT[i] = cosf(ang); sinT[i] = sinf(ang); }
        for (int it = gw; it < 8 * 256; it += NGW) { const int j = it >> 8, l = j >> 1, kv = j & 1;
            cvt_item(FARG(kv ? 27 : 26) + (size_t)l * DM * DM, DM, DM, DM, HB + (size_t)j * DM * DM, nullptr, 1.f, 0, 0, scr, it & 255, lane); }
        convert_layer(args, 0, scr, gw, NGW, lane, gtid, NGT);
    }
    PH_END

    PH_BEGIN
    {   pg8::Gemm g{WSP(WS_MEMB), HB, DM, DM, DM, 0, (long)NMEM * DM, (long)DM * DM, 0, 0, 4};
        pg8::Order S; S.init(1, 4, 32, G, bx);
        pg8::EpiPlain E{WSP(WS_KV), DM, (long)4 * NMEM * DM, (long)NMEM * DM, 4};
        pg8::gemm_phase(lds, g, S, E);
    }
    PH_END

    for (int l = 0; l < 4; ++l) {
        if (l > 0) { PH_BEGIN THIN_IDS convert_layer(args, l, scr, gw, NGW, lane, gtid, NGT); PH_END }
        const bool is_conv = l < 2;

        PH_BEGIN
        if (is_conv) {
            pg8::Gemm g{WSP(WS_XB), WSP(WS_WMIX), DM, DM, DM, 0, 0, 0, 0, 0, 1}; pg8::Order S; S.init(TR / 256, 8, 1, G, bx);
            pg8::EpiGated<0> E{WSP(WS_R1), DM, SSP, FARG(8) + l * 2 * DM, DM};
            pg8::gemm_phase(lds, g, S, E);
        } else {
            pg8::Gemm g{WSP(WS_XB), WSP(WS_WMIX), DM, DM, DM, 0, 0, 0, 0, 0, 1}; pg8::Order S; S.init(TR / 256, l == 2 ? 12 : 4, 1, G, bx);
            pg8::EpiQKV E{WSP(WS_R1), (size_t)(WS_KSH - WS_R1) / 2, SSP, (const float*)WSP(WS_COS), (const float*)WSP(WS_SIN)};
            pg8::gemm_phase(lds, g, S, E);
        }
        {
            pg8::Gemm g1{WSP(WS_KV) + (size_t)(l * 2 + 0) * 4 * NMEM * DM, WSP(WS_WQS), DM, DM, 256, (long)NMEM * DM, 256, 0, 256, 0, 4}; pg8::Order S1; S1.init(1, 4, 16, G, bx);
            pg8::EpiPlain E1{WSP(WS_BTS), DM, (long)DM * DM, (long)256 * DM, 4};
            pg8::gemm_phase(lds, g1, S1, E1);
            pg8::Gemm g2{WSP(WS_WOT), WSP(WS_KV) + (size_t)(l * 2 + 1) * 4 * NMEM * DM, DM, DM, 256, 0, 256, (long)NMEM * DM, 256, 0, 4}; pg8::Order S2; S2.init(4, 1, 16, G, G - 1 - bx);
            pg8::EpiPlain E2{WSP(WS_BTO), DM, (long)DM * DM, 256, 4};
            pg8::gemm_phase(lds, g2, S2, E2);
        }
        PH_END

        PH_BEGIN
        if (is_conv) {
#ifndef NO_CONV
            conv_phase(WSP(WS_R1), HB, FARG(9) + l * 31 * DM, FARG(10) + l * DM, FARG(11) + l * DM, FARG(12) + l * DM, lds, G, bx);
#endif
        } else {
#ifndef NO_ATTN
            const attn_body::bf16* qd = (const attn_body::bf16*)WSP(WS_R1); const attn_body::bf16* kd = (const attn_body::bf16*)WSP(WS_KSH); const attn_body::bf16* vd = (const attn_body::bf16*)WSP(WS_VSH);
            attn_body::bf16* od = (attn_body::bf16*)HB;
            for (int r = 0;; ++r) { const int p = (r & 1) ? (G - 1 - bx) : bx; const int idx = r * G + p; if (idx >= 2048) break;
                const int qb = 15 - (idx >> 7), j = idx & 127, b = j >> 5, h = (j >> 2) & 7, comp = (j >> 1) & 1, vh = j & 1;
                attn_body::attn_unit<8>(b, h * 128 + comp * 64, h * 128 + comp * 64, h * 128 + vh * 64, h * 128 + vh * 64, qb, qd, kd, vd, od + (size_t)comp * TR * DM, (char*)lds_raw); }
#endif
        }
        PH_END

        if (!is_conv) {
            PH_BEGIN
            THIN_IDS
            const int b = l - 2;
            const float lambda_init = 0.8f - 0.6f * expf(-0.3f * (float)l);
            const float d1 = wave_sum(FARG(19)[b * 64 + lane] * FARG(20)[b * 64 + lane]);
            const float d2 = wave_sum(FARG(21)[b * 64 + lane] * FARG(22)[b * 64 + lane]);
            const float lam = expf(d1) - expf(d2) + lambda_init;
            const float* sg = FARG(23) + b * 128 + (lane & 15) * 8;
            const f32x4 g0 = *(const f32x4*)sg * (1.0f - lambda_init), g1 = *(const f32x4*)(sg + 4) * (1.0f - lambda_init);
            const bf16_t* o0 = HB; const bf16_t* o1 = HB + (size_t)TR * DM; bf16_t* r1 = WSP(WS_R1);
            for (int i = gw * 4 + (lane >> 4); i < TR * 8; i += NGW * 4) { const size_t off = (size_t)(i >> 3) * DM + (i & 7) * 128 + (lane & 15) * 8;
                const u32x4 a = *(const u32x4*)(o0 + off), c = *(const u32x4*)(o1 + off);
                float o[8]; float sq = 0.f;
#pragma unroll
                for (int j = 0; j < 4; ++j) { o[2 * j] = bf_lo(a[j]) - lam * bf_lo(c[j]); o[2 * j + 1] = bf_hi(a[j]) - lam * bf_hi(c[j]); sq += o[2 * j] * o[2 * j] + o[2 * j + 1] * o[2 * j + 1]; }
                sq += __shfl_xor(sq, 1); sq += __shfl_xor(sq, 2); sq += __shfl_xor(sq, 4); sq += __shfl_xor(sq, 8);
                const float rs = rsqrtf(sq * (1.0f / 128.0f) + SUBLN_EPS);
                u32x4 w; w.x = cvt_pk_bf16(o[0] * rs * g0[0], o[1] * rs * g0[1]); w.y = cvt_pk_bf16(o[2] * rs * g0[2], o[3] * rs * g0[3]);
                w.z = cvt_pk_bf16(o[4] * rs * g1[0], o[5] * rs * g1[1]); w.w = cvt_pk_bf16(o[6] * rs * g1[2], o[7] * rs * g1[3]);
                *(u32x4*)(r1 + off) = w; }
            PH_END
        }

        PH_BEGIN
        {   pg8::Gemm g{is_conv ? HB : WSP(WS_R1), WSP(WS_WMIX) + (size_t)(is_conv ? 2 : 3) * DM * DM, DM, DM, DM, 0, 0, 0, 0, 0, 1}; pg8::Order S; S.init(TR / 256, 4, 1, G, bx);
            pg8::EpiResid E{XRES, XRES, WSP(WS_XB), SSP, is_conv ? FARG(14) + l * DM : nullptr};
            pg8::gemm_phase(lds, g, S, E);
        }
        PH_END

        PH_BEGIN
        {   pg8::Gemm g{WSP(WS_XB), WSP(WS_BTS), DM, DM, DM, 0, 0, 0, 0, (long)DM * DM, 1}; pg8::Order S; S.init(TR / 256, 4, 1, G, bx);
            pg8::EpiSoftmax E{WSP(WS_R1), SSP};
            pg8::gemm_phase(lds, g, S, E);
        }
        PH_END

        PH_BEGIN
        {   pg8::Gemm g{WSP(WS_R1), WSP(WS_BTO), DM, DM, DM, 0, 0, 0, 0, (long)DM * DM, 1}; pg8::Order S; S.init(TR / 256, 4, 1, G, bx);
            pg8::EpiResid E{XRES, XRES, WSP(WS_XB), SSP, nullptr};
            pg8::gemm_phase(lds, g, S, E);
        }
        PH_END

        PH_BEGIN
        {   pg8::Gemm g{WSP(WS_XB), WSP(WS_WGU), DM, DM, DM, 0, 0, 0, 0, 0, 1}; pg8::Order S; S.init(TR / 256, 2 * FF / 256, 1, G, bx);
            pg8::EpiGated<1> E{HB, FF, SSP, nullptr, 0};
            pg8::gemm_phase(lds, g, S, E);
        }
        PH_END

        PH_BEGIN
        {   pg8::Gemm g{HB, WSP(WS_WD), FF, FF, FF, 0, 0, 0, 0, 0, 1}; pg8::Order S; S.init(TR / 256, 4, 1, G, bx);
            pg8::EpiResid E{XRES, XRES, WSP(WS_XB), SSP, nullptr};
            pg8::gemm_phase(lds, g, S, E);
        }
        PH_END
    }

    PH_BEGIN
    {   THIN_IDS
        const float* gfin = FARG(6); float* xres = XRES;
        for (int m = gw; m < TR; m += NGW) { f32x4* xr = (f32x4*)(xres + (size_t)m * DM) + lane; f32x4 v[4]; float sq = 0.f;
#pragma unroll
            for (int j = 0; j < 4; ++j) { v[j] = xr[64 * j]; sq += (v[j][0] * v[j][0] + v[j][1] * v[j][1]) + (v[j][2] * v[j][2] + v[j][3] * v[j][3]); }
            const float rs = rsqrtf(wave_sum(sq) * (1.0f / DM) + RMS_EPS);
#pragma unroll
            for (int j = 0; j < 4; ++j) xr[64 * j] = v[j] * rs * *((const f32x4*)gfin + lane + 64 * j); }
    }
    PH_END
#undef PH_BEGIN
#undef PH_END
}

extern "C" void kernel_launch(void* const* d_in, const int* in_sizes, int n_in, void* d_out, int out_size, void* d_ws, size_t ws_size, hipStream_t stream) {
    static int grid = 0;
    if (grid == 0) {
        if (n_in != 32 || out_size != TR * DM || ws_size < WS_END) { fprintf(stderr, "kernel_launch: unexpected shapes (n_in %d out %d ws %zu)\n", n_in, out_size, ws_size); grid = -1; return; }
        int dev = 0, cus = 0, per_cu = 0;
        hipGetDevice(&dev); hipDeviceGetAttribute(&cus, hipDeviceAttributeMultiprocessorCount, dev);
        if (hipFuncSetAttribute((const void*)yoco_fwd, hipFuncAttributeMaxDynamicSharedMemorySize, LDS_BYTES) != hipSuccess) { fprintf(stderr, "kernel_launch: hipFuncSetAttribute failed\n"); grid = -1; return; }
        if (hipOccupancyMaxActiveBlocksPerMultiprocessor(&per_cu, (const void*)yoco_fwd, 512, LDS_BYTES) != hipSuccess || per_cu < 1) { fprintf(stderr, "kernel_launch: occupancy query gave %d\n", per_cu); per_cu = 1; (void)hipGetLastError(); }
        grid = cus * per_cu;
    }
    if (grid < 0) return;
    if (hipMemsetAsync((char*)d_ws + WS_BAR, 0, XCD_BAR_WORDS * 4, stream) != hipSuccess) { fprintf(stderr, "kernel_launch: memset failed\n"); return; }
    Args a{};
    for (int i = 0; i < 32; ++i) a.in[i] = d_in[i];
    a.in[32] = d_out; a.in[33] = d_ws;
    const int NPH = 2 + 7 + 8 + 9 + 9 + 1;
#if MK_SPLIT
    for (int p = 0; p < NPH; ++p) { a.ph_lo = p; a.ph_hi = p + 1; hipLaunchKernelGGL(yoco_fwd, dim3(grid), dim3(512), LDS_BYTES, stream, a); }
#else
    a.ph_lo = 0; a.ph_hi = NPH;
    void* kargs[] = {&a};
    hipError_t e = hipLaunchCooperativeKernel((const void*)yoco_fwd, dim3(grid), dim3(512), kargs, LDS_BYTES, stream);
    if (e != hipSuccess) fprintf(stderr, "kernel_launch: cooperative launch failed: %s (grid %d)\n", hipGetErrorString(e), grid);
#endif
}
```

```cpp
#include <hip/hip_runtime.h>
#include <hip/hip_cooperative_groups.h>
#include <hip/hip_bf16.h>
#include <cstdio>
#include <cstdint>
#include <cmath>
namespace cg = cooperative_groups;

#ifndef MK_SPLIT
#define MK_SPLIT 0
#endif

#define LAS __attribute__((address_space(3)))
typedef unsigned short bf16_t;
typedef short bf16x8 __attribute__((ext_vector_type(8)));
typedef float f32x4 __attribute__((ext_vector_type(4)));
typedef float f32x2 __attribute__((ext_vector_type(2)));
typedef unsigned u32x4 __attribute__((ext_vector_type(4)));
typedef unsigned u32x2 __attribute__((ext_vector_type(2)));

constexpr int TR = 16384, DM = 1024, FF = 2816, SEQ = 4096, NBATCH = 4, NMEM = 256;
constexpr float RMS_EPS = 1e-6f, LN_EPS = 1e-5f, SUBLN_EPS = 1e-5f;
constexpr float LOG2E = 1.4426950408889634f;
constexpr float C2 = 0.125f * LOG2E;

constexpr size_t MiB = 1u << 20;
constexpr size_t WS_SS = 0;
constexpr size_t WS_BAR = 512 * 1024;
constexpr size_t WS_COS = 1 * MiB;
constexpr size_t WS_SIN = 1 * MiB + 512 * 1024;
constexpr size_t WS_MEMB = 2 * MiB;
constexpr size_t WS_W = 4 * MiB;
constexpr size_t WS_WMIX = WS_W;
constexpr size_t WS_WQS = WS_W + 8 * MiB;
constexpr size_t WS_WOT = WS_W + 10 * MiB;
constexpr size_t WS_WGU = WS_W + 12 * MiB;
constexpr size_t WS_WD = WS_W + 24 * MiB;
constexpr size_t WS_BTS = 36 * MiB;
constexpr size_t WS_BTO = 44 * MiB;
constexpr size_t WS_KV = 52 * MiB;
constexpr size_t WS_XB = 68 * MiB;
constexpr size_t WS_R1 = 100 * MiB;
constexpr size_t WS_KSH = 132 * MiB;
constexpr size_t WS_VSH = 164 * MiB;
constexpr size_t WS_HB = 196 * MiB;
constexpr size_t WS_END = 284 * MiB;
static_assert(WS_KSH - WS_R1 == WS_VSH - WS_KSH, "q | k | v buffers equally spaced");

constexpr int LDS_STAGE = 131072, LDS_XCH = 131072, LDS_BARST = 139520, LDS_BYTES = 147456;

__device__ __forceinline__ unsigned cvt_pk_bf16(float lo, float hi) { unsigned r; asm volatile("v_cvt_pk_bf16_f32 %0, %1, %2" : "=v"(r) : "v"(lo), "v"(hi)); return r; }
__device__ __forceinline__ int opaque_tid() { int t = threadIdx.x; asm volatile("" : "+v"(t)); return t; }
__device__ __forceinline__ float bf_lo(unsigned u) { return __uint_as_float(u << 16); }
__device__ __forceinline__ float bf_hi(unsigned u) { return __uint_as_float(u & 0xffff0000u); }
__device__ __forceinline__ float wave_sum(float v) {
#pragma unroll
    for (int o = 1; o < 64; o <<= 1) v += __shfl_xor(v, o);
    return v;
}
__device__ __forceinline__ float fast_sigmoid(float x) { return __builtin_amdgcn_rcpf(1.0f + __builtin_amdgcn_exp2f(-x * LOG2E)); }
__device__ __forceinline__ float row_rs(const float* ss, int row) {
    const f32x4 a = *(const f32x4*)(ss + (size_t)row * 4);
    return rsqrtf(((a[0] + a[1]) + (a[2] + a[3])) * (1.0f / DM) + RMS_EPS);
}

namespace pg8 {
constexpr int BM = 256, BK = 64, HALF = 128, HTB = HALF * BK * 2, NXCD = 8, WGM = 8;
__host__ __device__ __forceinline__ int lds_byte(int r, int c) { const int st = (r >> 4) * 2 + (c >> 5), rr = r & 15, cc = c & 31, ob = rr * 64 + cc * 2; return st * 1024 + (ob ^ (((ob >> 9) & 1) << 5)); }
__host__ __device__ __forceinline__ void stage_rc(int b, int& R, int& C) { const int st = b / 1024, sb = b % 1024, swz = sb ^ (((sb >> 9) & 1) << 5); R = (st >> 1) * 16 + swz / 64; C = (st & 1) * 32 + (swz % 64) / 2; }
__host__ __device__ __forceinline__ int perm32(int rho) { const int n = rho >> 4, i = rho & 15; return 8 * (i >> 2) + 4 * n + (i & 3); }

struct Unit { int pm, pn, z; };
struct Gemm { const bf16_t* A; const bf16_t* Bt; int lda, ldb, K; long a_s1, a_s0, b_s1, b_s0, b_sb; int nz0; };
__device__ __forceinline__ const char* a_ptr(const Gemm& g, const Unit& u) { const int z1 = u.z / g.nz0, z0 = u.z % g.nz0; return (const char*)(g.A + z1 * g.a_s1 + z0 * g.a_s0 + (long)u.pm * BM * g.lda); }
__device__ __forceinline__ const char* b_ptr(const Gemm& g, const Unit& u) { const int z1 = u.z / g.nz0, z0 = u.z % g.nz0; return (const char*)(g.Bt + z1 * g.b_s1 + z0 * g.b_s0 + (long)(u.pm >> 4) * g.b_sb + (long)u.pn * BM * g.ldb); }

struct Order {
    int nM, nN, nz, nwg, G, c;
    __device__ void init(int nM_, int nN_, int nz_, int G_, int c_) { nM = nM_; nN = nN_; nz = nz_; nwg = nM * nN; G = G_; c = c_; }
    __device__ bool next(int i, Unit& u) const {
        const long L = (long)i * G + c; if (L >= (long)nwg * nz) return false;
        if (nz == 1) {
            int wgid = (int)L; { const int q = nwg / NXCD, r = nwg % NXCD, xcd = wgid % NXCD, off = wgid / NXCD; wgid = (xcd < r ? xcd * (q + 1) : r * (q + 1) + (xcd - r) * q) + off; }
            const int nig = WGM * nN, gid = wgid / nig, fm = gid * WGM, gsz = (nM - fm) < WGM ? (nM - fm) : WGM;
            u.pm = fm + ((wgid % nig) % gsz); u.pn = (wgid % nig) / gsz; u.z = 0;
        } else {
            const int l = (int)L; u.z = l / nwg; const int r = l % nwg; u.pm = r / nN; u.pn = r % nN;
        }
        return true;
    }
};

template <class Epi>
__device__ __forceinline__ void gemm_phase(LAS unsigned char* lds, const Gemm g, const Order& S, const Epi& E) {
    const int tid = opaque_tid(), wid = __builtin_amdgcn_readfirstlane(tid >> 6), lane = tid & 63, wr = wid >> 2, wc = wid & 3, fr = lane & 15, fq = lane >> 4;
    const int K = g.K, nt = K / BK;
    unsigned voffA[2], voffB[2];
#pragma unroll
    for (int i = 0; i < 2; ++i) { int R, C; stage_rc(tid * 16 + i * 8192, R, C); const int Rb = (R & ~31) + perm32(R & 31);
        voffA[i] = (unsigned)(R * g.lda + C) * 2u; voffB[i] = (unsigned)(Rb * g.ldb + C) * 2u; }
    const size_t kstep = (size_t)(BK * 2);
    const size_t hstepA = (size_t)HALF * g.lda * 2, hstepB = (size_t)HALF * g.ldb * 2;
    const unsigned ldsw = (unsigned)wid * 1024u;
    const int aoff = lds_byte(wr * 64 + fr, fq * 8), boff = lds_byte(wc * 32 + fr, fq * 8);
#define PG8_SA(b, h) (((b) * 2 + (h)) * HTB)
#define PG8_SB(b, h) ((4 + (b) * 2 + (h)) * HTB)
#define PG8_STAGE(bufoff, gbase, voff) do { _Pragma("unroll") for (int _i = 0; _i < 2; ++_i) \
        __builtin_amdgcn_global_load_lds((const unsigned*)((const char*)(gbase) + (voff)[_i]), (LAS unsigned*)(lds + (bufoff) + ldsw + _i * 8192), 16, 0, 0); } while (0)
#define PG8_LDA(dst, b, h) do { _Pragma("unroll") for (int m = 0; m < 4; ++m) _Pragma("unroll") for (int k = 0; k < 2; ++k) dst[m][k] = *(const LAS bf16x8*)(lds + PG8_SA(b, h) + aoff + m * 2048 + k * 1024); } while (0)
#define PG8_LDB(dst, b, h) do { _Pragma("unroll") for (int n = 0; n < 2; ++n) _Pragma("unroll") for (int k = 0; k < 2; ++k) dst[n][k] = *(const LAS bf16x8*)(lds + PG8_SB(b, h) + boff + n * 2048 + k * 1024); } while (0)
#define PG8_MMA(ai, bj, At, Bt) do { __builtin_amdgcn_s_setprio(1); _Pragma("unroll") for (int m = 0; m < 4; ++m) _Pragma("unroll") for (int n = 0; n < 2; ++n) _Pragma("unroll") for (int k = 0; k < 2; ++k) \
        acc[ai][bj][m][n] = __builtin_amdgcn_mfma_f32_16x16x32_bf16(Bt[n][k], At[m][k], acc[ai][bj][m][n], 0, 0, 0); __builtin_amdgcn_s_setprio(0); } while (0)
#define PG8_WAIT_V(n) asm volatile("s_waitcnt vmcnt(" #n ")" ::: "memory")
#define PG8_WAIT_L(n) asm volatile("s_waitcnt lgkmcnt(" #n ")" ::: "memory")
#define PG8_BAR __builtin_amdgcn_s_barrier()
#define PG8_SCHED __builtin_amdgcn_sched_barrier(0)
    Unit cur, nxt; int ui = 0;
    if (!S.next(0, cur)) return;
    f32x4 acc[2][2][4][2];
#pragma unroll
    for (int a = 0; a < 2; ++a)
#pragma unroll
        for (int b = 0; b < 2; ++b)
#pragma unroll
            for (int m = 0; m < 4; ++m)
#pragma unroll
                for (int n = 0; n < 2; ++n) acc[a][b][m][n] = (f32x4){0.f, 0.f, 0.f, 0.f};
    bf16x8 At[4][2], B0[2][2], B1[2][2];
    const char* cA = a_ptr(g, cur); const char* cB = b_ptr(g, cur);
    PG8_STAGE(PG8_SB(0, 0), cB, voffB); PG8_STAGE(PG8_SB(0, 1), cB + hstepB, voffB); PG8_STAGE(PG8_SA(0, 0), cA, voffA); PG8_STAGE(PG8_SA(0, 1), cA + hstepA, voffA);
    if (wr == 1) PG8_BAR;
    PG8_WAIT_V(2); PG8_BAR;
    PG8_STAGE(PG8_SB(1, 0), cB + kstep, voffB); PG8_STAGE(PG8_SA(1, 0), cA + kstep, voffA); PG8_STAGE(PG8_SB(1, 1), cB + hstepB + kstep, voffB);
    PG8_WAIT_V(6); PG8_BAR;
    for (;;) {
        const bool has_next = S.next(ui + 1, nxt);
        const char* nA = has_next ? a_ptr(g, nxt) : cA; const char* nB = has_next ? b_ptr(g, nxt) : cB;
        for (int t = 0; t < nt; t += 2) {
            const bool last = (t == nt - 2);
            const char* a1 = cA + (size_t)(t + 1) * kstep;
            const char* a2 = last ? nA : cA + (size_t)(t + 2) * kstep; const char* b2 = last ? nB : cB + (size_t)(t + 2) * kstep;
            const char* a3 = a2 + kstep; const char* b3 = b2 + kstep;
            PG8_LDB(B0, 0, 0); PG8_LDB(B1, 0, 1); PG8_SCHED; PG8_LDA(At, 0, 0); PG8_STAGE(PG8_SA(1, 1), a1 + hstepA, voffA);
            PG8_WAIT_V(8); PG8_WAIT_L(0); PG8_BAR; PG8_MMA(0, 0, At, B0); PG8_MMA(0, 1, At, B1); PG8_BAR; PG8_SCHED;
            PG8_LDA(At, 0, 1); PG8_STAGE(PG8_SB(0, 0), b2, voffB); PG8_STAGE(PG8_SB(0, 1), b2 + hstepB, voffB); PG8_STAGE(PG8_SA(0, 0), a2, voffA);
            PG8_WAIT_V(8); PG8_WAIT_L(0); PG8_BAR; PG8_MMA(1, 0, At, B0); PG8_MMA(1, 1, At, B1); PG8_BAR; PG8_SCHED;
            PG8_LDB(B0, 1, 0); PG8_LDB(B1, 1, 1); PG8_SCHED; PG8_LDA(At, 1, 0); PG8_STAGE(PG8_SA(0, 1), a2 + hstepA, voffA);
            PG8_WAIT_V(8); PG8_WAIT_L(0); PG8_BAR; PG8_MMA(0, 0, At, B0); PG8_MMA(0, 1, At, B1); PG8_BAR; PG8_SCHED;
            PG8_LDA(At, 1, 1); PG8_STAGE(PG8_SB(1, 0), b3, voffB); PG8_STAGE(PG8_SB(1, 1), b3 + hstepB, voffB); PG8_STAGE(PG8_SA(1, 0), a3, voffA);
            PG8_WAIT_V(8); PG8_WAIT_L(0); PG8_BAR; PG8_MMA(1, 0, At, B0); PG8_MMA(1, 1, At, B1); PG8_BAR; PG8_SCHED;
        }
        if (wr == 0) PG8_BAR;
        E(acc, cur, wr, wc, fr, fq, lds);
        if (!has_next) break;
#pragma unroll
        for (int a = 0; a < 2; ++a)
#pragma unroll
            for (int b = 0; b < 2; ++b)
#pragma unroll
                for (int m = 0; m < 4; ++m)
#pragma unroll
                    for (int n = 0; n < 2; ++n) acc[a][b][m][n] = (f32x4){0.f, 0.f, 0.f, 0.f};
        cur = nxt; cA = nA; cB = nB; ++ui;
        if (wr == 1) PG8_BAR;
    }
    PG8_WAIT_V(0);
    PG8_BAR;
#undef PG8_SA
#undef PG8_SB
#undef PG8_STAGE
#undef PG8_LDA
#undef PG8_LDB
#undef PG8_MMA
#undef PG8_WAIT_V
#undef PG8_WAIT_L
#undef PG8_BAR
#undef PG8_SCHED
}

typedef f32x4 Acc[2][2][4][2];

struct EpiPlain {
    bf16_t* O; int ldc; long c_s1, c_s0; int nz0;
    __device__ __forceinline__ void operator()(Acc& acc, const Unit& u, int wr, int wc, int fr, int fq, LAS unsigned char*) const {
        const int z1 = u.z / nz0, z0 = u.z % nz0;
        bf16_t* base = O + z1 * c_s1 + z0 * c_s0;
        const int row0 = u.pm * BM + wr * 64 + fr, col0 = u.pn * BM + wc * 32 + 8 * fq;
#pragma unroll
        for (int ai = 0; ai < 2; ++ai)
#pragma unroll
            for (int m = 0; m < 4; ++m) { bf16_t* rowp = base + (size_t)(row0 + ai * HALF + m * 16) * ldc + col0;
#pragma unroll
                for (int bj = 0; bj < 2; ++bj) { const f32x4 v0 = acc[ai][bj][m][0], v1 = acc[ai][bj][m][1];
                    u32x4 w; w.x = cvt_pk_bf16(v0[0], v0[1]); w.y = cvt_pk_bf16(v0[2], v0[3]); w.z = cvt_pk_bf16(v1[0], v1[1]); w.w = cvt_pk_bf16(v1[2], v1[3]);
                    *(u32x4*)(rowp + bj * HALF) = w; } }
    }
};

template <int MODE> struct EpiGated {
    bf16_t* O; int ldc; const float* ss; const float* bias; int bias_half;
    __device__ __forceinline__ void operator()(Acc& acc, const Unit& u, int wr, int wc, int fr, int fq, LAS unsigned char*) const {
        const int row0 = u.pm * BM + wr * 64 + fr, col0 = u.pn * HALF + wc * 32 + 8 * fq;
        f32x4 ba[2], bg[2];
#pragma unroll
        for (int n = 0; n < 2; ++n) { if (MODE == 0) { ba[n] = *(const f32x4*)(bias + col0 + 4 * n); bg[n] = *(const f32x4*)(bias + bias_half + col0 + 4 * n); } else { ba[n] = (f32x4){0.f, 0.f, 0.f, 0.f}; bg[n] = ba[n]; } }
#pragma unroll
        for (int ai = 0; ai < 2; ++ai)
#pragma unroll
            for (int m = 0; m < 4; ++m) { const int row = row0 + ai * HALF + m * 16; const float rs = row_rs(ss, row);
                float o[8];
#pragma unroll
                for (int n = 0; n < 2; ++n) { const f32x4 va = acc[ai][0][m][n] * rs + ba[n], vg = acc[ai][1][m][n] * rs + bg[n];
#pragma unroll
                    for (int j = 0; j < 4; ++j) o[4 * n + j] = (MODE == 0) ? va[j] * fast_sigmoid(vg[j]) : va[j] * fast_sigmoid(va[j]) * vg[j]; }
                u32x4 w; w.x = cvt_pk_bf16(o[0], o[1]); w.y = cvt_pk_bf16(o[2], o[3]); w.z = cvt_pk_bf16(o[4], o[5]); w.w = cvt_pk_bf16(o[6], o[7]);
                *(u32x4*)(O + (size_t)row * ldc + col0) = w; }
    }
};

struct EpiResid {
    bf16_t* xb; float* ss; const float* bias;
    __device__ __forceinline__ void operator()(Acc& acc, const Unit& u, int wr, int wc, int fr, int fq, LAS unsigned char* lds) const {
        LAS float* X = (LAS float*)(lds + LDS_XCH);
        const int row0 = u.pm * BM + wr * 64 + fr, col0 = u.pn * BM + wc * 32 + 8 * fq;
        f32x4 bv[2][2];
#pragma unroll
        for (int bj = 0; bj < 2; ++bj)
#pragma unroll
            for (int n = 0; n < 2; ++n) bv[bj][n] = bias ? *(const f32x4*)(bias + col0 + bj * HALF + 4 * n) : (f32x4){0.f, 0.f, 0.f, 0.f};
#pragma unroll
        for (int ai = 0; ai < 2; ++ai)
#pragma unroll
            for (int m = 0; m < 4; ++m) { const int row = row0 + ai * HALF + m * 16; const size_t ro = (size_t)row * DM + col0; float sq = 0.f;
#pragma unroll
                for (int bj = 0; bj < 2; ++bj) {
                    const u32x4 xin = *(const u32x4*)(xb + ro + bj * HALF);
                    const f32x4 x0 = (f32x4){bf_lo(xin.x), bf_hi(xin.x), bf_lo(xin.y), bf_hi(xin.y)}, x1 = (f32x4){bf_lo(xin.z), bf_hi(xin.z), bf_lo(xin.w), bf_hi(xin.w)};
                    const f32x4 v0 = acc[ai][bj][m][0] + bv[bj][0] + x0, v1 = acc[ai][bj][m][1] + bv[bj][1] + x1;
                    u32x4 w; w.x = cvt_pk_bf16(v0[0], v0[1]); w.y = cvt_pk_bf16(v0[2], v0[3]); w.z = cvt_pk_bf16(v1[0], v1[1]); w.w = cvt_pk_bf16(v1[2], v1[3]);
                    *(u32x4*)(xb + ro + bj * HALF) = w;
                    sq += (v0[0] * v0[0] + v0[1] * v0[1]) + (v0[2] * v0[2] + v0[3] * v0[3]) + (v1[0] * v1[0] + v1[1] * v1[1]) + (v1[2] * v1[2] + v1[3] * v1[3]); }
                sq += __shfl_xor(sq, 16); sq += __shfl_xor(sq, 32);
                if (fq == 0) X[(ai * HALF + wr * 64 + m * 16 + fr) * 4 + wc] = sq; }
        asm volatile("s_waitcnt lgkmcnt(0)" ::: "memory"); __builtin_amdgcn_s_barrier(); asm volatile("" ::: "memory");
        { const int t = opaque_tid(); if (t < 256) { const f32x4 v = *(const LAS f32x4*)(X + t * 4); ss[(size_t)(u.pm * BM + t) * 4 + u.pn] = (v[0] + v[1]) + (v[2] + v[3]); } }
    }
};

struct EpiSoftmax {
    bf16_t* P; const float* ss;
    __device__ __forceinline__ void operator()(Acc& acc, const Unit& u, int wr, int wc, int fr, int fq, LAS unsigned char* lds) const {
        LAS f32x2* X = (LAS f32x2*)(lds + LDS_XCH);
        float mloc[2][4];
#pragma unroll
        for (int ai = 0; ai < 2; ++ai)
#pragma unroll
            for (int m = 0; m < 4; ++m) { const int r = ai * HALF + wr * 64 + m * 16 + fr; const float rs = row_rs(ss, u.pm * BM + r);
                float mx = -INFINITY;
#pragma unroll
                for (int bj = 0; bj < 2; ++bj)
#pragma unroll
                    for (int n = 0; n < 2; ++n) { f32x4 v = acc[ai][bj][m][n] * rs; acc[ai][bj][m][n] = v; mx = fmaxf(mx, fmaxf(fmaxf(v[0], v[1]), fmaxf(v[2], v[3]))); }
                mx = fmaxf(mx, __shfl_xor(mx, 16)); mx = fmaxf(mx, __shfl_xor(mx, 32));
                float sum = 0.f;
#pragma unroll
                for (int bj = 0; bj < 2; ++bj)
#pragma unroll
                    for (int n = 0; n < 2; ++n) { f32x4 v = acc[ai][bj][m][n];
#pragma unroll
                        for (int j = 0; j < 4; ++j) { v[j] = __builtin_amdgcn_exp2f(v[j] - mx); sum += v[j]; }
                        acc[ai][bj][m][n] = v; }
                sum += __shfl_xor(sum, 16); sum += __shfl_xor(sum, 32);
                if (fq == 0) X[r * 4 + wc] = (f32x2){mx, sum};
                mloc[ai][m] = mx; }
        asm volatile("s_waitcnt lgkmcnt(0)" ::: "memory"); __builtin_amdgcn_s_barrier(); asm volatile("" ::: "memory");
        const int col0 = u.pn * BM + wc * 32 + 8 * fq;
#pragma unroll
        for (int ai = 0; ai < 2; ++ai)
#pragma unroll
            for (int m = 0; m < 4; ++m) { const int r = ai * HALF + wr * 64 + m * 16 + fr;
                const f32x2 a = X[r * 4 + 0], b = X[r * 4 + 1], c = X[r * 4 + 2], d = X[r * 4 + 3];
                const float M = fmaxf(fmaxf(a[0], b[0]), fmaxf(c[0], d[0]));
                const float L = a[1] * __builtin_amdgcn_exp2f(a[0] - M) + b[1] * __builtin_amdgcn_exp2f(b[0] - M) + c[1] * __builtin_amdgcn_exp2f(c[0] - M) + d[1] * __builtin_amdgcn_exp2f(d[0] - M);
                const float f = __builtin_amdgcn_exp2f(mloc[ai][m] - M) / L;
                bf16_t* rowp = P + (size_t)(u.pm * BM + r) * DM + col0;
#pragma unroll
                for (int bj = 0; bj < 2; ++bj) { const f32x4 v0 = acc[ai][bj][m][0] * f, v1 = acc[ai][bj][m][1] * f;
                    u32x4 w; w.x = cvt_pk_bf16(v0[0], v0[1]); w.y = cvt_pk_bf16(v0[2], v0[3]); w.z = cvt_pk_bf16(v1[0], v1[1]); w.w = cvt_pk_bf16(v1[2], v1[3]);
                    *(u32x4*)(rowp + bj * HALF) = w; } }
        asm volatile("s_waitcnt lgkmcnt(0)" ::: "memory"); __builtin_amdgcn_s_barrier(); asm volatile("" ::: "memory");
    }
};

struct EpiQKV {
    bf16_t* Q; size_t sel_stride; const float* ss; const float* cs; const float* sn;
    __device__ __forceinline__ void operator()(Acc& acc, const Unit& u, int wr, int wc, int fr, int fq, LAS unsigned char*) const {
        const int sel = u.pn >> 2; bf16_t* dst = Q + (size_t)sel * sel_stride;
        const float scl = sel == 0 ? C2 : 1.0f;
        const bool rot = (sel < 2) && ((wc & 1) == 0) && (fq < 2);
        const int row0 = u.pm * BM + wr * 64 + fr, col0 = (u.pn & 3) * BM + wc * 32 + 8 * fq;
#pragma unroll
        for (int ai = 0; ai < 2; ++ai)
#pragma unroll
            for (int m = 0; m < 4; ++m) { const int row = row0 + ai * HALF + m * 16; const float rs = row_rs(ss, row) * scl;
                f32x4 c4 = (f32x4){1.f, 1.f, 1.f, 1.f}, s4 = (f32x4){0.f, 0.f, 0.f, 0.f};
                if (rot) { c4 = *(const f32x4*)(cs + (size_t)row * 8 + 4 * fq); s4 = *(const f32x4*)(sn + (size_t)row * 8 + 4 * fq); }
                bf16_t* rowp = dst + (size_t)row * DM + col0;
#pragma unroll
                for (int bj = 0; bj < 2; ++bj) { const f32x4 a0 = acc[ai][bj][m][0] * rs, a1 = acc[ai][bj][m][1] * rs;
                    f32x4 v0, v1;
                    v0[0] = a0[0] * c4[0] - a0[1] * s4[0]; v0[1] = a0[0] * s4[0] + a0[1] * c4[0];
                    v0[2] = a0[2] * c4[1] - a0[3] * s4[1]; v0[3] = a0[2] * s4[1] + a0[3] * c4[1];
                    v1[0] = a1[0] * c4[2] - a1[1] * s4[2]; v1[1] = a1[0] * s4[2] + a1[1] * c4[2];
                    v1[2] = a1[2] * c4[3] - a1[3] * s4[3]; v1[3] = a1[2] * s4[3] + a1[3] * c4[3];
                    u32x4 w; w.x = cvt_pk_bf16(v0[0], v0[1]); w.y = cvt_pk_bf16(v0[2], v0[3]); w.z = cvt_pk_bf16(v1[0], v1[1]); w.w = cvt_pk_bf16(v1[2], v1[3]);
                    *(u32x4*)(rowp + bj * HALF) = w; } }
    }
};
}

namespace attn_body {
using bf16 = __hip_bfloat16;
using s16x4 = __attribute__((ext_vector_type(4))) short;
using f32x16 = __attribute__((ext_vector_type(16))) float;
constexpr int PITCH = 1024;
constexpr int NW = 8, QBLK = 32, QB = QBLK * NW, KVBLK = 64;
__device__ __forceinline__ int crow(int r, int hi) { return (r & 3) + 8 * (r >> 2) + 4 * hi; }
#define SBAR() __builtin_amdgcn_sched_barrier(0)
__device__ __forceinline__ void cmask(f32x16& p0, f32x16& p1, int jb, int qrel, int hi) {
  const float NEG = -INFINITY; int kb = 64 * jb + 4 * hi;
  #pragma unroll
  for (int r = 0; r < 16; ++r) { int kv = kb + (r & 3) + 8 * (r >> 2); if (kv > qrel) p0[r] = NEG; if (kv + 32 > qrel) p1[r] = NEG; }
}
constexpr int NSLOT = 3, SLOTB = 8192;
constexpr int LDS_K = 0, LDS_V = NSLOT * SLOTB, LDS_WS = 2 * NSLOT * SLOTB, LDS_OST = LDS_WS + NW * 64 * 4, LDS_ATT_BYTES = LDS_OST + NW * 4096;
__device__ __forceinline__ void glds16(const void* gsrc, unsigned lds_dst) { unsigned keep;
  asm volatile("s_mov_b32 %0, m0\n\ts_mov_b32 m0, %2\n\ts_nop 0\n\tglobal_load_lds_dwordx4 %1, off\n\ts_mov_b32 m0, %0" : "=&s"(keep) : "v"(gsrc), "s"(lds_dst) : "memory"); }
__device__ __forceinline__ float max3f(float a, float b, float c) { float r; asm("v_max3_f32 %0, %1, %2, %3" : "=v"(r) : "v"(a), "v"(b), "v"(c)); return r; }
__device__ __forceinline__ float max2f(float a, float b) { float r; asm("v_max_f32_e32 %0, %1, %2" : "=v"(r) : "v"(a), "v"(b)); return r; }
__device__ __forceinline__ float fadd_s(float a, float b) { float r; asm("v_add_f32_e32 %0, %1, %2" : "=v"(r) : "v"(a), "v"(b)); return r; }
__device__ __forceinline__ float fsub_s(float a, float b) { float r; asm("v_sub_f32_e32 %0, %1, %2" : "=v"(r) : "v"(a), "v"(b)); return r; }
typedef float f32x2_t __attribute__((ext_vector_type(2))); typedef __bf16 bf16x2_t __attribute__((ext_vector_type(2)));
__device__ __forceinline__ unsigned cvtpk_s(float lo, float hi) { f32x2_t v = {lo, hi}; bf16x2_t b = __builtin_convertvector(v, bf16x2_t); return __builtin_bit_cast(unsigned, b); }
#define WAIT_BAR(N) asm volatile("s_waitcnt vmcnt(" #N ") lgkmcnt(0)\n\ts_barrier" ::: "memory")

__device__ __forceinline__ void qkt(f32x16& p0, f32x16& p1, const char* Kslot, const bf16x8* qr, const f32x16& negm, int r32, int hi) {
  const char* kb = Kslot + hi * 1024 + r32 * 16;
  #pragma unroll
  for (int d0 = 0; d0 < 4; ++d0) {
    const bf16x8 b0 = *reinterpret_cast<const bf16x8*>(kb + d0 * 2048);
    const bf16x8 b1 = *reinterpret_cast<const bf16x8*>(kb + d0 * 2048 + 512);
    if (d0 == 0) { p0 = __builtin_amdgcn_mfma_f32_32x32x16_bf16(b0, qr[0], negm, 0, 0, 0); p1 = __builtin_amdgcn_mfma_f32_32x32x16_bf16(b1, qr[0], negm, 0, 0, 0); }
    else { p0 = __builtin_amdgcn_mfma_f32_32x32x16_bf16(b0, qr[d0], p0, 0, 0, 0); p1 = __builtin_amdgcn_mfma_f32_32x32x16_bf16(b1, qr[d0], p1, 0, 0, 0); } }
}
typedef __attribute__((address_space(3))) const char* lds_cptr;
typedef short v4i16_t __attribute__((ext_vector_type(4)));
__device__ __forceinline__ void kload8(bf16x8* kf, lds_cptr kp) {
  kf[0] = *(const __attribute__((address_space(3))) bf16x8*)(kp);        kf[1] = *(const __attribute__((address_space(3))) bf16x8*)(kp + 512);
  kf[2] = *(const __attribute__((address_space(3))) bf16x8*)(kp + 2048); kf[3] = *(const __attribute__((address_space(3))) bf16x8*)(kp + 2560);
  kf[4] = *(const __attribute__((address_space(3))) bf16x8*)(kp + 4096); kf[5] = *(const __attribute__((address_space(3))) bf16x8*)(kp + 4608);
  kf[6] = *(const __attribute__((address_space(3))) bf16x8*)(kp + 6144); kf[7] = *(const __attribute__((address_space(3))) bf16x8*)(kp + 6656);
}
__device__ __forceinline__ void kload2(bf16x8* kf, lds_cptr kp, int j) { kf[2 * j] = *(const __attribute__((address_space(3))) bf16x8*)(kp + j * 2048); kf[2 * j + 1] = *(const __attribute__((address_space(3))) bf16x8*)(kp + j * 2048 + 512); }
__device__ __forceinline__ s16x4 vtr(lds_cptr p) { return __builtin_bit_cast(s16x4, __builtin_amdgcn_ds_read_tr16_b64_v4i16((__attribute__((address_space(3))) v4i16_t*)p)); }
__device__ __forceinline__ float rowmax(const f32x16& p0, const f32x16& p1) {
  float a = max3f(p0[0], p0[1], p1[0]), b = max3f(p0[2], p0[3], p1[1]); a = max3f(a, p1[2], p1[3]);
  #pragma unroll
  for (int r = 4; r < 16; r += 4) { a = max3f(a, p0[r], p0[r + 1]); b = max3f(b, p0[r + 2], p0[r + 3]); a = max3f(a, p1[r], p1[r + 1]); b = max3f(b, p1[r + 2], p1[r + 3]); }
  const float m = max2f(a, b);
  auto rr = __builtin_amdgcn_permlane32_swap(__float_as_uint(m), __float_as_uint(m), false, false);
  return max2f(__uint_as_float(rr[0]), __uint_as_float(rr[1]));
}
__device__ __forceinline__ void pv(f32x16* o, int vb, bf16x8 pa0, bf16x8 pa1, bf16x8 pa2, bf16x8 pa3) {
  #pragma unroll
  for (int d0 = 0; d0 < 2; ++d0) { s16x4 lo[4], hi[4];
    #pragma unroll
    for (int ks = 0; ks < 4; ++ks) {
      asm volatile("ds_read_b64_tr_b16 %0,%1 offset:%c2" : "=&v"(lo[ks]) : "v"(vb), "i"(d0 * 4096 + ks * 1024) : "memory");
      asm volatile("ds_read_b64_tr_b16 %0,%1 offset:%c2" : "=&v"(hi[ks]) : "v"(vb), "i"(d0 * 4096 + ks * 1024 + 512) : "memory"); }
    asm volatile("s_waitcnt lgkmcnt(0)" ::: "memory"); SBAR();
    #define PK(k) (bf16x8){lo[k][0], lo[k][1], lo[k][2], lo[k][3], hi[k][0], hi[k][1], hi[k][2], hi[k][3]}
    o[d0] = __builtin_amdgcn_mfma_f32_32x32x16_bf16(pa0, PK(0), o[d0], 0, 0, 0);
    o[d0] = __builtin_amdgcn_mfma_f32_32x32x16_bf16(pa1, PK(1), o[d0], 0, 0, 0);
    o[d0] = __builtin_amdgcn_mfma_f32_32x32x16_bf16(pa2, PK(2), o[d0], 0, 0, 0);
    o[d0] = __builtin_amdgcn_mfma_f32_32x32x16_bf16(pa3, PK(3), o[d0], 0, 0, 0);
    #undef PK
  }
}

template<int THRL> __device__ __forceinline__ void attn_unit(int b, int qcol, int kcol, int vcol, int ocol, int qb, const bf16* Q, const bf16* __restrict__ K, const bf16* __restrict__ V, bf16* O, char* shm) {
  constexpr int DMP = PITCH;
  const int tid = opaque_tid(), lane = tid & 63, r32 = lane & 31, hi = lane >> 5; const int wid = __builtin_amdgcn_readfirstlane(tid >> 6);
  const long rowbase = (long)b * SEQ; const int q0 = qb * QB;
  const bf16* Qw = Q + (rowbase + q0 + wid * QBLK) * DMP + qcol;
  const bf16* Kh = K + rowbase * DMP + kcol, *Vh = V + rowbase * DMP + vcol;
  const unsigned lds0 = (unsigned)(uintptr_t)shm;
  float* wsf = (float*)(shm + LDS_WS) + wid * 64;
  const bf16* ksrc = Kh + (long)lane * DMP + wid * 8;
  const bf16* vsrc = Vh + (long)(16 * (wid & 3) + (lane >> 2)) * DMP + (wid >> 2) * 32 + (lane & 3) * 8;
  const unsigned kdst = lds0 + LDS_K + wid * 1024, vdst = lds0 + LDS_V + wid * 1024;
  #define DMA_K(t, slot) glds16(ksrc + (long)(t) * KVBLK * DMP, (unsigned)__builtin_amdgcn_readfirstlane(kdst + (slot)))
  #define DMA_V(t, slot) glds16(vsrc + (long)(t) * KVBLK * DMP, (unsigned)__builtin_amdgcn_readfirstlane(vdst + (slot)))
  const int vb0 = (int)(lds0 + LDS_V) + ((lane >> 4) & 1) * 32 + (lane & 3) * 8 + (4 * hi + ((lane & 15) >> 2)) * 64;
  const char* Kbase = shm + LDS_K; bf16x8 kf[8];
  const lds_cptr shm3 = (lds_cptr)shm; const lds_cptr kp0 = shm3 + LDS_K + hi * 1024 + r32 * 16; const lds_cptr vp0 = shm3 + LDS_V + ((lane >> 4) & 1) * 32 + (lane & 3) * 8 + (4 * hi + ((lane & 15) >> 2)) * 64;
  const int NT = (q0 + QB) / KVBLK;
  DMA_K(0, 0); DMA_V(0, 0); DMA_K(1, SLOTB);
  bf16x8 qr[4];
  #pragma unroll
  for (int d0 = 0; d0 < 4; ++d0) qr[d0] = *reinterpret_cast<const bf16x8*>(&Qw[(long)r32 * DMP + d0 * 16 + hi * 8]);
  float mhat = 0.f, l_reg = 0.f; f32x16 o[2]; o[0] = f32x16{}; o[1] = f32x16{}; f32x16 negm = f32x16{}; asm volatile("" : "+v"(negm));
  const int qrel = wid * QBLK + r32;
  #define CMASK(P0, P1, t) do { int jb_ = (t) - (NT - 4); if (jb_ >= 0) cmask(P0, P1, jb_, qrel, hi); } while (0)
  bool resc = false;
  #define START(P0, P1) do { const float rm = rowmax(P0, P1); resc = false; \
    { const float dl = rm; mhat = fadd_s(mhat, dl); \
      _Pragma("unroll") for (int r = 0; r < 16; ++r) { P0[r] = fsub_s(P0[r], dl); P1[r] = fsub_s(P1[r], dl); } \
      _Pragma("unroll") for (int r = 0; r < 16; ++r) negm[r] = -mhat; asm volatile("" : "+v"(negm)); } \
    _Pragma("unroll") for (int r = 0; r < 16; ++r) P0[r] = __builtin_amdgcn_exp2f(P0[r]); } while (0)
  #define RESC() do { if (resc) { asm volatile("s_waitcnt lgkmcnt(0)" ::: "memory"); \
      _Pragma("unroll") for (int d_ = 0; d_ < 2; ++d_) _Pragma("unroll") for (int r = 0; r < 16; ++r) o[d_][r] *= wsf[crow(r, hi)]; } } while (0)
  f32x16 pA0, pA1, pB0, pB1;
  int sl_prev = 0, sl_cur = 0, sl_next = SLOTB;
  #define ROT() do { sl_prev = sl_cur; sl_cur = sl_next; sl_next = (sl_next == (NSLOT - 1) * SLOTB) ? 0 : sl_next + SLOTB; } while (0)
  DMA_K(2, 2 * SLOTB);
  WAIT_BAR(3);
  qkt(pA0, pA1, Kbase, qr, negm, r32, hi); asm volatile("s_nop 15\n\ts_nop 7" : "+v"(pA0), "+v"(pA1)); CMASK(pA0, pA1, 0);
  START(pA0, pA1);
  _Pragma("unroll") for (int r = 0; r < 16; ++r) pA1[r] = __builtin_amdgcn_exp2f(pA1[r]);
  WAIT_BAR(0);
  DMA_K(3, 0); DMA_V(1, SLOTB);
  ROT();
  kload8(kf, kp0 + sl_cur);
  WAIT_BAR(2);
  s16x4 vlo[8], vhi[8]; u32x4 pw0, pw1, pw2, pw3;
  #define PKW(P, B) cvtpk_s(P[B], P[B + 1])
  #define PAF(k) __builtin_bit_cast(bf16x8, pw##k)
  #define VFR(i) (bf16x8){vlo[i][0], vlo[i][1], vlo[i][2], vlo[i][3], vhi[i][0], vhi[i][1], vhi[i][2], vhi[i][3]}
  #define PIN(x) asm volatile("" : "+v"(x))
  #define MX3(a, b, c) __builtin_fmaxf(__builtin_fmaxf((a), (b)), (c))
  #define GAPA(MF, A0, A1, A2, A3, W0, W1, PW) do { MF; sacc += A0; sacc += A1; sacc += A2; sacc += A3; PIN(sacc); W0; W1; PIN(PW); SBAR(); } while (0)
  #define EX(v) __builtin_amdgcn_exp2f(v)
  #define GAPB(MF, X, B) do { MF; X[B] = EX(X[B]); X[B + 1] = EX(X[B + 1]); X[B + 2] = EX(X[B + 2]); X[B + 3] = EX(X[B + 3]); PIN(X); SBAR(); } while (0)
  #define VRD(i) do { vlo[i] = vtr(vp_ + (((i) >> 2) * 4096 + ((i) & 3) * 1024)); vhi[i] = vtr(vp_ + (((i) >> 2) * 4096 + ((i) & 3) * 1024 + 512)); } while (0)
  #define KRD(G, j) do { if (G) { kload2(kf, kp0 + sl_next, j); SBAR(); } } while (0)
  #define STEP(C0, C1, P0, P1, t, GK, GV, GL) do { SBAR(); \
    const lds_cptr vp_ = vp0 + sl_prev; \
    VRD(0); SBAR(); float sacc = (P0[0] + P0[1]); \
    GAPA(C0 = __builtin_amdgcn_mfma_f32_32x32x16_bf16(kf[0], qr[0], negm, 0, 0, 0), P0[2], P0[3], P0[4], P0[5],     pw0[0] = PKW(P0, 0), pw0[1] = PKW(P0, 2), pw0); \
    VRD(4); SBAR(); GAPA(C1 = __builtin_amdgcn_mfma_f32_32x32x16_bf16(kf[1], qr[0], negm, 0, 0, 0), P0[6], P0[7], P0[8], P0[9],     pw0[2] = PKW(P0, 4), pw0[3] = PKW(P0, 6), pw0); \
    VRD(1); SBAR(); GAPA(C0 = __builtin_amdgcn_mfma_f32_32x32x16_bf16(kf[2], qr[1], C0, 0, 0, 0),   P0[10], P0[11], P0[12], P0[13], pw1[0] = PKW(P0, 8), pw1[1] = PKW(P0, 10), pw1); \
    VRD(5); SBAR(); GAPA(C1 = __builtin_amdgcn_mfma_f32_32x32x16_bf16(kf[3], qr[1], C1, 0, 0, 0),   P0[14], P0[15], P1[0], P1[1],   pw1[2] = PKW(P0, 12), pw1[3] = PKW(P0, 14), pw1); \
    VRD(2); SBAR(); GAPA(C0 = __builtin_amdgcn_mfma_f32_32x32x16_bf16(kf[4], qr[2], C0, 0, 0, 0),   P1[2], P1[3], P1[4], P1[5],     pw2[0] = PKW(P1, 0), pw2[1] = PKW(P1, 2), pw2); \
    VRD(6); SBAR(); GAPA(C1 = __builtin_amdgcn_mfma_f32_32x32x16_bf16(kf[5], qr[2], C1, 0, 0, 0),   P1[6], P1[7], P1[8], P1[9],     pw2[2] = PKW(P1, 4), pw2[3] = PKW(P1, 6), pw2); \
    VRD(3); SBAR(); GAPA(C0 = __builtin_amdgcn_mfma_f32_32x32x16_bf16(kf[6], qr[3], C0, 0, 0, 0),   P1[10], P1[11], P1[12], P1[13], pw3[0] = PKW(P1, 8), pw3[1] = PKW(P1, 10), pw3); \
    VRD(7); SBAR(); GAPA(C1 = __builtin_amdgcn_mfma_f32_32x32x16_bf16(kf[7], qr[3], C1, 0, 0, 0),   P1[14], P1[15], 0.f, 0.f,       pw3[2] = PKW(P1, 12), pw3[3] = PKW(P1, 14), pw3); \
    l_reg += sacc; \
    if (GK) { DMA_K((t) + 3, sl_cur); } if (GV) { DMA_V((t) + 1, sl_next); } \
    CMASK(C0, C1, t); \
    { float a = MX3(C0[0], C0[1], C1[0]), b = MX3(C0[2], C0[3], C1[1]); a = MX3(a, C1[2], C1[3]); \
      _Pragma("unroll") for (int r = 4; r < 16; r += 4) { a = MX3(a, C0[r], C0[r + 1]); b = MX3(b, C0[r + 2], C0[r + 3]); a = MX3(a, C1[r], C1[r + 1]); b = MX3(b, C1[r + 2], C1[r + 3]); } \
      float rm = __builtin_fmaxf(a, b); { auto rr = __builtin_amdgcn_permlane32_swap(__float_as_uint(rm), __float_as_uint(rm), false, false); rm = __builtin_fmaxf(__uint_as_float(rr[0]), __uint_as_float(rr[1])); } \
      resc = false; \
      if (__builtin_expect(__any(rm > (float)THRL), 0)) { const float dl = __builtin_fmaxf(rm, 0.f); mhat += dl; \
        _Pragma("unroll") for (int r = 0; r < 16; ++r) { C0[r] -= dl; C1[r] -= dl; } \
        _Pragma("unroll") for (int r = 0; r < 16; ++r) negm[r] = -mhat; asm volatile("" : "+v"(negm)); \
        const float f = __builtin_amdgcn_exp2f(-dl); l_reg *= f; if (hi == 0) wsf[r32] = f; resc = true; } } \
    SBAR(); \
    GAPB(o[0] = __builtin_amdgcn_mfma_f32_32x32x16_bf16(PAF(0), VFR(0), o[0], 0, 0, 0), C0, 0); \
    GAPB(o[1] = __builtin_amdgcn_mfma_f32_32x32x16_bf16(PAF(0), VFR(4), o[1], 0, 0, 0), C0, 4); \
    KRD(GL, 0); GAPB(o[0] = __builtin_amdgcn_mfma_f32_32x32x16_bf16(PAF(1), VFR(1), o[0], 0, 0, 0), C0, 8); \
    KRD(GL, 1); GAPB(o[1] = __builtin_amdgcn_mfma_f32_32x32x16_bf16(PAF(1), VFR(5), o[1], 0, 0, 0), C0, 12); \
    KRD(GL, 2); GAPB(o[0] = __builtin_amdgcn_mfma_f32_32x32x16_bf16(PAF(2), VFR(2), o[0], 0, 0, 0), C1, 0); \
    KRD(GL, 3); GAPB(o[1] = __builtin_amdgcn_mfma_f32_32x32x16_bf16(PAF(2), VFR(6), o[1], 0, 0, 0), C1, 4); \
    GAPB(o[0] = __builtin_amdgcn_mfma_f32_32x32x16_bf16(PAF(3), VFR(3), o[0], 0, 0, 0), C1, 8); \
    GAPB(o[1] = __builtin_amdgcn_mfma_f32_32x32x16_bf16(PAF(3), VFR(7), o[1], 0, 0, 0), C1, 12); \
    } while (0)
  int t = 1;
  #undef CMASK
  #define CMASK(P0, P1, t) do {} while (0)
  for (; t + 5 < NT; t += 2) {
    STEP(pB0, pB1, pA0, pA1, t, true, true, true);     WAIT_BAR(2); RESC(); ROT();
    STEP(pA0, pA1, pB0, pB1, t + 1, true, true, true); WAIT_BAR(2); RESC(); ROT();
  }
  #undef CMASK
  #define CMASK(P0, P1, t) do { int jb_ = (t) - (NT - 4); if (jb_ >= 0) cmask(P0, P1, jb_, qrel, hi); } while (0)
  #define ENDW(tt) do { if ((tt) + 3 < NT) { WAIT_BAR(2); } else if ((tt) + 2 < NT) { WAIT_BAR(1); } else { WAIT_BAR(0); } } while (0)
  for (; t + 1 < NT; t += 2) {
    STEP(pB0, pB1, pA0, pA1, t, (t + 3 < NT), (t + 1 < NT), (t + 1 < NT));         ENDW(t);     RESC(); ROT();
    STEP(pA0, pA1, pB0, pB1, t + 1, (t + 4 < NT), (t + 2 < NT), (t + 2 < NT));     ENDW(t + 1); RESC(); ROT();
  }
  STEP(pB0, pB1, pA0, pA1, NT - 1, false, false, false); RESC();
  { float sacc = pB0[0] + pB0[1]; _Pragma("unroll") for (int r = 2; r < 16; ++r) sacc += pB0[r]; _Pragma("unroll") for (int r = 0; r < 16; ++r) sacc += pB1[r]; l_reg += sacc;
    pw0 = (u32x4){PKW(pB0, 0), PKW(pB0, 2), PKW(pB0, 4), PKW(pB0, 6)}; pw1 = (u32x4){PKW(pB0, 8), PKW(pB0, 10), PKW(pB0, 12), PKW(pB0, 14)}; pw2 = (u32x4){PKW(pB1, 0), PKW(pB1, 2), PKW(pB1, 4), PKW(pB1, 6)}; pw3 = (u32x4){PKW(pB1, 8), PKW(pB1, 10), PKW(pB1, 12), PKW(pB1, 14)};
    SBAR(); pv(o, vb0 + sl_cur, PAF(0), PAF(1), PAF(2), PAF(3)); }
  #undef PKW
  #undef PAF
  #undef VFR
  #undef PIN
  #undef MX3
  #undef GAPA
  #undef GAPB
  #undef EX
  #undef VRD
  #undef KRD
  #undef STEP
  #undef ENDW
  { auto rr = __builtin_amdgcn_permlane32_swap(__float_as_uint(l_reg), __float_as_uint(l_reg), false, false); l_reg = __uint_as_float(rr[0]) + __uint_as_float(rr[1]); }
  if (hi == 0) wsf[32 + r32] = l_reg; asm volatile("s_waitcnt lgkmcnt(0)" ::: "memory");
  float rli[16];
  #pragma unroll
  for (int r = 0; r < 16; ++r) rli[r] = __builtin_amdgcn_rcpf(wsf[32 + crow(r, hi)]);
  bf16* Ow = O + (rowbase + q0 + wid * QBLK) * DMP + ocol;
  { bf16* stg = (bf16*)(shm + LDS_OST) + wid * 2048;
    #pragma unroll
    for (int r = 0; r < 16; ++r) { const int orow = crow(r, hi);
      #pragma unroll
      for (int d0 = 0; d0 < 2; ++d0) stg[orow * 64 + d0 * 32 + r32] = __float2bfloat16(o[d0][r] * rli[r]); }
    asm volatile("s_waitcnt lgkmcnt(0)" ::: "memory");
    #pragma unroll
    for (int i = 0; i < 4; ++i) { const int row = i * 8 + (lane >> 3), ch = lane & 7; const u32x4 v = *(const u32x4*)(stg + row * 64 + ch * 8); *(u32x4*)(Ow + (long)row * DMP + ch * 8) = v; } }
  asm volatile("s_waitcnt lgkmcnt(0)\n\ts_barrier" ::: "memory");
  #undef DMA_K
  #undef DMA_V
  #undef CMASK
  #undef START
  #undef RESC
  #undef ROT
}
#undef SBAR
#undef WAIT_BAR
}

#define XB_TMO      128
#define XB_XCNT(j)  (256  + 64 * (j))
#define XB_XSUB(j)  (1280 + 64 * (j))
#define XB_XGEN(j)  (2304 + 64 * (j))
#define XB_TOP      3328
#define XB_TOPGEN   3392
#define XCD_BAR_WORDS 3456
#define XB_SPIN_CAP (1u << 18)
__device__ __forceinline__ unsigned xb_ld(unsigned* p)              { return __hip_atomic_load(p, __ATOMIC_RELAXED, __HIP_MEMORY_SCOPE_AGENT); }
__device__ __forceinline__ unsigned xb_add(unsigned* p, unsigned v) { return __hip_atomic_fetch_add(p, v, __ATOMIC_RELAXED, __HIP_MEMORY_SCOPE_AGENT); }
__device__ __forceinline__ unsigned xb_xcc_id() { return (unsigned)__builtin_amdgcn_s_getreg((3 << 11) | 20) & 0xFu; }
#define XB_SPIN(cond, bar) do { unsigned _sp = 0; while (cond) { __builtin_amdgcn_s_sleep(1); \
    if ((++_sp & 255u) == 0u) { if (xb_ld(&(bar)[XB_TMO])) break; if (_sp > XB_SPIN_CAP) { atomicAdd(&(bar)[XB_TMO], 1u); break; } } } } while (0)
struct XcdBarrier { unsigned* bar; unsigned x; volatile LAS unsigned* st; };
__device__ __forceinline__ XcdBarrier xcd_barrier_post(unsigned* bar, volatile LAS unsigned* st) {
    XcdBarrier b; b.bar = bar; b.x = xb_xcc_id(); b.st = st;
    if (threadIdx.x == 0) (void)xb_add(&bar[XB_XCNT(b.x)], 1u);
    return b;
}
__device__ __forceinline__ void xcd_barrier_complete(unsigned* bar, unsigned x, unsigned& nloc, unsigned& nx) {
    const unsigned G = gridDim.x * gridDim.y * gridDim.z;
    unsigned sum, cnt, mine, sp = 0u;
    for (;;) {
        sum = 0u; cnt = 0u; mine = 0u;
#pragma unroll
        for (unsigned j = 0; j < 16; ++j) { const unsigned c = xb_ld(&bar[XB_XCNT(j)]); sum += c; cnt += (c > 0u) ? 1u : 0u; mine = (j == x) ? c : mine; }
        if (sum == G) break;
        __builtin_amdgcn_s_sleep(1);
        if ((++sp & 255u) == 0u) { if (xb_ld(&bar[XB_TMO])) break; if (sp > XB_SPIN_CAP) { atomicAdd(&bar[XB_TMO], 1u); break; } }
    }
    nloc = mine > 0u ? mine : 1u; nx = cnt > 0u ? cnt : 1u;
}
__device__ __forceinline__ void xcd_barrier(const XcdBarrier& b) {
    asm volatile("s_waitcnt vmcnt(0)" ::: "memory");
    __syncthreads();
    if (threadIdx.x == 0) {
        unsigned* bar = b.bar;
        __builtin_amdgcn_s_waitcnt(0);
        unsigned nloc = b.st[0], nx = b.st[1];
        if (nloc == 0u) { xcd_barrier_complete(bar, b.x, nloc, nx); b.st[0] = nloc; b.st[1] = nx; }
        const unsigned old = xb_add(&bar[XB_XSUB(b.x)], 1u);
        const unsigned gen = old / nloc;
        if (old + 1u == (gen + 1u) * nloc) {
            __builtin_amdgcn_fence(__ATOMIC_RELEASE, "agent");
            asm volatile("s_waitcnt vmcnt(0)" ::: "memory");
            const unsigned og = xb_add(&bar[XB_TOP], 1u);
            const unsigned tg = og / nx;
            if (og + 1u == (tg + 1u) * nx) xb_add(&bar[XB_TOPGEN], 1u);
            else XB_SPIN(xb_ld(&bar[XB_TOPGEN]) == tg, bar);
            __builtin_amdgcn_fence(__ATOMIC_ACQUIRE, "agent");
            xb_add(&bar[XB_XGEN(b.x)], 1u);
            asm volatile("s_waitcnt vmcnt(0)" ::: "memory");
        } else {
            XB_SPIN(xb_ld(&bar[XB_XGEN(b.x)]) == gen, bar);
            __builtin_amdgcn_fence(__ATOMIC_ACQUIRE, "agent");
            asm volatile("s_waitcnt vmcnt(0)" ::: "memory");
        }
    }
    __syncthreads();
}

__device__ __forceinline__ int map_row(int n, int mode, int arg) {
    if (mode == 1) return (n >> 7) * 256 + arg * 128 + (n & 127);
    if (mode == 2) { const int d = n & 63; if (d < 16) { const int dp = d < 8 ? 2 * d : 2 * (d - 8) + 1; return n - d + dp; } return n; }
    return n;
}
__device__ __forceinline__ void cvt_item(const float* W, int ldw, int K, int ncols, bf16_t* WT, const float* g, float scale, int mode, int arg, LAS float* scr, int item, int lane) {
    const int nblk = ncols / 64, kb = item / nblk, nb = item % nblk, k0 = 64 * kb, n0 = 64 * nb;
#pragma unroll 8
    for (int i = 0; i < 16; ++i) { const int kk = 4 * i + (lane >> 4); const float gs = g ? g[k0 + kk] * scale : scale;
        const f32x4 v = *(const f32x4*)(W + (size_t)(k0 + kk) * ldw + n0 + (lane & 15) * 4) * gs;
        LAS float* d = scr + kk * 65 + (lane & 15) * 4; d[0] = v[0]; d[1] = v[1]; d[2] = v[2]; d[3] = v[3]; }
    asm volatile("s_waitcnt lgkmcnt(0)" ::: "memory");
    const int c = lane & 7;
#pragma unroll
    for (int j = 0; j < 8; ++j) { const int n = (lane >> 3) + 8 * j; const LAS float* s = scr + (8 * c) * 65 + n;
        u32x4 o; o.x = cvt_pk_bf16(s[0 * 65], s[1 * 65]); o.y = cvt_pk_bf16(s[2 * 65], s[3 * 65]); o.z = cvt_pk_bf16(s[4 * 65], s[5 * 65]); o.w = cvt_pk_bf16(s[6 * 65], s[7 * 65]);
        *(u32x4*)(WT + (size_t)map_row(n0 + n, mode, arg) * K + k0 + 8 * c) = o; }
    asm volatile("s_waitcnt lgkmcnt(0)" ::: "memory");
}

struct Args { const void* in[34]; int ph_lo, ph_hi; };
__device__ __forceinline__ const void* ldarg(const Args& a, int k) { asm volatile("" : "+s"(k)); return a.in[k]; }
#define FARG(k) ((const float*)ldarg(args, k))
#define WSP(off) ((bf16_t*)((unsigned char*)ldarg(args, 33) + (off)))

__device__ __forceinline__ void convert_layer(const Args& args, int l, LAS float* scr, int gw, int NGW, int lane, int gtid, int NGT) {
    const int I1K = 16 * 16;
    const int IGU = 16 * (FF / 64), IDN = (FF / 64) * 16;
    const int total = 4 * I1K + I1K + 2 * IGU + IDN;
    for (int it = gw; it < total; it += NGW) {
        int r = it;
#define CVT(Wp, ldw, K, ncols, WTp, gp, sc, mode, arg) { const int ni = ((K) / 64) * ((ncols) / 64); if (r >= 0 && r < ni) cvt_item(Wp, ldw, K, ncols, WTp, gp, sc, mode, arg, scr, r, lane); r -= ni; }
        if (l < 2) {
            CVT(FARG(7) + (size_t)l * DM * 2 * DM, 2 * DM, DM, DM, WSP(WS_WMIX), FARG(3) + l * DM, 1.f, 1, 0);
            CVT(FARG(7) + (size_t)l * DM * 2 * DM + DM, 2 * DM, DM, DM, WSP(WS_WMIX), FARG(3) + l * DM, 1.f, 1, 1);
            CVT(FARG(13) + (size_t)l * DM * DM, DM, DM, DM, WSP(WS_WMIX) + (size_t)2 * DM * DM, nullptr, 1.f, 0, 0);
            r -= I1K;
        } else {
            const int b = l - 2;
            CVT(FARG(18) + (size_t)b * DM * DM, DM, DM, DM, WSP(WS_WMIX), FARG(3) + l * DM, 1.f, 2, 0);
            CVT(FARG(24) + (size_t)b * DM * DM, DM, DM, DM, WSP(WS_WMIX) + (size_t)3 * DM * DM, nullptr, 1.f, 0, 0);
            if (l == 2) {
                CVT(FARG(16), DM, DM, DM, WSP(WS_WMIX) + (size_t)DM * DM, FARG(15), 1.f, 2, 0);
                CVT(FARG(17), DM, DM, DM, WSP(WS_WMIX) + (size_t)2 * DM * DM, FARG(15), 1.f, 0, 0);
            } else r -= 2 * I1K;
        }
        CVT(FARG(28) + (size_t)l * DM * DM, DM, DM, DM, WSP(WS_WOT), nullptr, 1.f, 0, 0);
        CVT(FARG(29) + (size_t)l * DM * FF, FF, DM, FF, WSP(WS_WGU), FARG(5) + l * DM, 1.f, 1, 0);
        CVT(FARG(30) + (size_t)l * DM * FF, FF, DM, FF, WSP(WS_WGU), FARG(5) + l * DM, 1.f, 1, 1);
        CVT(FARG(31) + (size_t)l * FF * DM, DM, FF, DM, WSP(WS_WD), nullptr, 1.f, 0, 0);
#undef CVT
    }
    { const float* wq = FARG(25) + (size_t)l * DM * DM; bf16_t* o = WSP(WS_WQS); const float* norm_mem = FARG(4) + l * DM;
      for (int i = gtid; i < DM * DM / 8; i += NGT) { const int k = i >> 7; const float gs = norm_mem[k] * (0.0625f * LOG2E);
          const f32x4 v0 = *(const f32x4*)(wq + (size_t)i * 8) * gs, v1 = *(const f32x4*)(wq + (size_t)i * 8 + 4) * gs;
          u32x4 w; w.x = cvt_pk_bf16(v0[0], v0[1]); w.y = cvt_pk_bf16(v0[2], v0[3]); w.z = cvt_pk_bf16(v1[0], v1[1]); w.w = cvt_pk_bf16(v1[2], v1[3]);
          *(u32x4*)(o + (size_t)i * 8) = w; } }
}

__device__ __forceinline__ void conv_phase(const bf16_t* Gin, bf16_t* CV, const float* wdw, const float* bdw, const float* lng, const float* lnb, LAS unsigned char* lds, int G, int c) {
    constexpr int CT = 16;
    const int tid = opaque_tid(), lane = tid & 63, wid = tid >> 6, ch = 2 * tid;
    LAS float* red = (LAS float*)lds;
    LAS float* st = (LAS float*)(lds + 4096);
    float w0[31], w1[31];
#pragma unroll
    for (int j = 0; j < 31; ++j) { const f32x2 w = *(const f32x2*)(wdw + j * DM + ch); w0[j] = w[0]; w1[j] = w[1]; }
    const f32x2 bd = *(const f32x2*)(bdw + ch), gg = *(const f32x2*)(lng + ch), bb = *(const f32x2*)(lnb + ch);
    for (int unit = c; unit < TR / CT; unit += G) {
        const int row0 = unit * CT, t0 = row0 & (SEQ - 1);
        unsigned v[CT + 30];
#pragma unroll
        for (int j = 0; j < CT + 30; ++j) { const bool ok = (t0 - 30 + j) >= 0; v[j] = ok ? *(const unsigned*)(Gin + (size_t)(row0 - 30 + j) * DM + ch) : 0u; }
        float u0[CT], u1[CT];
#pragma unroll
        for (int t = 0; t < CT; ++t) { float a0 = bd[0], a1 = bd[1];
#pragma unroll
            for (int j = 0; j < 31; ++j) { a0 += w0[j] * bf_lo(v[t + j]); a1 += w1[j] * bf_hi(v[t + j]); }
            u0[t] = a0; u1[t] = a1; }
#pragma unroll
        for (int t = 0; t < CT; ++t) { float s = u0[t] + u1[t], q = u0[t] * u0[t] + u1[t] * u1[t]; s = wave_sum(s); q = wave_sum(q);
            if (lane == 0) { red[(wid * CT + t) * 2] = s; red[(wid * CT + t) * 2 + 1] = q; } }
        __syncthreads();
        if (tid < CT) { float s = 0.f, q = 0.f;
#pragma unroll
            for (int w = 0; w < 8; ++w) { s += red[(w * CT + tid) * 2]; q += red[(w * CT + tid) * 2 + 1]; }
            const float mean = s * (1.0f / DM), var = q * (1.0f / DM) - mean * mean;
            st[tid * 2] = mean; st[tid * 2 + 1] = rsqrtf(fmaxf(var, 0.f) + LN_EPS); }
        __syncthreads();
#pragma unroll
        for (int t = 0; t < CT; ++t) { const float mean = st[t * 2], rstd = st[t * 2 + 1];
            float y0 = (u0[t] - mean) * rstd * gg[0] + bb[0], y1 = (u1[t] - mean) * rstd * gg[1] + bb[1];
            y0 *= fast_sigmoid(y0); y1 *= fast_sigmoid(y1);
            *(unsigned*)(CV + (size_t)(row0 + t) * DM + ch) = cvt_pk_bf16(y0, y1); }
        __syncthreads();
    }
}

__global__ void __launch_bounds__(512, 2) yoco_fwd(Args args) {
    extern __shared__ __attribute__((aligned(16))) unsigned char lds_raw[];
    LAS unsigned char* lds = (LAS unsigned char*)lds_raw;
    cg::grid_group grid = cg::this_grid();
    const int G = gridDim.x, bx = blockIdx.x;
#define THIN_IDS const int tid = opaque_tid(), lane = tid & 63, wave = __builtin_amdgcn_readfirstlane(tid >> 6); const int gw = bx * 8 + wave, NGW = G * 8, gtid = bx * 512 + tid, NGT = G * 512; LAS float* scr = (LAS float*)(lds + wave * 16640); (void)lane; (void)gw; (void)NGW; (void)gtid; (void)NGT; (void)scr;
#define XRES ((float*)ldarg(args, 32))
#define SSP  ((float*)WSP(WS_SS))
#define HB   WSP(WS_HB)

    { const int t0 = opaque_tid(); if (t0 < 4) ((LAS unsigned*)(lds + LDS_BARST))[t0] = 0u; }
    __syncthreads();
    const XcdBarrier xbar = xcd_barrier_post((unsigned*)WSP(WS_BAR), (volatile LAS unsigned*)(lds + LDS_BARST));
    const int lo = args.ph_lo, hi = args.ph_hi;
    int ph = 0;
#define PH_BEGIN if (ph >= lo && ph < hi) {
#define PH_END   if (ph + 1 < hi) { if (ph == 0) grid.sync(); else xcd_barrier(xbar); } } ++ph;

    PH_BEGIN
    {   THIN_IDS
        const float* x = FARG(0); const float* mem = FARG(1); const int* pos = (const int*)ldarg(args, 2);
        float* ss = SSP; bf16_t* xb = WSP(WS_XB); bf16_t* memb = WSP(WS_MEMB);
        for (int m = gw; m < TR + NBATCH * NMEM; m += NGW) {
            const bool isx = m < TR; const float* src = isx ? x + (size_t)m * DM : mem + (size_t)(m - TR) * DM; bf16_t* dst = isx ? xb + (size_t)m * DM : memb + (size_t)(m - TR) * DM;
            float sq = 0.f;
#pragma unroll
            for (int j = 0; j < 4; ++j) { const f32x4 v = *((const f32x4*)src + lane + 64 * j); sq += (v[0] * v[0] + v[1] * v[1]) + (v[2] * v[2] + v[3] * v[3]);
                u32x2 w; w.x = cvt_pk_bf16(v[0], v[1]); w.y = cvt_pk_bf16(v[2], v[3]); *((u32x2*)dst + lane + 64 * j) = w;
            }
            sq = wave_sum(sq);
            if (isx && lane < 4) ss[(size_t)m * 4 + lane] = lane == 0 ? sq : 0.f;
        }
        float* cosT = (float*)WSP(WS_COS); float* sinT = (float*)WSP(WS_SIN);
        for (int i = gtid; i < TR * 8; i += NGT) { const int row = i >> 3, k = i & 7; const float inv = powf(500000.0f, -(float)(2 * k) / 16.0f); const float ang = (float)pos[row] * inv;
            cosT[i] = cosf(ang); sinT[i] = sinf(ang); }
        for (int it = gw; it < 8 * 256; it += NGW) { const int j = it >> 8, l = j >> 1, kv = j & 1;
            cvt_item(FARG(kv ? 27 : 26) + (size_t)l * DM * DM, DM, DM, DM, HB + (size_t)j * DM * DM, nullptr, 1.f, 0, 0, scr, it & 255, lane); }
        convert_layer(args, 0, scr, gw, NGW, lane, gtid, NGT);
    }
    PH_END

    PH_BEGIN
    {   pg8::Gemm g{WSP(WS_MEMB), HB, DM, DM, DM, 0, (long)NMEM * DM, (long)DM * DM, 0, 0, 4};
        pg8::Order S; S.init(1, 4, 32, G, bx);
        pg8::EpiPlain E{WSP(WS_KV), DM, (long)4 * NMEM * DM, (long)NMEM * DM, 4};
        pg8::gemm_phase(lds, g, S, E);
    }
    PH_END

    for (int l = 0; l < 4; ++l) {
        if (l > 0) { PH_BEGIN THIN_IDS convert_layer(args, l, scr, gw, NGW, lane, gtid, NGT); PH_END }
        const bool is_conv = l < 2;

        PH_BEGIN
        if (is_conv) {
            pg8::Gemm g{WSP(WS_XB), WSP(WS_WMIX), DM, DM, DM, 0, 0, 0, 0, 0, 1}; pg8::Order S; S.init(TR / 256, 8, 1, G, bx);
            pg8::EpiGated<0> E{WSP(WS_R1), DM, SSP, FARG(8) + l * 2 * DM, DM};
            pg8::gemm_phase(lds, g, S, E);
        } else {
            pg8::Gemm g{WSP(WS_XB), WSP(WS_WMIX), DM, DM, DM, 0, 0, 0, 0, 0, 1}; pg8::Order S; S.init(TR / 256, l == 2 ? 12 : 4, 1, G, bx);
            pg8::EpiQKV E{WSP(WS_R1), (size_t)(WS_KSH - WS_R1) / 2, SSP, (const float*)WSP(WS_COS), (const float*)WSP(WS_SIN)};
            pg8::gemm_phase(lds, g, S, E);
        }
        {
            pg8::Gemm g1{WSP(WS_KV) + (size_t)(l * 2 + 0) * 4 * NMEM * DM, WSP(WS_WQS), DM, DM, 256, (long)NMEM * DM, 256, 0, 256, 0, 4}; pg8::Order S1; S1.init(1, 4, 16, G, bx);
            pg8::EpiPlain E1{WSP(WS_BTS), DM, (long)DM * DM, (long)256 * DM, 4};
            pg8::gemm_phase(lds, g1, S1, E1);
            pg8::Gemm g2{WSP(WS_WOT), WSP(WS_KV) + (size_t)(l * 2 + 1) * 4 * NMEM * DM, DM, DM, 256, 0, 256, (long)NMEM * DM, 256, 0, 4}; pg8::Order S2; S2.init(4, 1, 16, G, G - 1 - bx);
            pg8::EpiPlain E2{WSP(WS_BTO), DM, (long)DM * DM, 256, 4};
            pg8::gemm_phase(lds, g2, S2, E2);
        }
        PH_END

        PH_BEGIN
        if (is_conv) {
#ifndef NO_CONV
            conv_phase(WSP(WS_R1), HB, FARG(9) + l * 31 * DM, FARG(10) + l * DM, FARG(11) + l * DM, FARG(12) + l * DM, lds, G, bx);
#endif
        } else {
#ifndef NO_ATTN
            const attn_body::bf16* qd = (const attn_body::bf16*)WSP(WS_R1); const attn_body::bf16* kd = (const attn_body::bf16*)WSP(WS_KSH); const attn_body::bf16* vd = (const attn_body::bf16*)WSP(WS_VSH);
            attn_body::bf16* od = (attn_body::bf16*)HB;
            for (int r = 0;; ++r) { const int p = (r & 1) ? (G - 1 - bx) : bx; const int idx = r * G + p; if (idx >= 2048) break;
                const int qb = 15 - (idx >> 7), j = idx & 127, b = j >> 5, h = (j >> 2) & 7, comp = (j >> 1) & 1, vh = j & 1;
                attn_body::attn_unit<8>(b, h * 128 + comp * 64, h * 128 + comp * 64, h * 128 + vh * 64, h * 128 + vh * 64, qb, qd, kd, vd, od + (size_t)comp * TR * DM, (char*)lds_raw); }
#endif
        }
        PH_END

        if (!is_conv) {
            PH_BEGIN
            THIN_IDS
            const int b = l - 2;
            const float lambda_init = 0.8f - 0.6f * expf(-0.3f * (float)l);
            const float d1 = wave_sum(FARG(19)[b * 64 + lane] * FARG(20)[b * 64 + lane]);
            const float d2 = wave_sum(FARG(21)[b * 64 + lane] * FARG(22)[b * 64 + lane]);
            const float lam = expf(d1) - expf(d2) + lambda_init;
            const float* sg = FARG(23) + b * 128 + (lane & 15) * 8;
            const f32x4 g0 = *(const f32x4*)sg * (1.0f - lambda_init), g1 = *(const f32x4*)(sg + 4) * (1.0f - lambda_init);
            const bf16_t* o0 = HB; const bf16_t* o1 = HB + (size_t)TR * DM; bf16_t* r1 = WSP(WS_R1);
            for (int i = gw * 4 + (lane >> 4); i < TR * 8; i += NGW * 4) { const size_t off = (size_t)(i >> 3) * DM + (i & 7) * 128 + (lane & 15) * 8;
                const u32x4 a = *(const u32x4*)(o0 + off), c = *(const u32x4*)(o1 + off);
                float o[8]; float sq = 0.f;
#pragma unroll
                for (int j = 0; j < 4; ++j) { o[2 * j] = bf_lo(a[j]) - lam * bf_lo(c[j]); o[2 * j + 1] = bf_hi(a[j]) - lam * bf_hi(c[j]); sq += o[2 * j] * o[2 * j] + o[2 * j + 1] * o[2 * j + 1]; }
                sq += __shfl_xor(sq, 1); sq += __shfl_xor(sq, 2); sq += __shfl_xor(sq, 4); sq += __shfl_xor(sq, 8);
                const float rs = rsqrtf(sq * (1.0f / 128.0f) + SUBLN_EPS);
                u32x4 w; w.x = cvt_pk_bf16(o[0] * rs * g0[0], o[1] * rs * g0[1]); w.y = cvt_pk_bf16(o[2] * rs * g0[2], o[3] * rs * g0[3]);
                w.z = cvt_pk_bf16(o[4] * rs * g1[0], o[5] * rs * g1[1]); w.w = cvt_pk_bf16(o[6] * rs * g1[2], o[7] * rs * g1[3]);
                *(u32x4*)(r1 + off) = w; }
            PH_END
        }

        PH_BEGIN
        {   pg8::Gemm g{is_conv ? HB : WSP(WS_R1), WSP(WS_WMIX) + (size_t)(is_conv ? 2 : 3) * DM * DM, DM, DM, DM, 0, 0, 0, 0, 0, 1}; pg8::Order S; S.init(TR / 256, 4, 1, G, bx);
            pg8::EpiResid E{WSP(WS_XB), SSP, is_conv ? FARG(14) + l * DM : nullptr};
            pg8::gemm_phase(lds, g, S, E);
        }
        PH_END

        PH_BEGIN
        {   pg8::Gemm g{WSP(WS_XB), WSP(WS_BTS), DM, DM, DM, 0, 0, 0, 0, (long)DM * DM, 1}; pg8::Order S; S.init(TR / 256, 4, 1, G, bx);
            pg8::EpiSoftmax E{WSP(WS_R1), SSP};
            pg8::gemm_phase(lds, g, S, E);
        }
        PH_END

        PH_BEGIN
        {   pg8::Gemm g{WSP(WS_R1), WSP(WS_BTO), DM, DM, DM, 0, 0, 0, 0, (long)DM * DM, 1}; pg8::Order S; S.init(TR / 256, 4, 1, G, bx);
            pg8::EpiResid E{WSP(WS_XB), SSP, nullptr};
            pg8::gemm_phase(lds, g, S, E);
        }
        PH_END

        PH_BEGIN
        {   pg8::Gemm g{WSP(WS_XB), WSP(WS_WGU), DM, DM, DM, 0, 0, 0, 0, 0, 1}; pg8::Order S; S.init(TR / 256, 2 * FF / 256, 1, G, bx);
            pg8::EpiGated<1> E{HB, FF, SSP, nullptr, 0};
            pg8::gemm_phase(lds, g, S, E);
        }
        PH_END

        PH_BEGIN
        {   pg8::Gemm g{HB, WSP(WS_WD), FF, FF, FF, 0, 0, 0, 0, 0, 1}; pg8::Order S; S.init(TR / 256, 4, 1, G, bx);
            pg8::EpiResid E{WSP(WS_XB), SSP, nullptr};
            pg8::gemm_phase(lds, g, S, E);
        }
        PH_END
    }

    PH_BEGIN
    {   THIN_IDS
        const float* gfin = FARG(6); float* outp = XRES; const bf16_t* xb = WSP(WS_XB);
        for (int m = gw; m < TR; m += NGW) { const u32x4 a = *((const u32x4*)(xb + (size_t)m * DM) + lane), b = *((const u32x4*)(xb + (size_t)m * DM) + 64 + lane);
            float v[16];
#pragma unroll
            for (int j = 0; j < 4; ++j) { v[2 * j] = bf_lo(a[j]); v[2 * j + 1] = bf_hi(a[j]); v[8 + 2 * j] = bf_lo(b[j]); v[8 + 2 * j + 1] = bf_hi(b[j]); }
            float sq = 0.f;
#pragma unroll
            for (int j = 0; j < 16; ++j) sq += v[j] * v[j];
            const float rs = rsqrtf(wave_sum(sq) * (1.0f / DM) + RMS_EPS);
            float* orow = outp + (size_t)m * DM;
#pragma unroll
            for (int h = 0; h < 2; ++h) { const int c0 = h * 512 + lane * 8; const f32x4 g0 = *(const f32x4*)(gfin + c0), g1 = *(const f32x4*)(gfin + c0 + 4);
                *(f32x4*)(orow + c0) = (f32x4){v[8 * h + 0] * rs * g0[0], v[8 * h + 1] * rs * g0[1], v[8 * h + 2] * rs * g0[2], v[8 * h + 3] * rs * g0[3]};
                *(f32x4*)(orow + c0 + 4) = (f32x4){v[8 * h + 4] * rs * g1[0], v[8 * h + 5] * rs * g1[1], v[8 * h + 6] * rs * g1[2], v[8 * h + 7] * rs * g1[3]}; } }
    }
    PH_END
#undef PH_BEGIN
#undef PH_END
}

extern "C" void kernel_launch(void* const* d_in, const int* in_sizes, int n_in, void* d_out, int out_size, void* d_ws, size_t ws_size, hipStream_t stream) {
    static int grid = 0;
    if (grid == 0) {
        if (n_in != 32 || out_size != TR * DM || ws_size < WS_END) { fprintf(stderr, "kernel_launch: unexpected shapes (n_in %d out %d ws %zu)\n", n_in, out_size, ws_size); grid = -1; return; }
        int dev = 0, cus = 0, per_cu = 0;
        hipGetDevice(&dev); hipDeviceGetAttribute(&cus, hipDeviceAttributeMultiprocessorCount, dev);
        if (hipFuncSetAttribute((const void*)yoco_fwd, hipFuncAttributeMaxDynamicSharedMemorySize, LDS_BYTES) != hipSuccess) { fprintf(stderr, "kernel_launch: hipFuncSetAttribute failed\n"); grid = -1; return; }
        if (hipOccupancyMaxActiveBlocksPerMultiprocessor(&per_cu, (const void*)yoco_fwd, 512, LDS_BYTES) != hipSuccess || per_cu < 1) { fprintf(stderr, "kernel_launch: occupancy query gave %d\n", per_cu); per_cu = 1; (void)hipGetLastError(); }
        grid = cus * per_cu;
    }
    if (grid < 0) return;
    if (hipMemsetAsync((char*)d_ws + WS_BAR, 0, XCD_BAR_WORDS * 4, stream) != hipSuccess) { fprintf(stderr, "kernel_launch: memset failed\n"); return; }
    Args a{};
    for (int i = 0; i < 32; ++i) a.in[i] = d_in[i];
    a.in[32] = d_out; a.in[33] = d_ws;
    const int NPH = 2 + 7 + 8 + 9 + 9 + 1;
#if MK_SPLIT
    for (int p = 0; p < NPH; ++p) { a.ph_lo = p; a.ph_hi = p + 1; hipLaunchKernelGGL(yoco_fwd, dim3(grid), dim3(512), LDS_BYTES, stream, a); }
#else
    a.ph_lo = 0; a.ph_hi = NPH;
    void* kargs[] = {&a};
    hipError_t e = hipLaunchCooperativeKernel((const void*)yoco_fwd, dim3(grid), dim3(512), kargs, LDS_BYTES, stream);
    if (e != hipSuccess) fprintf(stderr, "kernel_launch: cooperative launch failed: %s (grid %d)\n", hipGetErrorString(e), grid);
#endif
}
```

```cpp
#include <hip/hip_runtime.h>
#include <hip/hip_cooperative_groups.h>
#include <hip/hip_bf16.h>
#include <cstdio>
#include <cstdint>
#include <cmath>
namespace cg = cooperative_groups;

#define LAS __attribute__((address_space(3)))
typedef unsigned short bf16_t;
typedef short bf16x8 __attribute__((ext_vector_type(8)));
typedef float f32x4 __attribute__((ext_vector_type(4)));
typedef float f32x2 __attribute__((ext_vector_type(2)));
typedef unsigned u32x4 __attribute__((ext_vector_type(4)));
typedef unsigned u32x2 __attribute__((ext_vector_type(2)));

constexpr int TR = 16384, DM = 1024, FF = 2816, SEQ = 4096, NBATCH = 4, NMEM = 256;
constexpr float RMS_EPS = 1e-6f, LN_EPS = 1e-5f, SUBLN_EPS = 1e-5f;
constexpr float LOG2E = 1.4426950408889634f;
constexpr float C2 = 0.125f * LOG2E;

constexpr size_t MiB = 1u << 20;
constexpr size_t WS_SS = 0;
constexpr size_t WS_BAR = 512 * 1024;
constexpr size_t WS_COS = 1 * MiB;
constexpr size_t WS_SIN = 1 * MiB + 512 * 1024;
constexpr size_t WS_MEMB = 2 * MiB;
constexpr size_t WS_W = 4 * MiB;
constexpr size_t WS_WMIX = WS_W;
constexpr size_t WS_WQS = WS_W + 8 * MiB;
constexpr size_t WS_WOT = WS_W + 10 * MiB;
constexpr size_t WS_WGU = WS_W + 12 * MiB;
constexpr size_t WS_WD = WS_W + 24 * MiB;
constexpr size_t WS_BTS = 36 * MiB;
constexpr size_t WS_BTO = 44 * MiB;
constexpr size_t WS_KV = 52 * MiB;
constexpr size_t WS_XB = 68 * MiB;
constexpr size_t WS_R1 = 100 * MiB;
constexpr size_t WS_KSH = 132 * MiB;
constexpr size_t WS_VSH = 164 * MiB;
constexpr size_t WS_HB = 196 * MiB;
constexpr size_t WS_END = 284 * MiB;
static_assert(WS_KSH - WS_R1 == WS_VSH - WS_KSH, "q | k | v buffers equally spaced");

constexpr int LDS_STAGE = 131072, LDS_XCH = 131072, LDS_GTAB = 142336, LDS_BARST = 143360, LDS_BYTES = 147456;

typedef __bf16 bf16x2_hw __attribute__((ext_vector_type(2)));
__device__ __forceinline__ unsigned cvt_pk_bf16(float lo, float hi) { const f32x2 v = {lo, hi}; const bf16x2_hw b = __builtin_convertvector(v, bf16x2_hw); return __builtin_bit_cast(unsigned, b); }
__device__ __forceinline__ int opaque_tid() { int t = threadIdx.x; asm volatile("" : "+v"(t)); return t; }
typedef _Float16 f16x8 __attribute__((ext_vector_type(8)));
typedef _Float16 f16x2 __attribute__((ext_vector_type(2)));
__device__ __forceinline__ unsigned cvt_pk_f16(float lo, float hi) { const f32x2 v = {lo, hi}; const f16x2 h = __builtin_convertvector(v, f16x2); return __builtin_bit_cast(unsigned, h); }
__device__ __forceinline__ float h_lo(unsigned u) { return (float)__builtin_bit_cast(f16x2, u)[0]; }
__device__ __forceinline__ float h_hi(unsigned u) { return (float)__builtin_bit_cast(f16x2, u)[1]; }
__device__ __forceinline__ float bf_lo(unsigned u) { return __uint_as_float(u << 16); }
__device__ __forceinline__ float bf_hi(unsigned u) { return __uint_as_float(u & 0xffff0000u); }
__device__ __forceinline__ float wave_sum(float v) {
#pragma unroll
    for (int o = 1; o < 64; o <<= 1) v += __shfl_xor(v, o);
    return v;
}
__device__ __forceinline__ float fast_sigmoid(float x) { return __builtin_amdgcn_rcpf(1.0f + __builtin_amdgcn_exp2f(-x * LOG2E)); }
__device__ __forceinline__ float row_rs(const float* ss, int row) {
    const f32x4 a = *(const f32x4*)(ss + (size_t)row * 4);
    return rsqrtf(((a[0] + a[1]) + (a[2] + a[3])) * (1.0f / DM) + RMS_EPS);
}

namespace pg8 {
constexpr int BM = 256, BK = 64, HALF = 128, HTB = HALF * BK * 2, NXCD = 8, WGM = 8;
__host__ __device__ __forceinline__ int lds_byte(int r, int c) { const int st = (r >> 4) * 2 + (c >> 5), rr = r & 15, cc = c & 31, ob = rr * 64 + cc * 2; return st * 1024 + (ob ^ (((ob >> 9) & 1) << 5)); }
__host__ __device__ __forceinline__ void stage_rc(int b, int& R, int& C) { const int st = b / 1024, sb = b % 1024, swz = sb ^ (((sb >> 9) & 1) << 5); R = (st >> 1) * 16 + swz / 64; C = (st & 1) * 32 + (swz % 64) / 2; }
__host__ __device__ __forceinline__ int perm32(int rho) { const int n = rho >> 4, i = rho & 15; return 8 * (i >> 2) + 4 * n + (i & 3); }

struct Unit { int pm, pn, z; };
struct Gemm { const bf16_t* A; const bf16_t* Bt; int lda, ldb, K; long a_s1, a_s0, b_s1, b_s0, b_sb; int nz0; };
__device__ __forceinline__ const char* a_ptr(const Gemm& g, const Unit& u) { const int z1 = u.z / g.nz0, z0 = u.z % g.nz0; return (const char*)(g.A + z1 * g.a_s1 + z0 * g.a_s0 + (long)u.pm * BM * g.lda); }
__device__ __forceinline__ const char* b_ptr(const Gemm& g, const Unit& u) { const int z1 = u.z / g.nz0, z0 = u.z % g.nz0; return (const char*)(g.Bt + z1 * g.b_s1 + z0 * g.b_s0 + (long)(u.pm >> 4) * g.b_sb + (long)u.pn * BM * g.ldb); }

struct Order {
    int nM, nN, nz, nwg, G, c;
    __device__ void init(int nM_, int nN_, int nz_, int G_, int c_) { nM = nM_; nN = nN_; nz = nz_; nwg = nM * nN; G = G_; c = c_; }
    __device__ bool next(int i, Unit& u) const {
        const long L = (long)i * G + c; if (L >= (long)nwg * nz) return false;
        if (nz == 1) {
            int wgid = (int)L; { const int q = nwg / NXCD, r = nwg % NXCD, xcd = wgid % NXCD, off = wgid / NXCD; wgid = (xcd < r ? xcd * (q + 1) : r * (q + 1) + (xcd - r) * q) + off; }
            const int nig = WGM * nN, gid = wgid / nig, fm = gid * WGM, gsz = (nM - fm) < WGM ? (nM - fm) : WGM;
            u.pm = fm + ((wgid % nig) % gsz); u.pn = (wgid % nig) / gsz; u.z = 0;
        } else {
            const int l = (int)L; u.z = l / nwg; const int r = l % nwg; u.pm = r / nN; u.pn = r % nN;
        }
        return true;
    }
};

template <bool F16> __device__ __forceinline__ f32x4 mma16(bf16x8 a, bf16x8 b, f32x4 c) {
    if constexpr (F16) return __builtin_amdgcn_mfma_f32_16x16x32_f16(__builtin_bit_cast(f16x8, a), __builtin_bit_cast(f16x8, b), c, 0, 0, 0);
    else return __builtin_amdgcn_mfma_f32_16x16x32_bf16(a, b, c, 0, 0, 0);
}
template <class Epi, bool F16 = false>
__device__ __forceinline__ void gemm_phase(LAS unsigned char* lds, const Gemm g, const Order& S, const Epi& E) {
    const int tid = opaque_tid(), wid = __builtin_amdgcn_readfirstlane(tid >> 6), lane = tid & 63, wr = wid >> 2, wc = wid & 3, fr = lane & 15, fq = lane >> 4;
    const int K = g.K, nt = K / BK;
    unsigned voffA[2], voffB[2];
#pragma unroll
    for (int i = 0; i < 2; ++i) { int R, C; stage_rc(tid * 16 + i * 8192, R, C); const int Rb = (R & ~31) + perm32(R & 31);
        voffA[i] = (unsigned)(R * g.lda + C) * 2u; voffB[i] = (unsigned)(Rb * g.ldb + C) * 2u; }
    const size_t kstep = (size_t)(BK * 2);
    const size_t hstepA = (size_t)HALF * g.lda * 2, hstepB = (size_t)HALF * g.ldb * 2;
    const unsigned ldsw = (unsigned)wid * 1024u;
    const int aoff = lds_byte(wr * 64 + fr, fq * 8), boff = lds_byte(wc * 32 + fr, fq * 8);
#define PG8_SA(b, h) (((b) * 2 + (h)) * HTB)
#define PG8_SB(b, h) ((4 + (b) * 2 + (h)) * HTB)
#define PG8_STAGE(bufoff, gbase, voff) do { _Pragma("unroll") for (int _i = 0; _i < 2; ++_i) \
        __builtin_amdgcn_global_load_lds((const unsigned*)((const char*)(gbase) + (voff)[_i]), (LAS unsigned*)(lds + (bufoff) + ldsw + _i * 8192), 16, 0, 0); } while (0)
#define PG8_LDA(dst, b, h) do { _Pragma("unroll") for (int m = 0; m < 4; ++m) _Pragma("unroll") for (int k = 0; k < 2; ++k) dst[m][k] = *(const LAS bf16x8*)(lds + PG8_SA(b, h) + aoff + m * 2048 + k * 1024); } while (0)
#define PG8_LDB(dst, b, h) do { _Pragma("unroll") for (int n = 0; n < 2; ++n) _Pragma("unroll") for (int k = 0; k < 2; ++k) dst[n][k] = *(const LAS bf16x8*)(lds + PG8_SB(b, h) + boff + n * 2048 + k * 1024); } while (0)
#define PG8_MMA(ai, bj, At, Bt) do { __builtin_amdgcn_s_setprio(1); _Pragma("unroll") for (int m = 0; m < 4; ++m) _Pragma("unroll") for (int n = 0; n < 2; ++n) _Pragma("unroll") for (int k = 0; k < 2; ++k) \
        acc[ai][bj][m][n] = mma16<F16>(Bt[n][k], At[m][k], acc[ai][bj][m][n]); __builtin_amdgcn_s_setprio(0); } while (0)
#define PG8_WAIT_V(n) asm volatile("s_waitcnt vmcnt(" #n ")" ::: "memory")
#define PG8_WAIT_L(n) asm volatile("s_waitcnt lgkmcnt(" #n ")" ::: "memory")
#define PG8_BAR __builtin_amdgcn_s_barrier()
#define PG8_SCHED __builtin_amdgcn_sched_barrier(0)
    Unit cur, nxt; int ui = 0;
    if (!S.next(0, cur)) return;
    f32x4 acc[2][2][4][2];
#pragma unroll
    for (int a = 0; a < 2; ++a)
#pragma unroll
        for (int b = 0; b < 2; ++b)
#pragma unroll
            for (int m = 0; m < 4; ++m)
#pragma unroll
                for (int n = 0; n < 2; ++n) acc[a][b][m][n] = (f32x4){0.f, 0.f, 0.f, 0.f};
    bf16x8 At[4][2], B0[2][2], B1[2][2];
    const char* cA = a_ptr(g, cur); const char* cB = b_ptr(g, cur);
    PG8_STAGE(PG8_SB(0, 0), cB, voffB); PG8_STAGE(PG8_SB(0, 1), cB + hstepB, voffB); PG8_STAGE(PG8_SA(0, 0), cA, voffA); PG8_STAGE(PG8_SA(0, 1), cA + hstepA, voffA);
    if (wr == 1) PG8_BAR;
    PG8_WAIT_V(2); PG8_BAR;
    PG8_STAGE(PG8_SB(1, 0), cB + kstep, voffB); PG8_STAGE(PG8_SA(1, 0), cA + kstep, voffA); PG8_STAGE(PG8_SB(1, 1), cB + hstepB + kstep, voffB);
    PG8_WAIT_V(6); PG8_BAR;
    for (;;) {
        const bool has_next = S.next(ui + 1, nxt);
        const char* nA = has_next ? a_ptr(g, nxt) : cA; const char* nB = has_next ? b_ptr(g, nxt) : cB;
        for (int t = 0; t < nt; t += 2) {
            const bool last = (t == nt - 2);
            const char* a1 = cA + (size_t)(t + 1) * kstep;
            const char* a2 = last ? nA : cA + (size_t)(t + 2) * kstep; const char* b2 = last ? nB : cB + (size_t)(t + 2) * kstep;
            const char* a3 = a2 + kstep; const char* b3 = b2 + kstep;
            PG8_LDB(B0, 0, 0); PG8_LDB(B1, 0, 1); PG8_SCHED; PG8_LDA(At, 0, 0); PG8_STAGE(PG8_SA(1, 1), a1 + hstepA, voffA);
            PG8_WAIT_V(8); PG8_WAIT_L(0); PG8_BAR; PG8_MMA(0, 0, At, B0); PG8_MMA(0, 1, At, B1); PG8_BAR; PG8_SCHED;
            PG8_LDA(At, 0, 1); PG8_STAGE(PG8_SB(0, 0), b2, voffB); PG8_STAGE(PG8_SB(0, 1), b2 + hstepB, voffB); PG8_STAGE(PG8_SA(0, 0), a2, voffA);
            PG8_WAIT_V(8); PG8_WAIT_L(0); PG8_BAR; PG8_MMA(1, 0, At, B0); PG8_MMA(1, 1, At, B1); PG8_BAR; PG8_SCHED;
            PG8_LDB(B0, 1, 0); PG8_LDB(B1, 1, 1); PG8_SCHED; PG8_LDA(At, 1, 0); PG8_STAGE(PG8_SA(0, 1), a2 + hstepA, voffA);
            PG8_WAIT_V(8); PG8_WAIT_L(0); PG8_BAR; PG8_MMA(0, 0, At, B0); PG8_MMA(0, 1, At, B1); PG8_BAR; PG8_SCHED;
            PG8_LDA(At, 1, 1); PG8_STAGE(PG8_SB(1, 0), b3, voffB); PG8_STAGE(PG8_SB(1, 1), b3 + hstepB, voffB); PG8_STAGE(PG8_SA(1, 0), a3, voffA);
            PG8_WAIT_V(8); PG8_WAIT_L(0); PG8_BAR; PG8_MMA(1, 0, At, B0); PG8_MMA(1, 1, At, B1); PG8_BAR; PG8_SCHED;
        }
        if (wr == 0) PG8_BAR;
        E(acc, cur, wr, wc, fr, fq, lds);
        if (!has_next) break;
#pragma unroll
        for (int a = 0; a < 2; ++a)
#pragma unroll
            for (int b = 0; b < 2; ++b)
#pragma unroll
                for (int m = 0; m < 4; ++m)
#pragma unroll
                    for (int n = 0; n < 2; ++n) acc[a][b][m][n] = (f32x4){0.f, 0.f, 0.f, 0.f};
        cur = nxt; cA = nA; cB = nB; ++ui;
        if (wr == 1) PG8_BAR;
    }
    PG8_WAIT_V(0);
    PG8_BAR;
#undef PG8_SA
#undef PG8_SB
#undef PG8_STAGE
#undef PG8_LDA
#undef PG8_LDB
#undef PG8_MMA
#undef PG8_WAIT_V
#undef PG8_WAIT_L
#undef PG8_BAR
#undef PG8_SCHED
}

typedef f32x4 Acc[2][2][4][2];

struct EpiPlain {
    bf16_t* O; int ldc; long c_s1, c_s0; int nz0; int f16;
    __device__ __forceinline__ void operator()(Acc& acc, const Unit& u, int wr, int wc, int fr, int fq, LAS unsigned char*) const {
        const int z1 = u.z / nz0, z0 = u.z % nz0;
        bf16_t* base = O + z1 * c_s1 + z0 * c_s0;
        const int row0 = u.pm * BM + wr * 64 + fr, col0 = u.pn * BM + wc * 32 + 8 * fq;
#pragma unroll
        for (int ai = 0; ai < 2; ++ai)
#pragma unroll
            for (int m = 0; m < 4; ++m) { bf16_t* rowp = base + (size_t)(row0 + ai * HALF + m * 16) * ldc + col0;
#pragma unroll
                for (int bj = 0; bj < 2; ++bj) { const f32x4 v0 = acc[ai][bj][m][0], v1 = acc[ai][bj][m][1];
                    u32x4 w;
                    if (f16) { w.x = cvt_pk_f16(v0[0], v0[1]); w.y = cvt_pk_f16(v0[2], v0[3]); w.z = cvt_pk_f16(v1[0], v1[1]); w.w = cvt_pk_f16(v1[2], v1[3]); }
                    else { w.x = cvt_pk_bf16(v0[0], v0[1]); w.y = cvt_pk_bf16(v0[2], v0[3]); w.z = cvt_pk_bf16(v1[0], v1[1]); w.w = cvt_pk_bf16(v1[2], v1[3]); }
                    *(u32x4*)(rowp + bj * HALF) = w; } }
    }
};

template <int MODE> struct EpiGated {
    bf16_t* O; int ldc; const float* ss; const float* bias; int bias_half;
    __device__ __forceinline__ void operator()(Acc& acc, const Unit& u, int wr, int wc, int fr, int fq, LAS unsigned char*) const {
        const int row0 = u.pm * BM + wr * 64 + fr, col0 = u.pn * HALF + wc * 32 + 8 * fq;
        f32x4 ba[2], bg[2];
#pragma unroll
        for (int n = 0; n < 2; ++n) { if (MODE == 0) { ba[n] = *(const f32x4*)(bias + col0 + 4 * n); bg[n] = *(const f32x4*)(bias + bias_half + col0 + 4 * n); } else { ba[n] = (f32x4){0.f, 0.f, 0.f, 0.f}; bg[n] = ba[n]; } }
        float rsv[2][4];
#pragma unroll
        for (int ai = 0; ai < 2; ++ai)
#pragma unroll
            for (int m = 0; m < 4; ++m) rsv[ai][m] = row_rs(ss, row0 + ai * HALF + m * 16);
#pragma unroll
        for (int ai = 0; ai < 2; ++ai)
#pragma unroll
            for (int m = 0; m < 4; ++m) { const int row = row0 + ai * HALF + m * 16; const float rs = rsv[ai][m];
                float o[8];
                const f32x2 rs2 = (f32x2){rs, rs};
#pragma unroll
                for (int n = 0; n < 2; ++n)
#pragma unroll
                    for (int p = 0; p < 2; ++p) {
                        const f32x2 a2 = (f32x2){acc[ai][0][m][n][2 * p], acc[ai][0][m][n][2 * p + 1]}, g2 = (f32x2){acc[ai][1][m][n][2 * p], acc[ai][1][m][n][2 * p + 1]};
                        const f32x2 va = __builtin_elementwise_fma(a2, rs2, (f32x2){ba[n][2 * p], ba[n][2 * p + 1]}), vg = __builtin_elementwise_fma(g2, rs2, (f32x2){bg[n][2 * p], bg[n][2 * p + 1]});
                        const f32x2 sx = (MODE == 0 ? vg : va) * (f32x2){-LOG2E, -LOG2E};
                        f32x2 e; e[0] = __builtin_amdgcn_exp2f(sx[0]); e[1] = __builtin_amdgcn_exp2f(sx[1]);
                        const f32x2 den = e + (f32x2){1.0f, 1.0f};
                        f32x2 rc; rc[0] = __builtin_amdgcn_rcpf(den[0]); rc[1] = __builtin_amdgcn_rcpf(den[1]);
                        const f32x2 res = (MODE == 0) ? va * rc : (va * vg) * rc;
                        o[4 * n + 2 * p] = res[0]; o[4 * n + 2 * p + 1] = res[1]; }
                u32x4 w; w.x = cvt_pk_bf16(o[0], o[1]); w.y = cvt_pk_bf16(o[2], o[3]); w.z = cvt_pk_bf16(o[4], o[5]); w.w = cvt_pk_bf16(o[6], o[7]);
                *(u32x4*)(O + (size_t)row * ldc + col0) = w; }
    }
};

struct EpiResid {
    bf16_t* xb; float* ss; const float* bias;
    __device__ __forceinline__ void operator()(Acc& acc, const Unit& u, int wr, int wc, int fr, int fq, LAS unsigned char* lds) const {
        LAS float* X = (LAS float*)(lds + LDS_XCH);
        const int row0 = u.pm * BM + wr * 64 + fr, col0 = u.pn * BM + wc * 32 + 8 * fq;
        f32x4 bv[2][2];
#pragma unroll
        for (int bj = 0; bj < 2; ++bj)
#pragma unroll
            for (int n = 0; n < 2; ++n) bv[bj][n] = bias ? *(const f32x4*)(bias + col0 + bj * HALF + 4 * n) : (f32x4){0.f, 0.f, 0.f, 0.f};
#pragma unroll
        for (int ai = 0; ai < 2; ++ai) {
            u32x4 xpre[1][4][2];
#pragma unroll
            for (int m = 0; m < 4; ++m)
#pragma unroll
                for (int bj = 0; bj < 2; ++bj) xpre[0][m][bj] = *(const u32x4*)(xb + (size_t)(row0 + ai * HALF + m * 16) * DM + col0 + bj * HALF);
#pragma unroll
            for (int m = 0; m < 4; ++m) { const int row = row0 + ai * HALF + m * 16; const size_t ro = (size_t)row * DM + col0; float sq = 0.f;
#pragma unroll
                for (int bj = 0; bj < 2; ++bj) {
                    const u32x4 xin = xpre[0][m][bj];
                    const f32x4 x0 = (f32x4){h_lo(xin.x), h_hi(xin.x), h_lo(xin.y), h_hi(xin.y)}, x1 = (f32x4){h_lo(xin.z), h_hi(xin.z), h_lo(xin.w), h_hi(xin.w)};
                    const f32x4 v0 = acc[ai][bj][m][0] + bv[bj][0] + x0, v1 = acc[ai][bj][m][1] + bv[bj][1] + x1;
                    u32x4 w; w.x = cvt_pk_f16(v0[0], v0[1]); w.y = cvt_pk_f16(v0[2], v0[3]); w.z = cvt_pk_f16(v1[0], v1[1]); w.w = cvt_pk_f16(v1[2], v1[3]);
                    *(u32x4*)(xb + ro + bj * HALF) = w;
                    sq += (v0[0] * v0[0] + v0[1] * v0[1]) + (v0[2] * v0[2] + v0[3] * v0[3]) + (v1[0] * v1[0] + v1[1] * v1[1]) + (v1[2] * v1[2] + v1[3] * v1[3]); }
                sq += __shfl_xor(sq, 16); sq += __shfl_xor(sq, 32);
                if (fq == 0) X[(ai * HALF + wr * 64 + m * 16 + fr) * 4 + wc] = sq; } }
        asm volatile("s_waitcnt lgkmcnt(0)" ::: "memory"); __builtin_amdgcn_s_barrier(); asm volatile("" ::: "memory");
        { const int t = opaque_tid(); if (t < 256) { const f32x4 v = *(const LAS f32x4*)(X + t * 4); ss[(size_t)(u.pm * BM + t) * 4 + u.pn] = (v[0] + v[1]) + (v[2] + v[3]); } }
    }
};

struct EpiSoftmax {
    bf16_t* P; const float* ss;
    __device__ __forceinline__ void operator()(Acc& acc, const Unit& u, int wr, int wc, int fr, int fq, LAS unsigned char* lds) const {
        LAS f32x2* X = (LAS f32x2*)(lds + LDS_XCH);
        float mloc[2][4];
#pragma unroll
        for (int ai = 0; ai < 2; ++ai)
#pragma unroll
            for (int m = 0; m < 4; ++m) mloc[ai][m] = row_rs(ss, u.pm * BM + ai * HALF + wr * 64 + m * 16 + fr);
#pragma unroll
        for (int ai = 0; ai < 2; ++ai)
#pragma unroll
            for (int m = 0; m < 4; ++m) { const int r = ai * HALF + wr * 64 + m * 16 + fr; const float rs = mloc[ai][m];
                float mx = -INFINITY;
#pragma unroll
                for (int bj = 0; bj < 2; ++bj)
#pragma unroll
                    for (int n = 0; n < 2; ++n) { f32x4 v = acc[ai][bj][m][n] * rs; acc[ai][bj][m][n] = v; mx = fmaxf(mx, fmaxf(fmaxf(v[0], v[1]), fmaxf(v[2], v[3]))); }
                mx = fmaxf(mx, __shfl_xor(mx, 16)); mx = fmaxf(mx, __shfl_xor(mx, 32));
                float sum = 0.f;
#pragma unroll
                for (int bj = 0; bj < 2; ++bj)
#pragma unroll
                    for (int n = 0; n < 2; ++n) { f32x4 v = acc[ai][bj][m][n];
#pragma unroll
                        for (int j = 0; j < 4; ++j) { v[j] = __builtin_amdgcn_exp2f(v[j] - mx); sum += v[j]; }
                        acc[ai][bj][m][n] = v; }
                sum += __shfl_xor(sum, 16); sum += __shfl_xor(sum, 32);
                if (fq == 0) X[r * 4 + wc] = (f32x2){mx, sum};
                mloc[ai][m] = mx; }
        asm volatile("s_waitcnt lgkmcnt(0)" ::: "memory"); __builtin_amdgcn_s_barrier(); asm volatile("" ::: "memory");
        const int col0 = u.pn * BM + wc * 32 + 8 * fq;
#pragma unroll
        for (int ai = 0; ai < 2; ++ai)
#pragma unroll
            for (int m = 0; m < 4; ++m) { const int r = ai * HALF + wr * 64 + m * 16 + fr;
                const f32x2 a = X[r * 4 + 0], b = X[r * 4 + 1], c = X[r * 4 + 2], d = X[r * 4 + 3];
                const float M = fmaxf(fmaxf(a[0], b[0]), fmaxf(c[0], d[0]));
                const float L = a[1] * __builtin_amdgcn_exp2f(a[0] - M) + b[1] * __builtin_amdgcn_exp2f(b[0] - M) + c[1] * __builtin_amdgcn_exp2f(c[0] - M) + d[1] * __builtin_amdgcn_exp2f(d[0] - M);
                const float f = __builtin_amdgcn_exp2f(mloc[ai][m] - M) / L;
                bf16_t* rowp = P + (size_t)(u.pm * BM + r) * DM + col0;
#pragma unroll
                for (int bj = 0; bj < 2; ++bj) { const f32x4 v0 = acc[ai][bj][m][0] * f, v1 = acc[ai][bj][m][1] * f;
                    u32x4 w; w.x = cvt_pk_bf16(v0[0], v0[1]); w.y = cvt_pk_bf16(v0[2], v0[3]); w.z = cvt_pk_bf16(v1[0], v1[1]); w.w = cvt_pk_bf16(v1[2], v1[3]);
                    *(u32x4*)(rowp + bj * HALF) = w; } }
        asm volatile("s_waitcnt lgkmcnt(0)" ::: "memory"); __builtin_amdgcn_s_barrier(); asm volatile("" ::: "memory");
    }
};

struct EpiQKV {
    bf16_t* Q; size_t sel_stride; const float* ss; const float* cs; const float* sn;
    __device__ __forceinline__ void operator()(Acc& acc, const Unit& u, int wr, int wc, int fr, int fq, LAS unsigned char*) const {
        const int sel = u.pn >> 2; bf16_t* dst = Q + (size_t)sel * sel_stride;
        const float scl = sel == 0 ? C2 : 1.0f;
        const bool rot = (sel < 2) && ((wc & 1) == 0) && (fq < 2);
        const int row0 = u.pm * BM + wr * 64 + fr, col0 = (u.pn & 3) * BM + wc * 32 + 8 * fq;
        float rsv[2][4];
#pragma unroll
        for (int ai = 0; ai < 2; ++ai)
#pragma unroll
            for (int m = 0; m < 4; ++m) rsv[ai][m] = row_rs(ss, row0 + ai * HALF + m * 16) * scl;
#pragma unroll
        for (int ai = 0; ai < 2; ++ai) {
            f32x4 cpre[4], spre[4];
#pragma unroll
            for (int m = 0; m < 4; ++m) { cpre[m] = (f32x4){1.f, 1.f, 1.f, 1.f}; spre[m] = (f32x4){0.f, 0.f, 0.f, 0.f};
                if (rot) { const size_t ro = (size_t)(row0 + ai * HALF + m * 16) * 8 + 4 * fq; cpre[m] = *(const f32x4*)(cs + ro); spre[m] = *(const f32x4*)(sn + ro); } }
#pragma unroll
            for (int m = 0; m < 4; ++m) { const int row = row0 + ai * HALF + m * 16; const float rs = rsv[ai][m];
                const f32x4 c4 = cpre[m], s4 = spre[m];
                bf16_t* rowp = dst + (size_t)row * DM + col0;
#pragma unroll
                for (int bj = 0; bj < 2; ++bj) { const f32x4 a0 = acc[ai][bj][m][0] * rs, a1 = acc[ai][bj][m][1] * rs;
                    f32x4 v0, v1;
                    v0[0] = a0[0] * c4[0] - a0[1] * s4[0]; v0[1] = a0[0] * s4[0] + a0[1] * c4[0];
                    v0[2] = a0[2] * c4[1] - a0[3] * s4[1]; v0[3] = a0[2] * s4[1] + a0[3] * c4[1];
                    v1[0] = a1[0] * c4[2] - a1[1] * s4[2]; v1[1] = a1[0] * s4[2] + a1[1] * c4[2];
                    v1[2] = a1[2] * c4[3] - a1[3] * s4[3]; v1[3] = a1[2] * s4[3] + a1[3] * c4[3];
                    u32x4 w; w.x = cvt_pk_bf16(v0[0], v0[1]); w.y = cvt_pk_bf16(v0[2], v0[3]); w.z = cvt_pk_bf16(v1[0], v1[1]); w.w = cvt_pk_bf16(v1[2], v1[3]);
                    *(u32x4*)(rowp + bj * HALF) = w; } } }
    }
};
}

namespace attn_body {
using bf16 = __hip_bfloat16;
using s16x4 = __attribute__((ext_vector_type(4))) short;
using f32x16 = __attribute__((ext_vector_type(16))) float;
constexpr int PITCH = 1024;
constexpr int NW = 8, QBLK = 32, QB = QBLK * NW, KVBLK = 64;
__device__ __forceinline__ int crow(int r, int hi) { return (r & 3) + 8 * (r >> 2) + 4 * hi; }
#define SBAR() __builtin_amdgcn_sched_barrier(0)
__device__ __forceinline__ void cmask(f32x16& p0, f32x16& p1, int jb, int qrel, int hi) {
  const float NEG = -INFINITY; int kb = 64 * jb + 4 * hi;
  #pragma unroll
  for (int r = 0; r < 16; ++r) { int kv = kb + (r & 3) + 8 * (r >> 2); if (kv > qrel) p0[r] = NEG; if (kv + 32 > qrel) p1[r] = NEG; }
}
constexpr int NSLOT = 3, SLOTB = 8192;
constexpr int LDS_K = 0, LDS_V = NSLOT * SLOTB, LDS_WS = 2 * NSLOT * SLOTB, LDS_OST = LDS_WS + NW * 64 * 4, LDS_ATT_BYTES = LDS_OST + NW * 4096;
__device__ __forceinline__ void glds16(const void* gsrc, unsigned lds_dst) { unsigned keep;
  asm volatile("s_mov_b32 %0, m0\n\ts_mov_b32 m0, %2\n\ts_nop 0\n\tglobal_load_lds_dwordx4 %1, off\n\ts_mov_b32 m0, %0" : "=&s"(keep) : "v"(gsrc), "s"(lds_dst) : "memory"); }
__device__ __forceinline__ void glds16s(const void* sbase, unsigned voff, unsigned lds_dst) { unsigned keep;
  asm volatile("s_mov_b32 %0, m0\n\ts_mov_b32 m0, %3\n\ts_nop 0\n\tglobal_load_lds_dwordx4 %1, %2\n\ts_mov_b32 m0, %0" : "=&s"(keep) : "v"(voff), "s"(sbase), "s"(lds_dst) : "memory"); }
__device__ __forceinline__ float max3f(float a, float b, float c) { float r; asm("v_max3_f32 %0, %1, %2, %3" : "=v"(r) : "v"(a), "v"(b), "v"(c)); return r; }
__device__ __forceinline__ float max2f(float a, float b) { float r; asm("v_max_f32_e32 %0, %1, %2" : "=v"(r) : "v"(a), "v"(b)); return r; }
__device__ __forceinline__ float fadd_s(float a, float b) { float r; asm("v_add_f32_e32 %0, %1, %2" : "=v"(r) : "v"(a), "v"(b)); return r; }
__device__ __forceinline__ float fsub_s(float a, float b) { float r; asm("v_sub_f32_e32 %0, %1, %2" : "=v"(r) : "v"(a), "v"(b)); return r; }
typedef float f32x2_t __attribute__((ext_vector_type(2))); typedef __bf16 bf16x2_t __attribute__((ext_vector_type(2)));
__device__ __forceinline__ unsigned cvtpk_s(float lo, float hi) { f32x2_t v = {lo, hi}; bf16x2_t b = __builtin_convertvector(v, bf16x2_t); return __builtin_bit_cast(unsigned, b); }
#define WAIT_BAR(N) asm volatile("s_waitcnt vmcnt(" #N ") lgkmcnt(0)\n\ts_barrier" ::: "memory")

__device__ __forceinline__ void qkt(f32x16& p0, f32x16& p1, const char* Kslot, const bf16x8* qr, const f32x16& negm, int r32, int hi) {
  const char* kb = Kslot + hi * 1024 + r32 * 16;
  #pragma unroll
  for (int d0 = 0; d0 < 4; ++d0) {
    const bf16x8 b0 = *reinterpret_cast<const bf16x8*>(kb + d0 * 2048);
    const bf16x8 b1 = *reinterpret_cast<const bf16x8*>(kb + d0 * 2048 + 512);
    if (d0 == 0) { p0 = __builtin_amdgcn_mfma_f32_32x32x16_bf16(b0, qr[0], negm, 0, 0, 0); p1 = __builtin_amdgcn_mfma_f32_32x32x16_bf16(b1, qr[0], negm, 0, 0, 0); }
    else { p0 = __builtin_amdgcn_mfma_f32_32x32x16_bf16(b0, qr[d0], p0, 0, 0, 0); p1 = __builtin_amdgcn_mfma_f32_32x32x16_bf16(b1, qr[d0], p1, 0, 0, 0); } }
}
typedef __attribute__((address_space(3))) const char* lds_cptr;
typedef short v4i16_t __attribute__((ext_vector_type(4)));
__device__ __forceinline__ void kload8(bf16x8* kf, lds_cptr kp) {
  kf[0] = *(const __attribute__((address_space(3))) bf16x8*)(kp);        kf[1] = *(const __attribute__((address_space(3))) bf16x8*)(kp + 512);
  kf[2] = *(const __attribute__((address_space(3))) bf16x8*)(kp + 2048); kf[3] = *(const __attribute__((address_space(3))) bf16x8*)(kp + 2560);
  kf[4] = *(const __attribute__((address_space(3))) bf16x8*)(kp + 4096); kf[5] = *(const __attribute__((address_space(3))) bf16x8*)(kp + 4608);
  kf[6] = *(const __attribute__((address_space(3))) bf16x8*)(kp + 6144); kf[7] = *(const __attribute__((address_space(3))) bf16x8*)(kp + 6656);
}
__device__ __forceinline__ void kload2(bf16x8* kf, lds_cptr kp, int j) { kf[2 * j] = *(const __attribute__((address_space(3))) bf16x8*)(kp + j * 2048); kf[2 * j + 1] = *(const __attribute__((address_space(3))) bf16x8*)(kp + j * 2048 + 512); }
__device__ __forceinline__ s16x4 vtr(lds_cptr p) { return __builtin_bit_cast(s16x4, __builtin_amdgcn_ds_read_tr16_b64_v4i16((__attribute__((address_space(3))) v4i16_t*)p)); }
__device__ __forceinline__ float rowmax(const f32x16& p0, const f32x16& p1) {
  float a = max3f(p0[0], p0[1], p1[0]), b = max3f(p0[2], p0[3], p1[1]); a = max3f(a, p1[2], p1[3]);
  #pragma unroll
  for (int r = 4; r < 16; r += 4) { a = max3f(a, p0[r], p0[r + 1]); b = max3f(b, p0[r + 2], p0[r + 3]); a = max3f(a, p1[r], p1[r + 1]); b = max3f(b, p1[r + 2], p1[r + 3]); }
  const float m = max2f(a, b);
  auto rr = __builtin_amdgcn_permlane32_swap(__float_as_uint(m), __float_as_uint(m), false, false);
  return max2f(__uint_as_float(rr[0]), __uint_as_float(rr[1]));
}
__device__ __forceinline__ void pv(f32x16* o, int vb, bf16x8 pa0, bf16x8 pa1, bf16x8 pa2, bf16x8 pa3) {
  #pragma unroll
  for (int d0 = 0; d0 < 2; ++d0) { s16x4 lo[4], hi[4];
    #pragma unroll
    for (int ks = 0; ks < 4; ++ks) {
      asm volatile("ds_read_b64_tr_b16 %0,%1 offset:%c2" : "=&v"(lo[ks]) : "v"(vb), "i"(d0 * 4096 + ks * 1024) : "memory");
      asm volatile("ds_read_b64_tr_b16 %0,%1 offset:%c2" : "=&v"(hi[ks]) : "v"(vb), "i"(d0 * 4096 + ks * 1024 + 512) : "memory"); }
    asm volatile("s_waitcnt lgkmcnt(0)" ::: "memory"); SBAR();
    #define PK(k) (bf16x8){lo[k][0], lo[k][1], lo[k][2], lo[k][3], hi[k][0], hi[k][1], hi[k][2], hi[k][3]}
    o[d0] = __builtin_amdgcn_mfma_f32_32x32x16_bf16(pa0, PK(0), o[d0], 0, 0, 0);
    o[d0] = __builtin_amdgcn_mfma_f32_32x32x16_bf16(pa1, PK(1), o[d0], 0, 0, 0);
    o[d0] = __builtin_amdgcn_mfma_f32_32x32x16_bf16(pa2, PK(2), o[d0], 0, 0, 0);
    o[d0] = __builtin_amdgcn_mfma_f32_32x32x16_bf16(pa3, PK(3), o[d0], 0, 0, 0);
    #undef PK
  }
}

constexpr int LDS2_GTAB = 142336;
static_assert(LDS2_GTAB == LDS_GTAB, "attention gain table offset");
constexpr int LDS2_V = NSLOT * SLOTB, LDS2_WS = LDS2_V + NSLOT * 2 * SLOTB, LDS2_OST = LDS2_WS + NW * 64 * 4, LDS_ATT2_BYTES = LDS2_OST + NW * 8192;
template<int THRL, int MODE> __device__ __forceinline__ void attn_unit2(int b, int qcol, int kcol, int vcol, int ocol, int qb, const bf16* Q, const bf16* __restrict__ K, const bf16* __restrict__ V, bf16* O, char* shm) {
  constexpr int DMP = PITCH;
  const int tid = opaque_tid(), lane = tid & 63, r32 = lane & 31, hi = lane >> 5; const int wid = __builtin_amdgcn_readfirstlane(tid >> 6);
  const long rowbase = (long)b * SEQ; const int q0 = qb * QB;
  const bf16* Qw = Q + (rowbase + q0 + wid * QBLK) * DMP + qcol;
  const bf16* Kh = K + rowbase * DMP + kcol, *Vh = V + rowbase * DMP + vcol;
  const unsigned lds0 = (unsigned)(uintptr_t)shm;
  float* wsf = (float*)(shm + LDS2_WS) + wid * 64;
  const unsigned koff = (unsigned)(lane * DMP + wid * 8) * 2u;
  const unsigned voff = (unsigned)((16 * (wid & 3) + (lane >> 2)) * DMP + (wid >> 2) * 32 + (lane & 3) * 8) * 2u;
  const unsigned kdst = lds0 + LDS_K + wid * 1024, vdst = lds0 + LDS2_V + wid * 1024;
  #define DMA_K(t, slot) glds16s(Kh + (long)(t) * KVBLK * DMP, koff, (unsigned)__builtin_amdgcn_readfirstlane(kdst + (slot)))
  #define DMA_V(t, slot) do { glds16s(Vh + (long)(t) * KVBLK * DMP, voff, (unsigned)__builtin_amdgcn_readfirstlane(vdst + 2 * (slot))); \
    glds16s(Vh + (long)(t) * KVBLK * DMP + 64, voff, (unsigned)__builtin_amdgcn_readfirstlane(vdst + 2 * (slot) + 8192)); } while (0)
  const char* Kbase = shm + LDS_K; bf16x8 kf[8];
  const lds_cptr shm3 = (lds_cptr)shm; const lds_cptr kp0 = shm3 + LDS_K + hi * 1024 + r32 * 16; const lds_cptr vp0 = shm3 + LDS2_V + ((lane >> 4) & 1) * 32 + (lane & 3) * 8 + (4 * hi + ((lane & 15) >> 2)) * 64;
  const int NT = (q0 + QB) / KVBLK;
  DMA_K(0, 0); DMA_V(0, 0); DMA_K(1, SLOTB);
  bf16x8 qr[4];
  #pragma unroll
  for (int d0 = 0; d0 < 4; ++d0) qr[d0] = *reinterpret_cast<const bf16x8*>(&Qw[(long)r32 * DMP + d0 * 16 + hi * 8]);
  float mhat = 0.f, l_reg = 0.f; f32x16 o[4]; o[0] = f32x16{}; o[1] = f32x16{}; o[2] = f32x16{}; o[3] = f32x16{}; const f32x16 zc = f32x16{};
  #define CMASK(P0, P1, t) do { int jb_ = (t) - (NT - 4); if (jb_ >= 0) { const int ln_ = opaque_tid() & 63; cmask(P0, P1, jb_, wid * QBLK + (ln_ & 31), ln_ >> 5); } } while (0)
  bool resc = false;
  #define START(P0, P1) do { const float rm = rowmax(P0, P1); resc = false; \
    { const float dl = rm; mhat = fadd_s(mhat, dl); \
      _Pragma("unroll") for (int r = 0; r < 16; ++r) { P0[r] = fsub_s(P0[r], dl); P1[r] = fsub_s(P1[r], dl); } \
      } \
    _Pragma("unroll") for (int r = 0; r < 16; ++r) P0[r] = __builtin_amdgcn_exp2f(P0[r]); } while (0)
  #define RESC() do { if (resc) { asm volatile("s_waitcnt lgkmcnt(0)" ::: "memory"); \
      _Pragma("unroll") for (int d_ = 0; d_ < 4; ++d_) _Pragma("unroll") for (int r = 0; r < 16; ++r) o[d_][r] *= wsf[crow(r, hi)]; } } while (0)
  f32x16 pA0, pA1, pB0, pB1;
  int sl_prev = 0, sl_cur = 0, sl_next = SLOTB;
  #define ROT() do { sl_prev = sl_cur; sl_cur = sl_next; sl_next = (sl_next == (NSLOT - 1) * SLOTB) ? 0 : sl_next + SLOTB; } while (0)
  DMA_K(2, 2 * SLOTB);
  WAIT_BAR(3);
  qkt(pA0, pA1, Kbase, qr, zc, r32, hi); asm volatile("s_nop 15\n\ts_nop 7" : "+v"(pA0), "+v"(pA1)); CMASK(pA0, pA1, 0);
  START(pA0, pA1);
  _Pragma("unroll") for (int r = 0; r < 16; ++r) pA1[r] = __builtin_amdgcn_exp2f(pA1[r]);
  WAIT_BAR(0);
  DMA_K(3, 0); DMA_V(1, SLOTB);
  ROT();
  kload8(kf, kp0 + sl_cur);
  WAIT_BAR(3);
  s16x4 vlo[8], vhi[8]; u32x4 pw0, pw1, pw2, pw3;
  #define PKW(P, B) cvtpk_s(P[B], P[B + 1])
  #define PAF(k) __builtin_bit_cast(bf16x8, pw##k)
  #define VFR(i) (bf16x8){vlo[i][0], vlo[i][1], vlo[i][2], vlo[i][3], vhi[i][0], vhi[i][1], vhi[i][2], vhi[i][3]}
  #define PIN(x) asm volatile("" : "+v"(x))
  #define MX3(a, b, c) __builtin_fmaxf(__builtin_fmaxf((a), (b)), (c))
  #define GAPA(MF, A0, A1, A2, A3, W0, W1, PW) do { MF; sacc += A0; sacc += A1; sacc += A2; sacc += A3; PIN(sacc); W0; W1; PIN(PW); SBAR(); } while (0)
  #define EX(v) __builtin_amdgcn_exp2f(v)
  #define GAPB(MF, X, B) do { MF; X[B] = EX(X[B]); X[B + 1] = EX(X[B + 1]); PIN(X); SBAR(); } while (0)
  #define VRD(i) do { vlo[i] = vtr(vp_ + (((i) >> 2) * 4096 + ((i) & 3) * 1024)); vhi[i] = vtr(vp_ + (((i) >> 2) * 4096 + ((i) & 3) * 1024 + 512)); } while (0)
  #define VRD2(i) do { vlo[i] = vtr(vp_ + (8192 + ((i) >> 2) * 4096 + ((i) & 3) * 1024)); vhi[i] = vtr(vp_ + (8192 + ((i) >> 2) * 4096 + ((i) & 3) * 1024 + 512)); SBAR(); } while (0)
  #define KRD(G, j) do { if (G) { kload2(kf, kp0 + sl_next, j); SBAR(); } } while (0)
  #define STEP(C0, C1, P0, P1, t, GK, GV, GL) do { SBAR(); \
    const lds_cptr vp_ = vp0 + 2 * sl_prev; \
    VRD(0); SBAR(); float sacc = (P0[0] + P0[1]); \
    GAPA(C0 = __builtin_amdgcn_mfma_f32_32x32x16_bf16(kf[0], qr[0], zc, 0, 0, 0), P0[2], P0[3], P0[4], P0[5],     pw0[0] = PKW(P0, 0), pw0[1] = PKW(P0, 2), pw0); \
    VRD(4); SBAR(); GAPA(C1 = __builtin_amdgcn_mfma_f32_32x32x16_bf16(kf[1], qr[0], zc, 0, 0, 0), P0[6], P0[7], P0[8], P0[9],     pw0[2] = PKW(P0, 4), pw0[3] = PKW(P0, 6), pw0); \
    VRD(1); SBAR(); GAPA(C0 = __builtin_amdgcn_mfma_f32_32x32x16_bf16(kf[2], qr[1], C0, 0, 0, 0),   P0[10], P0[11], P0[12], P0[13], pw1[0] = PKW(P0, 8), pw1[1] = PKW(P0, 10), pw1); \
    VRD(5); SBAR(); GAPA(C1 = __builtin_amdgcn_mfma_f32_32x32x16_bf16(kf[3], qr[1], C1, 0, 0, 0),   P0[14], P0[15], P1[0], P1[1],   pw1[2] = PKW(P0, 12), pw1[3] = PKW(P0, 14), pw1); \
    VRD(2); SBAR(); GAPA(C0 = __builtin_amdgcn_mfma_f32_32x32x16_bf16(kf[4], qr[2], C0, 0, 0, 0),   P1[2], P1[3], P1[4], P1[5],     pw2[0] = PKW(P1, 0), pw2[1] = PKW(P1, 2), pw2); \
    VRD(6); SBAR(); GAPA(C1 = __builtin_amdgcn_mfma_f32_32x32x16_bf16(kf[5], qr[2], C1, 0, 0, 0),   P1[6], P1[7], P1[8], P1[9],     pw2[2] = PKW(P1, 4), pw2[3] = PKW(P1, 6), pw2); \
    VRD(3); SBAR(); GAPA(C0 = __builtin_amdgcn_mfma_f32_32x32x16_bf16(kf[6], qr[3], C0, 0, 0, 0),   P1[10], P1[11], P1[12], P1[13], pw3[0] = PKW(P1, 8), pw3[1] = PKW(P1, 10), pw3); \
    VRD(7); SBAR(); GAPA(C1 = __builtin_amdgcn_mfma_f32_32x32x16_bf16(kf[7], qr[3], C1, 0, 0, 0),   P1[14], P1[15], 0.f, 0.f,       pw3[2] = PKW(P1, 12), pw3[3] = PKW(P1, 14), pw3); \
    l_reg += sacc; \
    _Pragma("unroll") for (int r = 0; r < 16; ++r) { C0[r] -= mhat; C1[r] -= mhat; } \
    if (GK) { DMA_K((t) + 3, sl_cur); } if (GV) { DMA_V((t) + 1, sl_next); } \
    CMASK(C0, C1, t); \
    { float a = MX3(C0[0], C0[1], C1[0]), b = MX3(C0[2], C0[3], C1[1]); a = MX3(a, C1[2], C1[3]); \
      _Pragma("unroll") for (int r = 4; r < 16; r += 4) { a = MX3(a, C0[r], C0[r + 1]); b = MX3(b, C0[r + 2], C0[r + 3]); a = MX3(a, C1[r], C1[r + 1]); b = MX3(b, C1[r + 2], C1[r + 3]); } \
      float rm = __builtin_fmaxf(a, b); { auto rr = __builtin_amdgcn_permlane32_swap(__float_as_uint(rm), __float_as_uint(rm), false, false); rm = __builtin_fmaxf(__uint_as_float(rr[0]), __uint_as_float(rr[1])); } \
      resc = false; \
      if (__builtin_expect(__any(rm > (float)THRL), 0)) { const float dl = __builtin_fmaxf(rm, 0.f); mhat += dl; \
        _Pragma("unroll") for (int r = 0; r < 16; ++r) { C0[r] -= dl; C1[r] -= dl; } \
        const float f = __builtin_amdgcn_exp2f(-dl); l_reg *= f; if (hi == 0) wsf[r32] = f; resc = true; } } \
    SBAR(); \
    GAPB(o[0] = __builtin_amdgcn_mfma_f32_32x32x16_bf16(PAF(0), VFR(0), o[0], 0, 0, 0), C0, 0); VRD2(0); \
    GAPB(o[1] = __builtin_amdgcn_mfma_f32_32x32x16_bf16(PAF(0), VFR(4), o[1], 0, 0, 0), C0, 2); VRD2(4); \
    KRD(GL, 0); GAPB(o[0] = __builtin_amdgcn_mfma_f32_32x32x16_bf16(PAF(1), VFR(1), o[0], 0, 0, 0), C0, 4); VRD2(1); \
    KRD(GL, 1); GAPB(o[1] = __builtin_amdgcn_mfma_f32_32x32x16_bf16(PAF(1), VFR(5), o[1], 0, 0, 0), C0, 6); VRD2(5); \
    KRD(GL, 2); GAPB(o[0] = __builtin_amdgcn_mfma_f32_32x32x16_bf16(PAF(2), VFR(2), o[0], 0, 0, 0), C0, 8); VRD2(2); \
    KRD(GL, 3); GAPB(o[1] = __builtin_amdgcn_mfma_f32_32x32x16_bf16(PAF(2), VFR(6), o[1], 0, 0, 0), C0, 10); VRD2(6); \
    GAPB(o[0] = __builtin_amdgcn_mfma_f32_32x32x16_bf16(PAF(3), VFR(3), o[0], 0, 0, 0), C0, 12); VRD2(3); \
    GAPB(o[1] = __builtin_amdgcn_mfma_f32_32x32x16_bf16(PAF(3), VFR(7), o[1], 0, 0, 0), C0, 14); VRD2(7); \
    GAPB(o[2] = __builtin_amdgcn_mfma_f32_32x32x16_bf16(PAF(0), VFR(0), o[2], 0, 0, 0), C1, 0); \
    GAPB(o[3] = __builtin_amdgcn_mfma_f32_32x32x16_bf16(PAF(0), VFR(4), o[3], 0, 0, 0), C1, 2); \
    GAPB(o[2] = __builtin_amdgcn_mfma_f32_32x32x16_bf16(PAF(1), VFR(1), o[2], 0, 0, 0), C1, 4); \
    GAPB(o[3] = __builtin_amdgcn_mfma_f32_32x32x16_bf16(PAF(1), VFR(5), o[3], 0, 0, 0), C1, 6); \
    GAPB(o[2] = __builtin_amdgcn_mfma_f32_32x32x16_bf16(PAF(2), VFR(2), o[2], 0, 0, 0), C1, 8); \
    GAPB(o[3] = __builtin_amdgcn_mfma_f32_32x32x16_bf16(PAF(2), VFR(6), o[3], 0, 0, 0), C1, 10); \
    GAPB(o[2] = __builtin_amdgcn_mfma_f32_32x32x16_bf16(PAF(3), VFR(3), o[2], 0, 0, 0), C1, 12); \
    GAPB(o[3] = __builtin_amdgcn_mfma_f32_32x32x16_bf16(PAF(3), VFR(7), o[3], 0, 0, 0), C1, 14); \
    } while (0)
  int t = 1;
  #undef CMASK
  #define CMASK(P0, P1, t) do {} while (0)
  for (; t + 5 < NT; t += 2) {
    STEP(pB0, pB1, pA0, pA1, t, true, true, true);     WAIT_BAR(3); RESC(); ROT();
    STEP(pA0, pA1, pB0, pB1, t + 1, true, true, true); WAIT_BAR(3); RESC(); ROT();
  }
  #undef CMASK
  #define CMASK(P0, P1, t) do { int jb_ = (t) - (NT - 4); if (jb_ >= 0) { const int ln_ = opaque_tid() & 63; cmask(P0, P1, jb_, wid * QBLK + (ln_ & 31), ln_ >> 5); } } while (0)
  #define ENDW(tt) do { if ((tt) + 3 < NT) { WAIT_BAR(3); } else if ((tt) + 2 < NT) { WAIT_BAR(2); } else { WAIT_BAR(0); } } while (0)
  for (; t + 1 < NT; t += 2) {
    STEP(pB0, pB1, pA0, pA1, t, (t + 3 < NT), (t + 1 < NT), (t + 1 < NT));         ENDW(t);     RESC(); ROT();
    STEP(pA0, pA1, pB0, pB1, t + 1, (t + 4 < NT), (t + 2 < NT), (t + 2 < NT));     ENDW(t + 1); RESC(); ROT();
  }
  STEP(pB0, pB1, pA0, pA1, NT - 1, false, false, false); RESC();
  { float sacc = pB0[0] + pB0[1]; _Pragma("unroll") for (int r = 2; r < 16; ++r) sacc += pB0[r]; _Pragma("unroll") for (int r = 0; r < 16; ++r) sacc += pB1[r]; l_reg += sacc;
    pw0 = (u32x4){PKW(pB0, 0), PKW(pB0, 2), PKW(pB0, 4), PKW(pB0, 6)}; pw1 = (u32x4){PKW(pB0, 8), PKW(pB0, 10), PKW(pB0, 12), PKW(pB0, 14)}; pw2 = (u32x4){PKW(pB1, 0), PKW(pB1, 2), PKW(pB1, 4), PKW(pB1, 6)}; pw3 = (u32x4){PKW(pB1, 8), PKW(pB1, 10), PKW(pB1, 12), PKW(pB1, 14)};
    SBAR(); const int ln_ = opaque_tid() & 63; const int vb0 = (int)(lds0 + LDS2_V) + ((ln_ >> 4) & 1) * 32 + (ln_ & 3) * 8 + (4 * (ln_ >> 5) + ((ln_ & 15) >> 2)) * 64;
    pv(o, vb0 + 2 * sl_cur, PAF(0), PAF(1), PAF(2), PAF(3)); pv(o + 2, vb0 + 2 * sl_cur + 8192, PAF(0), PAF(1), PAF(2), PAF(3)); }
  #undef PKW
  #undef PAF
  #undef VFR
  #undef PIN
  #undef MX3
  #undef GAPA
  #undef GAPB
  #undef EX
  #undef VRD
  #undef VRD2
  #undef KRD
  #undef STEP
  #undef ENDW
  { auto rr = __builtin_amdgcn_permlane32_swap(__float_as_uint(l_reg), __float_as_uint(l_reg), false, false); l_reg = __uint_as_float(rr[0]) + __uint_as_float(rr[1]); }
  if (hi == 0) wsf[32 + r32] = l_reg; asm volatile("s_waitcnt lgkmcnt(0)" ::: "memory");
  float rli[16];
  #pragma unroll
  for (int r = 0; r < 16; ++r) rli[r] = __builtin_amdgcn_rcpf(wsf[32 + crow(r, hi)]);
  bf16* Ow = O + (rowbase + q0 + wid * QBLK) * DMP + ocol;
  { bf16* stg = (bf16*)(shm + LDS2_OST) + wid * 4096;
    if (MODE == 1) {
      #pragma unroll
      for (int r = 0; r < 16; ++r) { const int orow = crow(r, hi);
        #pragma unroll
        for (int d0 = 0; d0 < 4; ++d0) stg[orow * 128 + d0 * 32 + r32] = __float2bfloat16(o[d0][r] * rli[r]); }
      asm volatile("s_waitcnt lgkmcnt(0)" ::: "memory");
    } else {
      const float* gain = (const float*)(shm + LDS2_GTAB);
      const float lam = gain[128];
      float gn[4];
      #pragma unroll
      for (int d0 = 0; d0 < 4; ++d0) gn[d0] = gain[d0 * 32 + r32];
      #pragma unroll
      for (int r = 0; r < 16; ++r) { const int orow = crow(r, hi); float sq = 0.f;
        #pragma unroll
        for (int d0 = 0; d0 < 4; ++d0) { const float d = __bfloat162float(stg[orow * 128 + d0 * 32 + r32]) - lam * (o[d0][r] * rli[r]); o[d0][r] = d; sq += d * d; }
        sq += __shfl_xor(sq, 1); sq += __shfl_xor(sq, 2); sq += __shfl_xor(sq, 4); sq += __shfl_xor(sq, 8); sq += __shfl_xor(sq, 16);
        const float rs = rsqrtf(sq * (1.0f / 128.0f) + 1e-5f);
        #pragma unroll
        for (int d0 = 0; d0 < 4; ++d0) stg[orow * 128 + d0 * 32 + r32] = __float2bfloat16(o[d0][r] * rs * gn[d0]); }
      asm volatile("s_waitcnt lgkmcnt(0)" ::: "memory");
      #pragma unroll
      for (int i = 0; i < 8; ++i) { const int row = i * 4 + (lane >> 4), ch = lane & 15; const u32x4 v = *(const u32x4*)(stg + row * 128 + ch * 8); *(u32x4*)(Ow + (long)row * DMP + ch * 8) = v; } } }
  asm volatile("s_waitcnt lgkmcnt(0)\n\ts_barrier" ::: "memory");
  #undef DMA_K
  #undef DMA_V
  #undef CMASK
  #undef START
  #undef RESC
  #undef ROT
}
#undef SBAR
#undef WAIT_BAR
}

#define XB_TMO      128
#define XB_XCNT(j)  (256  + 64 * (j))
#define XB_XSUB(j)  (1280 + 64 * (j))
#define XB_XGEN(j)  (2304 + 64 * (j))
#define XB_TOP      3328
#define XB_TOPGEN   3392
#define XCD_BAR_WORDS 3456
#define XB_SPIN_CAP (1u << 18)
__device__ __forceinline__ unsigned xb_ld(unsigned* p)              { return __hip_atomic_load(p, __ATOMIC_RELAXED, __HIP_MEMORY_SCOPE_AGENT); }
__device__ __forceinline__ unsigned xb_add(unsigned* p, unsigned v) { return __hip_atomic_fetch_add(p, v, __ATOMIC_RELAXED, __HIP_MEMORY_SCOPE_AGENT); }
__device__ __forceinline__ unsigned xb_xcc_id() { return (unsigned)__builtin_amdgcn_s_getreg((3 << 11) | 20) & 0xFu; }
#define XB_SPIN(cond, bar) do { unsigned _sp = 0; while (cond) { __builtin_amdgcn_s_sleep(1); \
    if ((++_sp & 255u) == 0u) { if (xb_ld(&(bar)[XB_TMO])) break; if (_sp > XB_SPIN_CAP) { atomicAdd(&(bar)[XB_TMO], 1u); break; } } } } while (0)
struct XcdBarrier { unsigned* bar; unsigned x; volatile LAS unsigned* st; };
__device__ __forceinline__ XcdBarrier xcd_barrier_post(unsigned* bar, volatile LAS unsigned* st) {
    XcdBarrier b; b.bar = bar; b.x = xb_xcc_id(); b.st = st;
    if (threadIdx.x == 0) (void)xb_add(&bar[XB_XCNT(b.x)], 1u);
    return b;
}
__device__ __forceinline__ void xcd_barrier_complete(unsigned* bar, unsigned x, unsigned& nloc, unsigned& nx) {
    const unsigned G = gridDim.x * gridDim.y * gridDim.z;
    unsigned sum, cnt, mine, sp = 0u;
    for (;;) {
        sum = 0u; cnt = 0u; mine = 0u;
#pragma unroll
        for (unsigned j = 0; j < 16; ++j) { const unsigned c = xb_ld(&bar[XB_XCNT(j)]); sum += c; cnt += (c > 0u) ? 1u : 0u; mine = (j == x) ? c : mine; }
        if (sum == G) break;
        __builtin_amdgcn_s_sleep(1);
        if ((++sp & 255u) == 0u) { if (xb_ld(&bar[XB_TMO])) break; if (sp > XB_SPIN_CAP) { atomicAdd(&bar[XB_TMO], 1u); break; } }
    }
    nloc = mine > 0u ? mine : 1u; nx = cnt > 0u ? cnt : 1u;
}
__device__ __forceinline__ void xcd_barrier(const XcdBarrier& b) {
    asm volatile("s_waitcnt vmcnt(0)" ::: "memory");
    __syncthreads();
    if (threadIdx.x == 0) {
        unsigned* bar = b.bar;
        __builtin_amdgcn_s_waitcnt(0);
        unsigned nloc = b.st[0], nx = b.st[1];
        if (nloc == 0u) { xcd_barrier_complete(bar, b.x, nloc, nx); b.st[0] = nloc; b.st[1] = nx; }
        const unsigned old = xb_add(&bar[XB_XSUB(b.x)], 1u);
        const unsigned gen = old / nloc;
        if (old + 1u == (gen + 1u) * nloc) {
            __builtin_amdgcn_fence(__ATOMIC_RELEASE, "agent");
            asm volatile("s_waitcnt vmcnt(0)" ::: "memory");
            const unsigned og = xb_add(&bar[XB_TOP], 1u);
            const unsigned tg = og / nx;
            if (og + 1u == (tg + 1u) * nx) xb_add(&bar[XB_TOPGEN], 1u);
            else XB_SPIN(xb_ld(&bar[XB_TOPGEN]) == tg, bar);
            __builtin_amdgcn_fence(__ATOMIC_ACQUIRE, "agent");
            xb_add(&bar[XB_XGEN(b.x)], 1u);
            asm volatile("s_waitcnt vmcnt(0)" ::: "memory");
        } else {
            XB_SPIN(xb_ld(&bar[XB_XGEN(b.x)]) == gen, bar);
            __builtin_amdgcn_fence(__ATOMIC_ACQUIRE, "agent");
            asm volatile("s_waitcnt vmcnt(0)" ::: "memory");
        }
    }
    __syncthreads();
}

__device__ __forceinline__ int map_row(int n, int mode, int arg) {
    if (mode == 1) return (n >> 7) * 256 + arg * 128 + (n & 127);
    if (mode == 2) { const int d = n & 63; if (d < 16) { const int dp = d < 8 ? 2 * d : 2 * (d - 8) + 1; return n - d + dp; } return n; }
    return n;
}
__device__ __forceinline__ void cvt_item(const float* W, int ldw, int K, int ncols, bf16_t* WT, const float* g, float scale, int mode, int arg, LAS float* scr, int item, int lane, int f16 = 0) {
    const int nblk = ncols / 64, kb = item / nblk, nb = item % nblk, k0 = 64 * kb, n0 = 64 * nb;
#pragma unroll
    for (int i = 0; i < 16; ++i) { const int kk = 4 * i + (lane >> 4); const float gs = g ? g[k0 + kk] * scale : scale;
        const f32x4 v = *(const f32x4*)(W + (size_t)(k0 + kk) * ldw + n0 + (lane & 15) * 4) * gs;
        LAS float* d = scr + kk * 65 + (lane & 15) * 4; d[0] = v[0]; d[1] = v[1]; d[2] = v[2]; d[3] = v[3]; }
    asm volatile("s_waitcnt lgkmcnt(0)" ::: "memory");
    const int c = lane & 7;
#pragma unroll
    for (int j = 0; j < 8; ++j) { const int n = (lane >> 3) + 8 * j; const LAS float* s = scr + (8 * c) * 65 + n;
        u32x4 o;
        if (f16) { o.x = cvt_pk_f16(s[0 * 65], s[1 * 65]); o.y = cvt_pk_f16(s[2 * 65], s[3 * 65]); o.z = cvt_pk_f16(s[4 * 65], s[5 * 65]); o.w = cvt_pk_f16(s[6 * 65], s[7 * 65]); }
        else { o.x = cvt_pk_bf16(s[0 * 65], s[1 * 65]); o.y = cvt_pk_bf16(s[2 * 65], s[3 * 65]); o.z = cvt_pk_bf16(s[4 * 65], s[5 * 65]); o.w = cvt_pk_bf16(s[6 * 65], s[7 * 65]); }
        *(u32x4*)(WT + (size_t)map_row(n0 + n, mode, arg) * K + k0 + 8 * c) = o; }
    asm volatile("s_waitcnt lgkmcnt(0)" ::: "memory");
}

struct Args { const void* in[34]; int ph_lo, ph_hi; };
__device__ __forceinline__ const void* ldarg(const Args& a, int k) { asm volatile("" : "+s"(k)); return a.in[k]; }
#define FARG(k) ((const float*)ldarg(args, k))
#define WSP(off) ((bf16_t*)((unsigned char*)ldarg(args, 33) + (off)))

__device__ __forceinline__ void convert_layer(const Args& args, int l, int parts, LAS float* scr, int gw, int NGW, int lane, int gtid, int NGT) {
    const int I1K = 16 * 16;
    const int IGU = 16 * (FF / 64), IDN = (FF / 64) * 16;
    const int n0 = 4 * I1K + I1K, n1 = n0 + 2 * IGU, total = n1 + IDN;
    for (int seg = 0; seg < 3; ++seg) {
        const int bit = seg == 0 ? 1 : (seg == 1 ? 4 : 2); if (!(parts & bit)) continue;
        const int it_lo = seg == 0 ? 0 : (seg == 1 ? n0 : n1), it_hi = seg == 0 ? n0 : (seg == 1 ? n1 : total);
    for (int it = it_lo + gw; it < it_hi; it += NGW) {
        int r = it;
#define CVT(Wp, ldw, K, ncols, WTp, gp, sc, mode, arg, F16_) { const int ni = ((K) / 64) * ((ncols) / 64); if (r >= 0 && r < ni) cvt_item(Wp, ldw, K, ncols, WTp, gp, sc, mode, arg, scr, r, lane, F16_); r -= ni; }
        if (l < 2) {
            CVT(FARG(7) + (size_t)l * DM * 2 * DM, 2 * DM, DM, DM, WSP(WS_WMIX), FARG(3) + l * DM, 1.f, 1, 0, 1);
            CVT(FARG(7) + (size_t)l * DM * 2 * DM + DM, 2 * DM, DM, DM, WSP(WS_WMIX), FARG(3) + l * DM, 1.f, 1, 1, 1);
            CVT(FARG(13) + (size_t)l * DM * DM, DM, DM, DM, WSP(WS_WMIX) + (size_t)2 * DM * DM, nullptr, 1.f, 0, 0, 0);
            r -= I1K;
        } else {
            const int b = l - 2;
            CVT(FARG(18) + (size_t)b * DM * DM, DM, DM, DM, WSP(WS_WMIX), FARG(3) + l * DM, 1.f, 2, 0, 1);
            CVT(FARG(24) + (size_t)b * DM * DM, DM, DM, DM, WSP(WS_WMIX) + (size_t)3 * DM * DM, nullptr, 1.f, 0, 0, 0);
            if (l == 2) {
                CVT(FARG(16), DM, DM, DM, WSP(WS_WMIX) + (size_t)DM * DM, FARG(15), 1.f, 2, 0, 1);
                CVT(FARG(17), DM, DM, DM, WSP(WS_WMIX) + (size_t)2 * DM * DM, FARG(15), 1.f, 0, 0, 1);
            } else r -= 2 * I1K;
        }
        CVT(FARG(28) + (size_t)l * DM * DM, DM, DM, DM, WSP(WS_WOT), nullptr, 1.f, 0, 0, 0);
        CVT(FARG(29) + (size_t)l * DM * FF, FF, DM, FF, WSP(WS_WGU), FARG(5) + l * DM, 1.f, 1, 0, 1);
        CVT(FARG(30) + (size_t)l * DM * FF, FF, DM, FF, WSP(WS_WGU), FARG(5) + l * DM, 1.f, 1, 1, 1);
        CVT(FARG(31) + (size_t)l * FF * DM, DM, FF, DM, WSP(WS_WD), nullptr, 1.f, 0, 0, 0);
#undef CVT
    } }
    if (parts & 1) { const float* wq = FARG(25) + (size_t)l * DM * DM; bf16_t* o = WSP(WS_WQS); const float* norm_mem = FARG(4) + l * DM;
      for (int i = gtid; i < DM * DM / 8; i += NGT) { const int k = i >> 7; const float gs = norm_mem[k] * (0.0625f * LOG2E);
          const f32x4 v0 = *(const f32x4*)(wq + (size_t)i * 8) * gs, v1 = *(const f32x4*)(wq + (size_t)i * 8 + 4) * gs;
          u32x4 w; w.x = cvt_pk_bf16(v0[0], v0[1]); w.y = cvt_pk_bf16(v0[2], v0[3]); w.z = cvt_pk_bf16(v1[0], v1[1]); w.w = cvt_pk_bf16(v1[2], v1[3]);
          *(u32x4*)(o + (size_t)i * 8) = w; } }
}

__device__ __forceinline__ void conv_phase(const bf16_t* Gin, bf16_t* CV, const float* wdw, const float* bdw, const float* lng, const float* lnb, LAS unsigned char* lds, int G, int c) {
    constexpr int CT = 16;
    const int tid = opaque_tid(), lane = tid & 63, wid = tid >> 6, ch = 2 * tid;
    LAS float* red = (LAS float*)lds;
    LAS float* st = (LAS float*)(lds + 4096);
    f32x2 w2[31];
#pragma unroll
    for (int j = 0; j < 31; ++j) w2[j] = *(const f32x2*)(wdw + j * DM + ch);
    const f32x2 bd = *(const f32x2*)(bdw + ch), gg = *(const f32x2*)(lng + ch), bb = *(const f32x2*)(lnb + ch);
    for (int unit = c; unit < TR / CT; unit += G) {
        const int row0 = unit * CT, t0 = row0 & (SEQ - 1);
        f32x2 x2[CT + 30];
#pragma unroll
        for (int j = 0; j < CT + 30; ++j) { const bool ok = (t0 - 30 + j) >= 0; const unsigned v = ok ? *(const unsigned*)(Gin + (size_t)(row0 - 30 + j) * DM + ch) : 0u; x2[j] = (f32x2){bf_lo(v), bf_hi(v)}; }
        float u0[CT], u1[CT];
#pragma unroll
        for (int t = 0; t < CT; ++t) { f32x2 a = bd;
#pragma unroll
            for (int j = 0; j < 31; ++j) a = __builtin_elementwise_fma(w2[j], x2[t + j], a);
            u0[t] = a[0]; u1[t] = a[1]; }
#pragma unroll
        for (int t = 0; t < CT; ++t) { float s = u0[t] + u1[t], q = u0[t] * u0[t] + u1[t] * u1[t]; s = wave_sum(s); q = wave_sum(q);
            if (lane == 0) { red[(wid * CT + t) * 2] = s; red[(wid * CT + t) * 2 + 1] = q; } }
        __syncthreads();
        if (tid < CT) { float s = 0.f, q = 0.f;
#pragma unroll
            for (int w = 0; w < 8; ++w) { s += red[(w * CT + tid) * 2]; q += red[(w * CT + tid) * 2 + 1]; }
            const float mean = s * (1.0f / DM), var = q * (1.0f / DM) - mean * mean;
            st[tid * 2] = mean; st[tid * 2 + 1] = rsqrtf(fmaxf(var, 0.f) + LN_EPS); }
        __syncthreads();
#pragma unroll
        for (int t = 0; t < CT; ++t) { const float mean = st[t * 2], rstd = st[t * 2 + 1];
            float y0 = (u0[t] - mean) * rstd * gg[0] + bb[0], y1 = (u1[t] - mean) * rstd * gg[1] + bb[1];
            y0 *= fast_sigmoid(y0); y1 *= fast_sigmoid(y1);
            *(unsigned*)(CV + (size_t)(row0 + t) * DM + ch) = cvt_pk_bf16(y0, y1); }
        __syncthreads();
    }
}

__global__ void __launch_bounds__(512, 2) yoco_fwd(Args args) {
    extern __shared__ __attribute__((aligned(16))) unsigned char lds_raw[];
    LAS unsigned char* lds = (LAS unsigned char*)lds_raw;
    cg::grid_group grid = cg::this_grid();
    const int G = gridDim.x, bx = blockIdx.x;
#define THIN_IDS const int tid = opaque_tid(), lane = tid & 63, wave = __builtin_amdgcn_readfirstlane(tid >> 6); const int gw = bx * 8 + wave, NGW = G * 8, gtid = bx * 512 + tid, NGT = G * 512; LAS float* scr = (LAS float*)(lds + wave * 16640); (void)lane; (void)gw; (void)NGW; (void)gtid; (void)NGT; (void)scr;
#define XRES ((float*)ldarg(args, 32))
#define SSP  ((float*)WSP(WS_SS))
#define HB   WSP(WS_HB)

    { const int t0 = opaque_tid(); if (t0 < 4) ((LAS unsigned*)(lds + LDS_BARST))[t0] = 0u; }
    __syncthreads();
    (void)xcd_barrier_post((unsigned*)WSP(WS_BAR), (volatile LAS unsigned*)(lds + LDS_BARST));
#define SEAM() do { if (args.ph_hi < 0) grid.sync();     \
        XcdBarrier xb_; xb_.bar = (unsigned*)WSP(WS_BAR); xb_.x = xb_xcc_id(); xb_.st = (volatile LAS unsigned*)(lds + LDS_BARST); xcd_barrier(xb_); } while (0)
#ifndef PROBE_MASK
#define PROBE_MASK 0u
#endif
    bool last_phase_ = false;
#define PH_BEGIN(kind) { const bool probe_ = (PROBE_MASK >> (kind)) & 1u; const unsigned long long pt0_ = probe_ ? __builtin_amdgcn_s_memrealtime() : 0ull;
#define PH_END   if (probe_) { __syncthreads(); const unsigned long long pt1_ = __builtin_amdgcn_s_memrealtime(); while (__builtin_amdgcn_s_memrealtime() - pt1_ < 3ull * (pt1_ - pt0_)) __builtin_amdgcn_s_sleep(8); } \
                 if (!last_phase_) SEAM(); }

    PH_BEGIN(0)
    {   THIN_IDS
        const float* x = FARG(0); const float* mem = FARG(1); const int* pos = (const int*)ldarg(args, 2);
        float* ss = SSP; bf16_t* xb = WSP(WS_XB); bf16_t* memb = WSP(WS_MEMB);
        for (int m0 = gw; m0 < TR + NBATCH * NMEM; m0 += 2 * NGW) {
            f32x4 v[2][4]; bool ok[2];
#pragma unroll
            for (int q = 0; q < 2; ++q) { const int m = m0 + q * NGW; ok[q] = m < TR + NBATCH * NMEM; const bool isx = m < TR;
                const float* src = isx ? x + (size_t)m * DM : mem + (size_t)(m - TR) * DM;
#pragma unroll
                for (int j = 0; j < 4; ++j) v[q][j] = ok[q] ? *((const f32x4*)src + lane + 64 * j) : (f32x4){0.f, 0.f, 0.f, 0.f}; }
#pragma unroll
            for (int q = 0; q < 2; ++q) { const int m = m0 + q * NGW; if (!ok[q]) continue; const bool isx = m < TR;
                bf16_t* dst = isx ? xb + (size_t)m * DM : memb + (size_t)(m - TR) * DM; float sq = 0.f;
#pragma unroll
                for (int j = 0; j < 4; ++j) { const f32x4 w4 = v[q][j]; sq += (w4[0] * w4[0] + w4[1] * w4[1]) + (w4[2] * w4[2] + w4[3] * w4[3]);
                    u32x2 w; if (isx) { w.x = cvt_pk_f16(w4[0], w4[1]); w.y = cvt_pk_f16(w4[2], w4[3]); } else { w.x = cvt_pk_bf16(w4[0], w4[1]); w.y = cvt_pk_bf16(w4[2], w4[3]); } *((u32x2*)dst + lane + 64 * j) = w; }
                sq = wave_sum(sq);
                if (isx && lane < 4) ss[(size_t)m * 4 + lane] = lane == 0 ? sq : 0.f; }
        }
        float* cosT = (float*)WSP(WS_COS); float* sinT = (float*)WSP(WS_SIN);
        for (int i = gtid; i < TR * 8; i += NGT) { const int row = i >> 3, k = i & 7; const float inv = powf(500000.0f, -(float)(2 * k) / 16.0f); const float ang = (float)pos[row] * inv;
            cosT[i] = cosf(ang); sinT[i] = sinf(ang); }
        for (int it = gw; it < 8 * 256; it += NGW) { const int j = it >> 8, l = j >> 1, kv = j & 1;
            cvt_item(FARG(kv ? 27 : 26) + (size_t)l * DM * DM, DM, DM, DM, HB + (size_t)j * DM * DM, nullptr, 1.f, 0, 0, scr, it & 255, lane); }
        convert_layer(args, 0, 7, scr, gw, NGW, lane, gtid, NGT);
    }
    PH_END

    PH_BEGIN(1)
    {   pg8::Gemm g{WSP(WS_MEMB), HB, DM, DM, DM, 0, (long)NMEM * DM, (long)DM * DM, 0, 0, 4};
        pg8::Order S; S.init(1, 4, 32, G, bx);
        pg8::EpiPlain E{WSP(WS_KV), DM, (long)4 * NMEM * DM, (long)NMEM * DM, 4, 0};
        pg8::gemm_phase(lds, g, S, E);
    }
    PH_END

    for (int l = 0; l < 4; ++l) {
        const bool is_conv = l < 2;

        PH_BEGIN(3)
        if (is_conv) {
            pg8::Gemm g{WSP(WS_XB), WSP(WS_WMIX), DM, DM, DM, 0, 0, 0, 0, 0, 1}; pg8::Order S; S.init(TR / 256, 8, 1, G, bx);
            pg8::EpiGated<0> E{WSP(WS_R1), DM, SSP, FARG(8) + l * 2 * DM, DM};
            pg8::gemm_phase<pg8::EpiGated<0>, true>(lds, g, S, E);
        } else {
            pg8::Gemm g{WSP(WS_XB), WSP(WS_WMIX), DM, DM, DM, 0, 0, 0, 0, 0, 1}; pg8::Order S; S.init(TR / 256, l == 2 ? 12 : 4, 1, G, bx);
            pg8::EpiQKV E{WSP(WS_R1), (size_t)(WS_KSH - WS_R1) / 2, SSP, (const float*)WSP(WS_COS), (const float*)WSP(WS_SIN)};
            pg8::gemm_phase<pg8::EpiQKV, true>(lds, g, S, E);
        }
        {
            pg8::Gemm g1{WSP(WS_KV) + (size_t)(l * 2 + 0) * 4 * NMEM * DM, WSP(WS_WQS), DM, DM, 256, (long)NMEM * DM, 256, 0, 256, 0, 4}; pg8::Order S1; S1.init(1, 4, 16, G, bx);
            pg8::EpiPlain E1{WSP(WS_BTS), DM, (long)DM * DM, (long)256 * DM, 4, 1};
            pg8::gemm_phase(lds, g1, S1, E1);
            pg8::Gemm g2{WSP(WS_WOT), WSP(WS_KV) + (size_t)(l * 2 + 1) * 4 * NMEM * DM, DM, DM, 256, 0, 256, (long)NMEM * DM, 256, 0, 4}; pg8::Order S2; S2.init(4, 1, 16, G, G - 1 - bx);
            pg8::EpiPlain E2{WSP(WS_BTO), DM, (long)DM * DM, 256, 4, 0};
            pg8::gemm_phase(lds, g2, S2, E2);
        }
        PH_END

        PH_BEGIN((is_conv ? 4 : 5))
        if (is_conv) {
#ifndef NO_CONV
            conv_phase(WSP(WS_R1), HB, FARG(9) + l * 31 * DM, FARG(10) + l * DM, FARG(11) + l * DM, FARG(12) + l * DM, lds, G, bx);
#endif
        } else {
#ifndef NO_ATTN
            const attn_body::bf16* qd = (const attn_body::bf16*)WSP(WS_R1); const attn_body::bf16* kd = (const attn_body::bf16*)WSP(WS_KSH); const attn_body::bf16* vd = (const attn_body::bf16*)WSP(WS_VSH);
            attn_body::bf16* od = (attn_body::bf16*)WSP(WS_R1);
            float lam, li1;
            {   const int ln = opaque_tid() & 63; const int bb = l - 2; const float lambda_init = 0.8f - 0.6f * expf(-0.3f * (float)l);
                const float d1 = wave_sum(FARG(19)[bb * 64 + ln] * FARG(20)[bb * 64 + ln]), d2 = wave_sum(FARG(21)[bb * 64 + ln] * FARG(22)[bb * 64 + ln]);
                lam = expf(d1) - expf(d2) + lambda_init; li1 = 1.0f - lambda_init; }
            float* gtab = (float*)((char*)lds_raw + LDS_GTAB);
            { const int t = opaque_tid(); if (t < 128) gtab[t] = FARG(23)[(l - 2) * 128 + t] * li1; if (t == 128) gtab[128] = lam; }
            __syncthreads();
#define ATT_PAIR(B_, H_, QB_) do { \
                attn_body::attn_unit2<8, 1>(B_, (H_) * 128, (H_) * 128, (H_) * 128, (H_) * 128, QB_, qd, kd, vd, od, (char*)lds_raw); \
                attn_body::attn_unit2<8, 2>(B_, (H_) * 128 + 64, (H_) * 128 + 64, (H_) * 128, (H_) * 128, QB_, qd, kd, vd, od, (char*)lds_raw); } while (0)
            for (int i = 0;; ++i) { int b, h, qb;
                if (G == 256) {
                    if (i >= 2) break; const int xk = bx >> 3, bh = (bx & 7) * 4 + (xk >> 3), p = xk & 7; b = bh >> 3; h = bh & 7; qb = i == 0 ? 15 - p : p;
                } else {
                    const int pp = (i & 1) ? (G - 1 - bx) : bx; const int idx = i * G + pp; if (idx >= 512) break; qb = 15 - (idx >> 5); const int j = idx & 31; b = j >> 3; h = j & 7; }
                ATT_PAIR(b, h, qb); }
#undef ATT_PAIR
#endif
        }
        if (l > 0) { THIN_IDS convert_layer(args, l, 2, scr, gw, NGW, lane, gtid, NGT); }
        PH_END

        PH_BEGIN(7)
        {   pg8::Gemm g{is_conv ? HB : WSP(WS_R1), WSP(WS_WMIX) + (size_t)(is_conv ? 2 : 3) * DM * DM, DM, DM, DM, 0, 0, 0, 0, 0, 1}; pg8::Order S; S.init(TR / 256, 4, 1, G, bx);
            pg8::EpiResid E{WSP(WS_XB), SSP, is_conv ? FARG(14) + l * DM : nullptr};
            pg8::gemm_phase(lds, g, S, E);
        }
        PH_END

        PH_BEGIN(8)
        {   pg8::Gemm g{WSP(WS_XB), WSP(WS_BTS), DM, DM, DM, 0, 0, 0, 0, (long)DM * DM, 1}; pg8::Order S; S.init(TR / 256, 4, 1, G, bx);
            pg8::EpiSoftmax E{WSP(WS_R1), SSP};
            pg8::gemm_phase<pg8::EpiSoftmax, true>(lds, g, S, E);
        }
        PH_END

        PH_BEGIN(9)
        {   pg8::Gemm g{WSP(WS_R1), WSP(WS_BTO), DM, DM, DM, 0, 0, 0, 0, (long)DM * DM, 1}; pg8::Order S; S.init(TR / 256, 4, 1, G, bx);
            pg8::EpiResid E{WSP(WS_XB), SSP, nullptr};
            pg8::gemm_phase(lds, g, S, E);
        }
        PH_END

        PH_BEGIN(10)
        {   pg8::Gemm g{WSP(WS_XB), WSP(WS_WGU), DM, DM, DM, 0, 0, 0, 0, 0, 1}; pg8::Order S; S.init(TR / 256, 2 * FF / 256, 1, G, bx);
            pg8::EpiGated<1> E{HB, FF, SSP, nullptr, 0};
            pg8::gemm_phase<pg8::EpiGated<1>, true>(lds, g, S, E);
            {   const int nun = (TR / 256) * (2 * FF / 256), tail = nun % G;
                if (l < 3) { if (tail > 0 && bx >= tail) { const int tid = opaque_tid(), lane = tid & 63, wave = __builtin_amdgcn_readfirstlane(tid >> 6); LAS float* scr = (LAS float*)(lds + wave * 16640);
                        convert_layer(args, l + 1, 1, scr, (bx - tail) * 8 + wave, (G - tail) * 8, lane, (bx - tail) * 512 + tid, (G - tail) * 512); }
                    else if (tail == 0) { THIN_IDS convert_layer(args, l + 1, 1, scr, gw, NGW, lane, gtid, NGT); } } }
        }
        PH_END

        PH_BEGIN(11)
        {   pg8::Gemm g{HB, WSP(WS_WD), FF, FF, FF, 0, 0, 0, 0, 0, 1}; pg8::Order S; S.init(TR / 256, 4, 1, G, bx);
            pg8::EpiResid E{WSP(WS_XB), SSP, nullptr};
            pg8::gemm_phase(lds, g, S, E);
            if (l < 3) { THIN_IDS convert_layer(args, l + 1, 4, scr, gw, NGW, lane, gtid, NGT); }
        }
        PH_END
    }

    last_phase_ = true;
    PH_BEGIN(12)
    {   THIN_IDS
        const float* gfin = FARG(6); float* outp = XRES; const bf16_t* xb = WSP(WS_XB);
        for (int m0 = gw; m0 < TR; m0 += 2 * NGW) {
            u32x4 ra[2][2]; bool ok[2];
#pragma unroll
            for (int q = 0; q < 2; ++q) { const int m = m0 + q * NGW; ok[q] = m < TR; const u32x4* p = (const u32x4*)(xb + (size_t)(ok[q] ? m : m0) * DM); ra[q][0] = p[lane]; ra[q][1] = p[64 + lane]; }
#pragma unroll
            for (int q = 0; q < 2; ++q) { const int m = m0 + q * NGW; if (!ok[q]) continue; const u32x4 a = ra[q][0], b = ra[q][1];
            float v[16];
#pragma unroll
            for (int j = 0; j < 4; ++j) { v[2 * j] = h_lo(a[j]); v[2 * j + 1] = h_hi(a[j]); v[8 + 2 * j] = h_lo(b[j]); v[8 + 2 * j + 1] = h_hi(b[j]); }
            float sq = 0.f;
#pragma unroll
            for (int j = 0; j < 16; ++j) sq += v[j] * v[j];
            const float rs = rsqrtf(wave_sum(sq) * (1.0f / DM) + RMS_EPS);
            float* orow = outp + (size_t)m * DM;
#pragma unroll
            for (int h = 0; h < 2; ++h) { const int c0 = h * 512 + lane * 8; const f32x4 g0 = *(const f32x4*)(gfin + c0), g1 = *(const f32x4*)(gfin + c0 + 4);
                *(f32x4*)(orow + c0) = (f32x4){v[8 * h + 0] * rs * g0[0], v[8 * h + 1] * rs * g0[1], v[8 * h + 2] * rs * g0[2], v[8 * h + 3] * rs * g0[3]};
                *(f32x4*)(orow + c0 + 4) = (f32x4){v[8 * h + 4] * rs * g1[0], v[8 * h + 5] * rs * g1[1], v[8 * h + 6] * rs * g1[2], v[8 * h + 7] * rs * g1[3]}; } } }
    }
    PH_END
#undef PH_BEGIN
#undef PH_END
}

extern "C" void kernel_launch(void* const* d_in, const int* in_sizes, int n_in, void* d_out, int out_size, void* d_ws, size_t ws_size, hipStream_t stream) {
    static int grid = 0;
    if (grid == 0) {
        if (n_in != 32 || out_size != TR * DM || ws_size < WS_END) { fprintf(stderr, "kernel_launch: unexpected shapes (n_in %d out %d ws %zu)\n", n_in, out_size, ws_size); grid = -1; return; }
        int dev = 0, cus = 0, per_cu = 0;
        hipGetDevice(&dev); hipDeviceGetAttribute(&cus, hipDeviceAttributeMultiprocessorCount, dev);
        if (hipFuncSetAttribute((const void*)yoco_fwd, hipFuncAttributeMaxDynamicSharedMemorySize, LDS_BYTES) != hipSuccess) { fprintf(stderr, "kernel_launch: hipFuncSetAttribute failed\n"); grid = -1; return; }
        if (hipOccupancyMaxActiveBlocksPerMultiprocessor(&per_cu, (const void*)yoco_fwd, 512, LDS_BYTES) != hipSuccess || per_cu < 1) { fprintf(stderr, "kernel_launch: occupancy query gave %d\n", per_cu); per_cu = 1; (void)hipGetLastError(); }
        grid = cus * per_cu;
    }
    if (grid < 0) return;
    if (hipMemsetAsync((char*)d_ws + WS_BAR, 0, XCD_BAR_WORDS * 4, stream) != hipSuccess) { fprintf(stderr, "kernel_launch: memset failed\n"); return; }
    Args a{};
    for (int i = 0; i < 32; ++i) a.in[i] = d_in[i];
    a.in[32] = d_out; a.in[33] = d_ws;
    a.ph_lo = 0; a.ph_hi = 1;
    void* kargs[] = {&a};
    hipError_t e = hipLaunchCooperativeKernel((const void*)yoco_fwd, dim3(grid), dim3(512), kargs, LDS_BYTES, stream);
    if (e != hipSuccess) fprintf(stderr, "kernel_launch: cooperative launch failed: %s (grid %d)\n", hipGetErrorString(e), grid);
}
```

```cpp
#include <hip/hip_runtime.h>
#include <hip/hip_cooperative_groups.h>
#include <hip/hip_bf16.h>
#include <cstdio>
#include <cstdint>
#include <cmath>
namespace cg = cooperative_groups;

#define LAS __attribute__((address_space(3)))
typedef unsigned short bf16_t;
typedef short bf16x8 __attribute__((ext_vector_type(8)));
typedef float f32x4 __attribute__((ext_vector_type(4)));
typedef float f32x2 __attribute__((ext_vector_type(2)));
typedef unsigned u32x4 __attribute__((ext_vector_type(4)));
typedef unsigned u32x2 __attribute__((ext_vector_type(2)));

constexpr int TR = 16384, DM = 1024, FF = 2816, SEQ = 4096, NBATCH = 4, NMEM = 256;
constexpr float RMS_EPS = 1e-6f, LN_EPS = 1e-5f, SUBLN_EPS = 1e-5f;
constexpr float LOG2E = 1.4426950408889634f;
constexpr float C2 = 0.125f * LOG2E;

constexpr size_t MiB = 1u << 20;
constexpr size_t WS_SS = 0;
constexpr size_t WS_BAR = 512 * 1024;
constexpr size_t WS_COS = 1 * MiB;
constexpr size_t WS_SIN = 1 * MiB + 512 * 1024;
constexpr size_t WS_MEMB = 2 * MiB;
constexpr size_t WS_W = 4 * MiB;
constexpr size_t WS_WMIX = WS_W;
constexpr size_t WS_WQS = WS_W + 8 * MiB;
constexpr size_t WS_WOT = WS_W + 10 * MiB;
constexpr size_t WS_WGU = WS_W + 12 * MiB;
constexpr size_t WS_WD = WS_W + 24 * MiB;
constexpr size_t WS_BTS = 36 * MiB;
constexpr size_t WS_BTO = 44 * MiB;
constexpr size_t WS_KV = 52 * MiB;
constexpr size_t WS_XB = 68 * MiB;
constexpr size_t WS_R1 = 100 * MiB;
constexpr size_t WS_KSH = 132 * MiB;
constexpr size_t WS_VSH = 164 * MiB;
constexpr size_t WS_HB = 196 * MiB;
constexpr size_t WS_END = 284 * MiB;
static_assert(WS_KSH - WS_R1 == WS_VSH - WS_KSH, "q | k | v buffers equally spaced");

constexpr int LDS_STAGE = 131072, LDS_XCH = 131072, LDS_RS = 139264, LDS_GTAB = 142336, LDS_BARST = 143360, LDS_BYTES = 147456;

typedef __bf16 bf16x2_hw __attribute__((ext_vector_type(2)));
__device__ __forceinline__ unsigned cvt_pk_bf16(float lo, float hi) { const f32x2 v = {lo, hi}; const bf16x2_hw b = __builtin_convertvector(v, bf16x2_hw); return __builtin_bit_cast(unsigned, b); }
__device__ __forceinline__ int opaque_tid() { int t = threadIdx.x; asm volatile("" : "+v"(t)); return t; }
typedef _Float16 f16x8 __attribute__((ext_vector_type(8)));
typedef _Float16 f16x2 __attribute__((ext_vector_type(2)));
__device__ __forceinline__ unsigned cvt_pk_f16(float lo, float hi) { const f32x2 v = {lo, hi}; const f16x2 h = __builtin_convertvector(v, f16x2); return __builtin_bit_cast(unsigned, h); }
__device__ __forceinline__ float h_lo(unsigned u) { return (float)__builtin_bit_cast(f16x2, u)[0]; }
__device__ __forceinline__ float h_hi(unsigned u) { return (float)__builtin_bit_cast(f16x2, u)[1]; }
__device__ __forceinline__ float bf_lo(unsigned u) { return __uint_as_float(u << 16); }
__device__ __forceinline__ float bf_hi(unsigned u) { return __uint_as_float(u & 0xffff0000u); }
__device__ __forceinline__ float wave_sum(float v) {
#pragma unroll
    for (int o = 1; o < 64; o <<= 1) v += __shfl_xor(v, o);
    return v;
}
__device__ __forceinline__ float fast_sigmoid(float x) { return __builtin_amdgcn_rcpf(1.0f + __builtin_amdgcn_exp2f(-x * LOG2E)); }
__device__ __forceinline__ float row_rs_lds(LAS unsigned char* lds, int r) {
    const f32x4 a = *(const LAS f32x4*)(lds + LDS_RS + r * 16);
    return rsqrtf(((a[0] + a[1]) + (a[2] + a[3])) * (1.0f / DM) + RMS_EPS);
}
__device__ __forceinline__ float row_rs(const float* ss, int row) {
    const f32x4 a = *(const f32x4*)(ss + (size_t)row * 4);
    return rsqrtf(((a[0] + a[1]) + (a[2] + a[3])) * (1.0f / DM) + RMS_EPS);
}

namespace pg8 {
constexpr int BM = 256, BK = 64, HALF = 128, HTB = HALF * BK * 2, NXCD = 8, WGM = 8;
__host__ __device__ __forceinline__ int lds_byte(int r, int c) { const int st = (r >> 4) * 2 + (c >> 5), rr = r & 15, cc = c & 31, ob = rr * 64 + cc * 2; return st * 1024 + (ob ^ (((ob >> 9) & 1) << 5)); }
__host__ __device__ __forceinline__ void stage_rc(int b, int& R, int& C) { const int st = b / 1024, sb = b % 1024, swz = sb ^ (((sb >> 9) & 1) << 5); R = (st >> 1) * 16 + swz / 64; C = (st & 1) * 32 + (swz % 64) / 2; }
__host__ __device__ __forceinline__ int perm32(int rho) { const int n = rho >> 4, i = rho & 15; return 8 * (i >> 2) + 4 * n + (i & 3); }

struct Unit { int pm, pn, z; };
struct Gemm { const bf16_t* A; const bf16_t* Bt; int lda, ldb, K; long a_s1, a_s0, b_s1, b_s0, b_sb; int nz0; };
__device__ __forceinline__ const char* a_ptr(const Gemm& g, const Unit& u) { const int z1 = u.z / g.nz0, z0 = u.z % g.nz0; return (const char*)(g.A + z1 * g.a_s1 + z0 * g.a_s0 + (long)u.pm * BM * g.lda); }
__device__ __forceinline__ const char* b_ptr(const Gemm& g, const Unit& u) { const int z1 = u.z / g.nz0, z0 = u.z % g.nz0; return (const char*)(g.Bt + z1 * g.b_s1 + z0 * g.b_s0 + (long)(u.pm >> 4) * g.b_sb + (long)u.pn * BM * g.ldb); }

struct Order {
    int nM, nN, nz, nwg, G, c;
    __device__ void init(int nM_, int nN_, int nz_, int G_, int c_) { nM = nM_; nN = nN_; nz = nz_; nwg = nM * nN; G = G_; c = c_; }
    __device__ bool next(int i, Unit& u) const {
        const long L = (long)i * G + c; if (L >= (long)nwg * nz) return false;
        if (nz == 1) {
            int wgid = (int)L; { const int q = nwg / NXCD, r = nwg % NXCD, xcd = wgid % NXCD, off = wgid / NXCD; wgid = (xcd < r ? xcd * (q + 1) : r * (q + 1) + (xcd - r) * q) + off; }
            const int nig = WGM * nN, gid = wgid / nig, fm = gid * WGM, gsz = (nM - fm) < WGM ? (nM - fm) : WGM;
            u.pm = fm + ((wgid % nig) % gsz); u.pn = (wgid % nig) / gsz; u.z = 0;
        } else {
            const int l = (int)L; u.z = l / nwg; const int r = l % nwg; u.pm = r / nN; u.pn = r % nN;
        }
        return true;
    }
};

template <bool F16> __device__ __forceinline__ f32x4 mma16(bf16x8 a, bf16x8 b, f32x4 c) {
    if constexpr (F16) return __builtin_amdgcn_mfma_f32_16x16x32_f16(__builtin_bit_cast(f16x8, a), __builtin_bit_cast(f16x8, b), c, 0, 0, 0);
    else return __builtin_amdgcn_mfma_f32_16x16x32_bf16(a, b, c, 0, 0, 0);
}
template <class Epi, bool F16 = false>
__device__ __forceinline__ void gemm_phase(LAS unsigned char* lds, const Gemm g, const Order& S, const Epi& E) {
    const int tid = opaque_tid(), wid = __builtin_amdgcn_readfirstlane(tid >> 6), lane = tid & 63, wr = wid >> 2, wc = wid & 3, fr = lane & 15, fq = lane >> 4;
    const int K = g.K, nt = K / BK;
    unsigned voffA[2], voffB[2];
#pragma unroll
    for (int i = 0; i < 2; ++i) { int R, C; stage_rc(tid * 16 + i * 8192, R, C); const int Rb = (R & ~31) + perm32(R & 31);
        voffA[i] = (unsigned)(R * g.lda + C) * 2u; voffB[i] = (unsigned)(Rb * g.ldb + C) * 2u; }
    const size_t kstep = (size_t)(BK * 2);
    const size_t hstepA = (size_t)HALF * g.lda * 2, hstepB = (size_t)HALF * g.ldb * 2;
    const unsigned ldsw = (unsigned)wid * 1024u;
    const int aoff = lds_byte(wr * 64 + fr, fq * 8), boff = lds_byte(wc * 32 + fr, fq * 8);
#define PG8_SA(b, h) (((b) * 2 + (h)) * HTB)
#define PG8_SB(b, h) ((4 + (b) * 2 + (h)) * HTB)
#define PG8_STAGE(bufoff, gbase, voff) do { _Pragma("unroll") for (int _i = 0; _i < 2; ++_i) \
        __builtin_amdgcn_global_load_lds((const unsigned*)((const char*)(gbase) + (voff)[_i]), (LAS unsigned*)(lds + (bufoff) + ldsw + _i * 8192), 16, 0, 0); } while (0)
#define PG8_LDA(dst, b, h) do { _Pragma("unroll") for (int m = 0; m < 4; ++m) _Pragma("unroll") for (int k = 0; k < 2; ++k) dst[m][k] = *(const LAS bf16x8*)(lds + PG8_SA(b, h) + aoff + m * 2048 + k * 1024); } while (0)
#define PG8_LDB(dst, b, h) do { _Pragma("unroll") for (int n = 0; n < 2; ++n) _Pragma("unroll") for (int k = 0; k < 2; ++k) dst[n][k] = *(const LAS bf16x8*)(lds + PG8_SB(b, h) + boff + n * 2048 + k * 1024); } while (0)
#define PG8_MMA(ai, bj, At, Bt) do { __builtin_amdgcn_s_setprio(1); _Pragma("unroll") for (int m = 0; m < 4; ++m) _Pragma("unroll") for (int n = 0; n < 2; ++n) _Pragma("unroll") for (int k = 0; k < 2; ++k) \
        acc[ai][bj][m][n] = mma16<F16>(Bt[n][k], At[m][k], acc[ai][bj][m][n]); __builtin_amdgcn_s_setprio(0); } while (0)
#define PG8_WAIT_V(n) asm volatile("s_waitcnt vmcnt(" #n ")" ::: "memory")
#define PG8_WAIT_L(n) asm volatile("s_waitcnt lgkmcnt(" #n ")" ::: "memory")
#define PG8_BAR __builtin_amdgcn_s_barrier()
#define PG8_SCHED __builtin_amdgcn_sched_barrier(0)
    Unit cur, nxt; int ui = 0;
    if (!S.next(0, cur)) return;
    f32x4 acc[2][2][4][2];
#pragma unroll
    for (int a = 0; a < 2; ++a)
#pragma unroll
        for (int b = 0; b < 2; ++b)
#pragma unroll
            for (int m = 0; m < 4; ++m)
#pragma unroll
                for (int n = 0; n < 2; ++n) acc[a][b][m][n] = (f32x4){0.f, 0.f, 0.f, 0.f};
    bf16x8 At[4][2], B0[2][2], B1[2][2];
    const char* cA = a_ptr(g, cur); const char* cB = b_ptr(g, cur);
    PG8_STAGE(PG8_SB(0, 0), cB, voffB); PG8_STAGE(PG8_SB(0, 1), cB + hstepB, voffB); PG8_STAGE(PG8_SA(0, 0), cA, voffA); PG8_STAGE(PG8_SA(0, 1), cA + hstepA, voffA);
    if (wr == 1) PG8_BAR;
    PG8_WAIT_V(2); PG8_BAR;
    PG8_STAGE(PG8_SB(1, 0), cB + kstep, voffB); PG8_STAGE(PG8_SA(1, 0), cA + kstep, voffA); PG8_STAGE(PG8_SB(1, 1), cB + hstepB + kstep, voffB);
    PG8_WAIT_V(6); PG8_BAR;
    for (;;) {
        const bool has_next = S.next(ui + 1, nxt);
        const char* nA = has_next ? a_ptr(g, nxt) : cA; const char* nB = has_next ? b_ptr(g, nxt) : cB;
        for (int t = 0; t < nt; t += 2) {
            const bool last = (t == nt - 2);
            const char* a1 = cA + (size_t)(t + 1) * kstep;
            const char* a2 = last ? nA : cA + (size_t)(t + 2) * kstep; const char* b2 = last ? nB : cB + (size_t)(t + 2) * kstep;
            const char* a3 = a2 + kstep; const char* b3 = b2 + kstep;
            if constexpr (Epi::NEEDS_RS) { if (last && wid < 4) __builtin_amdgcn_global_load_lds((const unsigned*)(E.ss + ((size_t)cur.pm * BM + wid * 64 + lane) * 4), (LAS unsigned*)(lds + LDS_RS + wid * 1024), 16, 0, 0); }
            PG8_LDB(B0, 0, 0); PG8_LDB(B1, 0, 1); PG8_SCHED; PG8_LDA(At, 0, 0); PG8_STAGE(PG8_SA(1, 1), a1 + hstepA, voffA);
            PG8_WAIT_V(8); PG8_WAIT_L(0); PG8_BAR; PG8_MMA(0, 0, At, B0); PG8_MMA(0, 1, At, B1); PG8_BAR; PG8_SCHED;
            PG8_LDA(At, 0, 1); PG8_STAGE(PG8_SB(0, 0), b2, voffB); PG8_STAGE(PG8_SB(0, 1), b2 + hstepB, voffB); PG8_STAGE(PG8_SA(0, 0), a2, voffA);
            PG8_WAIT_V(8); PG8_WAIT_L(0); PG8_BAR; PG8_MMA(1, 0, At, B0); PG8_MMA(1, 1, At, B1); PG8_BAR; PG8_SCHED;
            PG8_LDB(B0, 1, 0); PG8_LDB(B1, 1, 1); PG8_SCHED; PG8_LDA(At, 1, 0); PG8_STAGE(PG8_SA(0, 1), a2 + hstepA, voffA);
            PG8_WAIT_V(8); PG8_WAIT_L(0); PG8_BAR; PG8_MMA(0, 0, At, B0); PG8_MMA(0, 1, At, B1); PG8_BAR; PG8_SCHED;
            PG8_LDA(At, 1, 1); PG8_STAGE(PG8_SB(1, 0), b3, voffB); PG8_STAGE(PG8_SB(1, 1), b3 + hstepB, voffB); PG8_STAGE(PG8_SA(1, 0), a3, voffA);
            PG8_WAIT_V(8); PG8_WAIT_L(0); PG8_BAR; PG8_MMA(1, 0, At, B0); PG8_MMA(1, 1, At, B1); PG8_BAR; PG8_SCHED;
        }
        if (wr == 0) PG8_BAR;
        E(acc, cur, wr, wc, fr, fq, lds);
        if (!has_next) break;
#pragma unroll
        for (int a = 0; a < 2; ++a)
#pragma unroll
            for (int b = 0; b < 2; ++b)
#pragma unroll
                for (int m = 0; m < 4; ++m)
#pragma unroll
                    for (int n = 0; n < 2; ++n) acc[a][b][m][n] = (f32x4){0.f, 0.f, 0.f, 0.f};
        cur = nxt; cA = nA; cB = nB; ++ui;
        if (wr == 1) PG8_BAR;
    }
    PG8_WAIT_V(0);
    PG8_BAR;
#undef PG8_SA
#undef PG8_SB
#undef PG8_STAGE
#undef PG8_LDA
#undef PG8_LDB
#undef PG8_MMA
#undef PG8_WAIT_V
#undef PG8_WAIT_L
#undef PG8_BAR
#undef PG8_SCHED
}

typedef f32x4 Acc[2][2][4][2];

struct EpiPlain {
    static constexpr bool NEEDS_RS = false;
    bf16_t* O; int ldc; long c_s1, c_s0; int nz0; int f16;
    __device__ __forceinline__ void operator()(Acc& acc, const Unit& u, int wr, int wc, int fr, int fq, LAS unsigned char*) const {
        const int z1 = u.z / nz0, z0 = u.z % nz0;
        bf16_t* base = O + z1 * c_s1 + z0 * c_s0;
        const int row0 = u.pm * BM + wr * 64 + fr, col0 = u.pn * BM + wc * 32 + 8 * fq;
#pragma unroll
        for (int ai = 0; ai < 2; ++ai)
#pragma unroll
            for (int m = 0; m < 4; ++m) { bf16_t* rowp = base + (size_t)(row0 + ai * HALF + m * 16) * ldc + col0;
#pragma unroll
                for (int bj = 0; bj < 2; ++bj) { const f32x4 v0 = acc[ai][bj][m][0], v1 = acc[ai][bj][m][1];
                    u32x4 w;
                    if (f16) { w.x = cvt_pk_f16(v0[0], v0[1]); w.y = cvt_pk_f16(v0[2], v0[3]); w.z = cvt_pk_f16(v1[0], v1[1]); w.w = cvt_pk_f16(v1[2], v1[3]); }
                    else { w.x = cvt_pk_bf16(v0[0], v0[1]); w.y = cvt_pk_bf16(v0[2], v0[3]); w.z = cvt_pk_bf16(v1[0], v1[1]); w.w = cvt_pk_bf16(v1[2], v1[3]); }
                    *(u32x4*)(rowp + bj * HALF) = w; } }
    }
};

template <int MODE> struct EpiGated {
    static constexpr bool NEEDS_RS = true;
    bf16_t* O; int ldc; const float* ss; const float* bias; int bias_half;
    __device__ __forceinline__ void operator()(Acc& acc, const Unit& u, int wr, int wc, int fr, int fq, LAS unsigned char* lds) const {
        const int row0 = u.pm * BM + wr * 64 + fr, col0 = u.pn * HALF + wc * 32 + 8 * fq;
        f32x4 ba[2], bg[2];
#pragma unroll
        for (int n = 0; n < 2; ++n) { if (MODE == 0) { ba[n] = *(const f32x4*)(bias + col0 + 4 * n); bg[n] = *(const f32x4*)(bias + bias_half + col0 + 4 * n); } else { ba[n] = (f32x4){0.f, 0.f, 0.f, 0.f}; bg[n] = ba[n]; } }
        float rsv[2][4];
#pragma unroll
        for (int ai = 0; ai < 2; ++ai)
#pragma unroll
            for (int m = 0; m < 4; ++m) rsv[ai][m] = row_rs_lds(lds, ai * HALF + wr * 64 + m * 16 + fr);
#pragma unroll
        for (int ai = 0; ai < 2; ++ai)
#pragma unroll
            for (int m = 0; m < 4; ++m) { const int row = row0 + ai * HALF + m * 16; const float rs = rsv[ai][m];
                float o[8];
                const f32x2 rs2 = (f32x2){rs, rs};
#pragma unroll
                for (int n = 0; n < 2; ++n)
#pragma unroll
                    for (int p = 0; p < 2; ++p) {
                        const f32x2 a2 = (f32x2){acc[ai][0][m][n][2 * p], acc[ai][0][m][n][2 * p + 1]}, g2 = (f32x2){acc[ai][1][m][n][2 * p], acc[ai][1][m][n][2 * p + 1]};
                        const f32x2 va = __builtin_elementwise_fma(a2, rs2, (f32x2){ba[n][2 * p], ba[n][2 * p + 1]}), vg = __builtin_elementwise_fma(g2, rs2, (f32x2){bg[n][2 * p], bg[n][2 * p + 1]});
                        const f32x2 sx = (MODE == 0 ? vg : va) * (f32x2){-LOG2E, -LOG2E};
                        f32x2 e; e[0] = __builtin_amdgcn_exp2f(sx[0]); e[1] = __builtin_amdgcn_exp2f(sx[1]);
                        const f32x2 den = e + (f32x2){1.0f, 1.0f};
                        f32x2 rc; rc[0] = __builtin_amdgcn_rcpf(den[0]); rc[1] = __builtin_amdgcn_rcpf(den[1]);
                        const f32x2 res = (MODE == 0) ? va * rc : (va * vg) * rc;
                        o[4 * n + 2 * p] = res[0]; o[4 * n + 2 * p + 1] = res[1]; }
                u32x4 w; w.x = cvt_pk_bf16(o[0], o[1]); w.y = cvt_pk_bf16(o[2], o[3]); w.z = cvt_pk_bf16(o[4], o[5]); w.w = cvt_pk_bf16(o[6], o[7]);
                *(u32x4*)(O + (size_t)row * ldc + col0) = w; }
    }
};

struct EpiResid {
    static constexpr bool NEEDS_RS = false;
    bf16_t* xb; float* ss; const float* bias;
    __device__ __forceinline__ void operator()(Acc& acc, const Unit& u, int wr, int wc, int fr, int fq, LAS unsigned char* lds) const {
        LAS float* X = (LAS float*)(lds + LDS_XCH);
        const int row0 = u.pm * BM + wr * 64 + fr, col0 = u.pn * BM + wc * 32 + 8 * fq;
        f32x4 bv[2][2];
#pragma unroll
        for (int bj = 0; bj < 2; ++bj)
#pragma unroll
            for (int n = 0; n < 2; ++n) bv[bj][n] = bias ? *(const f32x4*)(bias + col0 + bj * HALF + 4 * n) : (f32x4){0.f, 0.f, 0.f, 0.f};
#pragma unroll
        for (int ai = 0; ai < 2; ++ai) {
            u32x4 xpre[1][4][2];
#pragma unroll
            for (int m = 0; m < 4; ++m)
#pragma unroll
                for (int bj = 0; bj < 2; ++bj) xpre[0][m][bj] = *(const u32x4*)(xb + (size_t)(row0 + ai * HALF + m * 16) * DM + col0 + bj * HALF);
#pragma unroll
            for (int m = 0; m < 4; ++m) { const int row = row0 + ai * HALF + m * 16; const size_t ro = (size_t)row * DM + col0; float sq = 0.f;
#pragma unroll
                for (int bj = 0; bj < 2; ++bj) {
                    const u32x4 xin = xpre[0][m][bj];
                    const f32x4 x0 = (f32x4){h_lo(xin.x), h_hi(xin.x), h_lo(xin.y), h_hi(xin.y)}, x1 = (f32x4){h_lo(xin.z), h_hi(xin.z), h_lo(xin.w), h_hi(xin.w)};
                    const f32x4 v0 = acc[ai][bj][m][0] + bv[bj][0] + x0, v1 = acc[ai][bj][m][1] + bv[bj][1] + x1;
                    u32x4 w; w.x = cvt_pk_f16(v0[0], v0[1]); w.y = cvt_pk_f16(v0[2], v0[3]); w.z = cvt_pk_f16(v1[0], v1[1]); w.w = cvt_pk_f16(v1[2], v1[3]);
                    *(u32x4*)(xb + ro + bj * HALF) = w;
                    sq += (v0[0] * v0[0] + v0[1] * v0[1]) + (v0[2] * v0[2] + v0[3] * v0[3]) + (v1[0] * v1[0] + v1[1] * v1[1]) + (v1[2] * v1[2] + v1[3] * v1[3]); }
                sq += __shfl_xor(sq, 16); sq += __shfl_xor(sq, 32);
                if (fq == 0) X[(ai * HALF + wr * 64 + m * 16 + fr) * 4 + wc] = sq; } }
        asm volatile("s_waitcnt lgkmcnt(0)" ::: "memory"); __builtin_amdgcn_s_barrier(); asm volatile("" ::: "memory");
        { const int t = opaque_tid(); if (t < 256) { const f32x4 v = *(const LAS f32x4*)(X + t * 4); ss[(size_t)(u.pm * BM + t) * 4 + u.pn] = (v[0] + v[1]) + (v[2] + v[3]); } }
    }
};

struct EpiSoftmax {
    static constexpr bool NEEDS_RS = true;
    bf16_t* P; const float* ss;
    __device__ __forceinline__ void operator()(Acc& acc, const Unit& u, int wr, int wc, int fr, int fq, LAS unsigned char* lds) const {
        LAS f32x2* X = (LAS f32x2*)(lds + LDS_XCH);
        float mloc[2][4];
#pragma unroll
        for (int ai = 0; ai < 2; ++ai)
#pragma unroll
            for (int m = 0; m < 4; ++m) mloc[ai][m] = row_rs_lds(lds, ai * HALF + wr * 64 + m * 16 + fr);
#pragma unroll
        for (int ai = 0; ai < 2; ++ai)
#pragma unroll
            for (int m = 0; m < 4; ++m) { const int r = ai * HALF + wr * 64 + m * 16 + fr; const float rs = mloc[ai][m];
                float mx = -INFINITY;
#pragma unroll
                for (int bj = 0; bj < 2; ++bj)
#pragma unroll
                    for (int n = 0; n < 2; ++n) { f32x4 v = acc[ai][bj][m][n] * rs; acc[ai][bj][m][n] = v; mx = fmaxf(mx, fmaxf(fmaxf(v[0], v[1]), fmaxf(v[2], v[3]))); }
                mx = fmaxf(mx, __shfl_xor(mx, 16)); mx = fmaxf(mx, __shfl_xor(mx, 32));
                float sum = 0.f;
#pragma unroll
                for (int bj = 0; bj < 2; ++bj)
#pragma unroll
                    for (int n = 0; n < 2; ++n) { f32x4 v = acc[ai][bj][m][n];
#pragma unroll
                        for (int j = 0; j < 4; ++j) { v[j] = __builtin_amdgcn_exp2f(v[j] - mx); sum += v[j]; }
                        acc[ai][bj][m][n] = v; }
                sum += __shfl_xor(sum, 16); sum += __shfl_xor(sum, 32);
                if (fq == 0) X[r * 4 + wc] = (f32x2){mx, sum};
                mloc[ai][m] = mx; }
        asm volatile("s_waitcnt lgkmcnt(0)" ::: "memory"); __builtin_amdgcn_s_barrier(); asm volatile("" ::: "memory");
        const int col0 = u.pn * BM + wc * 32 + 8 * fq;
#pragma unroll
        for (int ai = 0; ai < 2; ++ai)
#pragma unroll
            for (int m = 0; m < 4; ++m) { const int r = ai * HALF + wr * 64 + m * 16 + fr;
                const f32x2 a = X[r * 4 + 0], b = X[r * 4 + 1], c = X[r * 4 + 2], d = X[r * 4 + 3];
                const float M = fmaxf(fmaxf(a[0], b[0]), fmaxf(c[0], d[0]));
                const float L = a[1] * __builtin_amdgcn_exp2f(a[0] - M) + b[1] * __builtin_amdgcn_exp2f(b[0] - M) + c[1] * __builtin_amdgcn_exp2f(c[0] - M) + d[1] * __builtin_amdgcn_exp2f(d[0] - M);
                const float f = __builtin_amdgcn_exp2f(mloc[ai][m] - M) / L;
                bf16_t* rowp = P + (size_t)(u.pm * BM + r) * DM + col0;
#pragma unroll
                for (int bj = 0; bj < 2; ++bj) { const f32x4 v0 = acc[ai][bj][m][0] * f, v1 = acc[ai][bj][m][1] * f;
                    u32x4 w; w.x = cvt_pk_bf16(v0[0], v0[1]); w.y = cvt_pk_bf16(v0[2], v0[3]); w.z = cvt_pk_bf16(v1[0], v1[1]); w.w = cvt_pk_bf16(v1[2], v1[3]);
                    *(u32x4*)(rowp + bj * HALF) = w; } }
        asm volatile("s_waitcnt lgkmcnt(0)" ::: "memory"); __builtin_amdgcn_s_barrier(); asm volatile("" ::: "memory");
    }
};

struct EpiQKV {
    static constexpr bool NEEDS_RS = true;
    bf16_t* Q; size_t sel_stride; const float* ss; const float* cs; const float* sn;
    __device__ __forceinline__ void operator()(Acc& acc, const Unit& u, int wr, int wc, int fr, int fq, LAS unsigned char* lds) const {
        const int sel = u.pn >> 2; bf16_t* dst = Q + (size_t)sel * sel_stride;
        const float scl = sel == 0 ? C2 : 1.0f;
        const bool rot = (sel < 2) && ((wc & 1) == 0) && (fq < 2);
        const int row0 = u.pm * BM + wr * 64 + fr, col0 = (u.pn & 3) * BM + wc * 32 + 8 * fq;
        float rsv[2][4];
#pragma unroll
        for (int ai = 0; ai < 2; ++ai)
#pragma unroll
            for (int m = 0; m < 4; ++m) rsv[ai][m] = row_rs_lds(lds, ai * HALF + wr * 64 + m * 16 + fr) * scl;
#pragma unroll
        for (int ai = 0; ai < 2; ++ai) {
            f32x4 cpre[4], spre[4];
#pragma unroll
            for (int m = 0; m < 4; ++m) { cpre[m] = (f32x4){1.f, 1.f, 1.f, 1.f}; spre[m] = (f32x4){0.f, 0.f, 0.f, 0.f};
                if (rot) { const size_t ro = (size_t)(row0 + ai * HALF + m * 16) * 8 + 4 * fq; cpre[m] = *(const f32x4*)(cs + ro); spre[m] = *(const f32x4*)(sn + ro); } }
#pragma unroll
            for (int m = 0; m < 4; ++m) { const int row = row0 + ai * HALF + m * 16; const float rs = rsv[ai][m];
                const f32x4 c4 = cpre[m], s4 = spre[m];
                bf16_t* rowp = dst + (size_t)row * DM + col0;
#pragma unroll
                for (int bj = 0; bj < 2; ++bj) { const f32x4 a0 = acc[ai][bj][m][0] * rs, a1 = acc[ai][bj][m][1] * rs;
                    f32x4 v0, v1;
                    v0[0] = a0[0] * c4[0] - a0[1] * s4[0]; v0[1] = a0[0] * s4[0] + a0[1] * c4[0];
                    v0[2] = a0[2] * c4[1] - a0[3] * s4[1]; v0[3] = a0[2] * s4[1] + a0[3] * c4[1];
                    v1[0] = a1[0] * c4[2] - a1[1] * s4[2]; v1[1] = a1[0] * s4[2] + a1[1] * c4[2];
                    v1[2] = a1[2] * c4[3] - a1[3] * s4[3]; v1[3] = a1[2] * s4[3] + a1[3] * c4[3];
                    u32x4 w; w.x = cvt_pk_bf16(v0[0], v0[1]); w.y = cvt_pk_bf16(v0[2], v0[3]); w.z = cvt_pk_bf16(v1[0], v1[1]); w.w = cvt_pk_bf16(v1[2], v1[3]);
                    *(u32x4*)(rowp + bj * HALF) = w; } } }
    }
};
}

namespace attn_body {
using bf16 = __hip_bfloat16;
using s16x4 = __attribute__((ext_vector_type(4))) short;
using f32x16 = __attribute__((ext_vector_type(16))) float;
constexpr int PITCH = 1024;
constexpr int NW = 8, QBLK = 32, QB = QBLK * NW, KVBLK = 64;
__device__ __forceinline__ int crow(int r, int hi) { return (r & 3) + 8 * (r >> 2) + 4 * hi; }
#define SBAR() __builtin_amdgcn_sched_barrier(0)
__device__ __forceinline__ void cmask(f32x16& p0, f32x16& p1, int jb, int qrel, int hi) {
  const float NEG = -INFINITY; int kb = 64 * jb + 4 * hi;
  #pragma unroll
  for (int r = 0; r < 16; ++r) { int kv = kb + (r & 3) + 8 * (r >> 2); if (kv > qrel) p0[r] = NEG; if (kv + 32 > qrel) p1[r] = NEG; }
}
constexpr int NSLOT = 3, SLOTB = 8192;
constexpr int LDS_K = 0, LDS_V = NSLOT * SLOTB, LDS_WS = 2 * NSLOT * SLOTB, LDS_OST = LDS_WS + NW * 64 * 4, LDS_ATT_BYTES = LDS_OST + NW * 4096;
__device__ __forceinline__ void glds16(const void* gsrc, unsigned lds_dst) { unsigned keep;
  asm volatile("s_mov_b32 %0, m0\n\ts_mov_b32 m0, %2\n\ts_nop 0\n\tglobal_load_lds_dwordx4 %1, off\n\ts_mov_b32 m0, %0" : "=&s"(keep) : "v"(gsrc), "s"(lds_dst) : "memory"); }
__device__ __forceinline__ void glds16s(const void* sbase, unsigned voff, unsigned lds_dst) { unsigned keep;
  asm volatile("s_mov_b32 %0, m0\n\ts_mov_b32 m0, %3\n\ts_nop 0\n\tglobal_load_lds_dwordx4 %1, %2\n\ts_mov_b32 m0, %0" : "=&s"(keep) : "v"(voff), "s"(sbase), "s"(lds_dst) : "memory"); }
__device__ __forceinline__ float max3f(float a, float b, float c) { float r; asm("v_max3_f32 %0, %1, %2, %3" : "=v"(r) : "v"(a), "v"(b), "v"(c)); return r; }
__device__ __forceinline__ float max2f(float a, float b) { float r; asm("v_max_f32_e32 %0, %1, %2" : "=v"(r) : "v"(a), "v"(b)); return r; }
__device__ __forceinline__ float fadd_s(float a, float b) { float r; asm("v_add_f32_e32 %0, %1, %2" : "=v"(r) : "v"(a), "v"(b)); return r; }
__device__ __forceinline__ float fsub_s(float a, float b) { float r; asm("v_sub_f32_e32 %0, %1, %2" : "=v"(r) : "v"(a), "v"(b)); return r; }
typedef float f32x2_t __attribute__((ext_vector_type(2))); typedef __bf16 bf16x2_t __attribute__((ext_vector_type(2)));
__device__ __forceinline__ unsigned cvtpk_s(float lo, float hi) { f32x2_t v = {lo, hi}; bf16x2_t b = __builtin_convertvector(v, bf16x2_t); return __builtin_bit_cast(unsigned, b); }
#define WAIT_BAR(N) asm volatile("s_waitcnt vmcnt(" #N ") lgkmcnt(0)\n\ts_barrier" ::: "memory")

__device__ __forceinline__ void qkt(f32x16& p0, f32x16& p1, const char* Kslot, const bf16x8* qr, const f32x16& negm, int r32, int hi) {
  const char* kb = Kslot + hi * 1024 + r32 * 16;
  #pragma unroll
  for (int d0 = 0; d0 < 4; ++d0) {
    const bf16x8 b0 = *reinterpret_cast<const bf16x8*>(kb + d0 * 2048);
    const bf16x8 b1 = *reinterpret_cast<const bf16x8*>(kb + d0 * 2048 + 512);
    if (d0 == 0) { p0 = __builtin_amdgcn_mfma_f32_32x32x16_bf16(b0, qr[0], negm, 0, 0, 0); p1 = __builtin_amdgcn_mfma_f32_32x32x16_bf16(b1, qr[0], negm, 0, 0, 0); }
    else { p0 = __builtin_amdgcn_mfma_f32_32x32x16_bf16(b0, qr[d0], p0, 0, 0, 0); p1 = __builtin_amdgcn_mfma_f32_32x32x16_bf16(b1, qr[d0], p1, 0, 0, 0); } }
}
typedef __attribute__((address_space(3))) const char* lds_cptr;
typedef short v4i16_t __attribute__((ext_vector_type(4)));
__device__ __forceinline__ void kload8(bf16x8* kf, lds_cptr kp) {
  kf[0] = *(const __attribute__((address_space(3))) bf16x8*)(kp);        kf[1] = *(const __attribute__((address_space(3))) bf16x8*)(kp + 512);
  kf[2] = *(const __attribute__((address_space(3))) bf16x8*)(kp + 2048); kf[3] = *(const __attribute__((address_space(3))) bf16x8*)(kp + 2560);
  kf[4] = *(const __attribute__((address_space(3))) bf16x8*)(kp + 4096); kf[5] = *(const __attribute__((address_space(3))) bf16x8*)(kp + 4608);
  kf[6] = *(const __attribute__((address_space(3))) bf16x8*)(kp + 6144); kf[7] = *(const __attribute__((address_space(3))) bf16x8*)(kp + 6656);
}
__device__ __forceinline__ void kload2(bf16x8* kf, lds_cptr kp, int j) { kf[2 * j] = *(const __attribute__((address_space(3))) bf16x8*)(kp + j * 2048); kf[2 * j + 1] = *(const __attribute__((address_space(3))) bf16x8*)(kp + j * 2048 + 512); }
__device__ __forceinline__ s16x4 vtr(lds_cptr p) { return __builtin_bit_cast(s16x4, __builtin_amdgcn_ds_read_tr16_b64_v4i16((__attribute__((address_space(3))) v4i16_t*)p)); }
__device__ __forceinline__ float rowmax(const f32x16& p0, const f32x16& p1) {
  float a = max3f(p0[0], p0[1], p1[0]), b = max3f(p0[2], p0[3], p1[1]); a = max3f(a, p1[2], p1[3]);
  #pragma unroll
  for (int r = 4; r < 16; r += 4) { a = max3f(a, p0[r], p0[r + 1]); b = max3f(b, p0[r + 2], p0[r + 3]); a = max3f(a, p1[r], p1[r + 1]); b = max3f(b, p1[r + 2], p1[r + 3]); }
  const float m = max2f(a, b);
  auto rr = __builtin_amdgcn_permlane32_swap(__float_as_uint(m), __float_as_uint(m), false, false);
  return max2f(__uint_as_float(rr[0]), __uint_as_float(rr[1]));
}
__device__ __forceinline__ void pv(f32x16* o, int vb, bf16x8 pa0, bf16x8 pa1, bf16x8 pa2, bf16x8 pa3) {
  #pragma unroll
  for (int d0 = 0; d0 < 2; ++d0) { s16x4 lo[4], hi[4];
    #pragma unroll
    for (int ks = 0; ks < 4; ++ks) {
      asm volatile("ds_read_b64_tr_b16 %0,%1 offset:%c2" : "=&v"(lo[ks]) : "v"(vb), "i"(d0 * 4096 + ks * 1024) : "memory");
      asm volatile("ds_read_b64_tr_b16 %0,%1 offset:%c2" : "=&v"(hi[ks]) : "v"(vb), "i"(d0 * 4096 + ks * 1024 + 512) : "memory"); }
    asm volatile("s_waitcnt lgkmcnt(0)" ::: "memory"); SBAR();
    #define PK(k) (bf16x8){lo[k][0], lo[k][1], lo[k][2], lo[k][3], hi[k][0], hi[k][1], hi[k][2], hi[k][3]}
    o[d0] = __builtin_amdgcn_mfma_f32_32x32x16_bf16(pa0, PK(0), o[d0], 0, 0, 0);
    o[d0] = __builtin_amdgcn_mfma_f32_32x32x16_bf16(pa1, PK(1), o[d0], 0, 0, 0);
    o[d0] = __builtin_amdgcn_mfma_f32_32x32x16_bf16(pa2, PK(2), o[d0], 0, 0, 0);
    o[d0] = __builtin_amdgcn_mfma_f32_32x32x16_bf16(pa3, PK(3), o[d0], 0, 0, 0);
    #undef PK
  }
}

constexpr int LDS2_GTAB = 142336;
static_assert(LDS2_GTAB == LDS_GTAB, "attention gain table offset");
constexpr int LDS2_V = NSLOT * SLOTB, LDS2_WS = LDS2_V + NSLOT * 2 * SLOTB, LDS2_OST = LDS2_WS + NW * 64 * 4, LDS_ATT2_BYTES = LDS2_OST + NW * 8192;
template<int THRL, int MODE> __device__ __forceinline__ void attn_unit2(int b, int qcol, int kcol, int vcol, int ocol, int qb, const bf16* Q, const bf16* __restrict__ K, const bf16* __restrict__ V, bf16* O, char* shm) {
  constexpr int DMP = PITCH;
  const int tid = opaque_tid(), lane = tid & 63, r32 = lane & 31, hi = lane >> 5; const int wid = __builtin_amdgcn_readfirstlane(tid >> 6);
  const long rowbase = (long)b * SEQ; const int q0 = qb * QB;
  const bf16* Qw = Q + (rowbase + q0 + wid * QBLK) * DMP + qcol;
  const bf16* Kh = K + rowbase * DMP + kcol, *Vh = V + rowbase * DMP + vcol;
  const unsigned lds0 = (unsigned)(uintptr_t)shm;
  float* wsf = (float*)(shm + LDS2_WS) + wid * 64;
  const unsigned koff = (unsigned)(lane * DMP + wid * 8) * 2u;
  const unsigned voff = (unsigned)((16 * (wid & 3) + (lane >> 2)) * DMP + (wid >> 2) * 32 + (lane & 3) * 8) * 2u;
  const unsigned kdst = lds0 + LDS_K + wid * 1024, vdst = lds0 + LDS2_V + wid * 1024;
  #define DMA_K(t, slot) glds16s(Kh + (long)(t) * KVBLK * DMP, koff, (unsigned)__builtin_amdgcn_readfirstlane(kdst + (slot)))
  #define DMA_V(t, slot) do { glds16s(Vh + (long)(t) * KVBLK * DMP, voff, (unsigned)__builtin_amdgcn_readfirstlane(vdst + 2 * (slot))); \
    glds16s(Vh + (long)(t) * KVBLK * DMP + 64, voff, (unsigned)__builtin_amdgcn_readfirstlane(vdst + 2 * (slot) + 8192)); } while (0)
  const char* Kbase = shm + LDS_K; bf16x8 kf[8];
  const lds_cptr shm3 = (lds_cptr)shm; const lds_cptr kp0 = shm3 + LDS_K + hi * 1024 + r32 * 16; const lds_cptr vp0 = shm3 + LDS2_V + ((lane >> 4) & 1) * 32 + (lane & 3) * 8 + (4 * hi + ((lane & 15) >> 2)) * 64;
  const int NT = (q0 + QB) / KVBLK;
  DMA_K(0, 0); DMA_V(0, 0); DMA_K(1, SLOTB);
  bf16x8 qr[4];
  #pragma unroll
  for (int d0 = 0; d0 < 4; ++d0) qr[d0] = *reinterpret_cast<const bf16x8*>(&Qw[(long)r32 * DMP + d0 * 16 + hi * 8]);
  float mhat = 0.f, l_reg = 0.f; f32x16 o[4]; o[0] = f32x16{}; o[1] = f32x16{}; o[2] = f32x16{}; o[3] = f32x16{}; const f32x16 zc = f32x16{};
  #define CMASK(P0, P1, t) do { int jb_ = (t) - (NT - 4); if (jb_ >= 0) { const int ln_ = opaque_tid() & 63; cmask(P0, P1, jb_, wid * QBLK + (ln_ & 31), ln_ >> 5); } } while (0)
  bool resc = false;
  #define START(P0, P1) do { const float rm = rowmax(P0, P1); resc = false; \
    { const float dl = rm; mhat = fadd_s(mhat, dl); \
      _Pragma("unroll") for (int r = 0; r < 16; ++r) { P0[r] = fsub_s(P0[r], dl); P1[r] = fsub_s(P1[r], dl); } \
      } \
    _Pragma("unroll") for (int r = 0; r < 16; ++r) P0[r] = __builtin_amdgcn_exp2f(P0[r]); } while (0)
  #define RESC() do { if (resc) { asm volatile("s_waitcnt lgkmcnt(0)" ::: "memory"); \
      _Pragma("unroll") for (int d_ = 0; d_ < 4; ++d_) _Pragma("unroll") for (int r = 0; r < 16; ++r) o[d_][r] *= wsf[crow(r, hi)]; } } while (0)
  f32x16 pA0, pA1, pB0, pB1;
  int sl_prev = 0, sl_cur = 0, sl_next = SLOTB;
  #define ROT() do { sl_prev = sl_cur; sl_cur = sl_next; sl_next = (sl_next == (NSLOT - 1) * SLOTB) ? 0 : sl_next + SLOTB; } while (0)
  DMA_K(2, 2 * SLOTB);
  WAIT_BAR(3);
  qkt(pA0, pA1, Kbase, qr, zc, r32, hi); asm volatile("s_nop 15\n\ts_nop 7" : "+v"(pA0), "+v"(pA1)); CMASK(pA0, pA1, 0);
  START(pA0, pA1);
  _Pragma("unroll") for (int r = 0; r < 16; ++r) pA1[r] = __builtin_amdgcn_exp2f(pA1[r]);
  WAIT_BAR(0);
  DMA_K(3, 0); DMA_V(1, SLOTB);
  ROT();
  kload8(kf, kp0 + sl_cur);
  WAIT_BAR(3);
  s16x4 vlo[8], vhi[8]; u32x4 pw0, pw1, pw2, pw3;
  #define PKW(P, B) cvtpk_s(P[B], P[B + 1])
  #define PAF(k) __builtin_bit_cast(bf16x8, pw##k)
  #define VFR(i) (bf16x8){vlo[i][0], vlo[i][1], vlo[i][2], vlo[i][3], vhi[i][0], vhi[i][1], vhi[i][2], vhi[i][3]}
  #define PIN(x) asm volatile("" : "+v"(x))
  #define MX3(a, b, c) __builtin_fmaxf(__builtin_fmaxf((a), (b)), (c))
  #define GAPA(MF, A0, A1, A2, A3, W0, W1, PW) do { MF; sacc += A0; sacc += A1; sacc += A2; sacc += A3; PIN(sacc); W0; W1; PIN(PW); SBAR(); } while (0)
  #define EX(v) __builtin_amdgcn_exp2f(v)
  #define GAPB(MF, X, B) do { MF; X[B] = EX(X[B]); X[B + 1] = EX(X[B + 1]); PIN(X); SBAR(); } while (0)
  #define VRD(i) do { vlo[i] = vtr(vp_ + (((i) >> 2) * 4096 + ((i) & 3) * 1024)); vhi[i] = vtr(vp_ + (((i) >> 2) * 4096 + ((i) & 3) * 1024 + 512)); } while (0)
  #define VRD2(i) do { vlo[i] = vtr(vp_ + (8192 + ((i) >> 2) * 4096 + ((i) & 3) * 1024)); vhi[i] = vtr(vp_ + (8192 + ((i) >> 2) * 4096 + ((i) & 3) * 1024 + 512)); SBAR(); } while (0)
  #define KRD(G, j) do { if (G) { kload2(kf, kp0 + sl_next, j); SBAR(); } } while (0)
  #define STEP(C0, C1, P0, P1, t, GK, GV, GL) do { SBAR(); \
    const lds_cptr vp_ = vp0 + 2 * sl_prev; \
    VRD(0); SBAR(); float sacc = (P0[0] + P0[1]); \
    GAPA(C0 = __builtin_amdgcn_mfma_f32_32x32x16_bf16(kf[0], qr[0], zc, 0, 0, 0), P0[2], P0[3], P0[4], P0[5],     pw0[0] = PKW(P0, 0), pw0[1] = PKW(P0, 2), pw0); \
    VRD(4); SBAR(); GAPA(C1 = __builtin_amdgcn_mfma_f32_32x32x16_bf16(kf[1], qr[0], zc, 0, 0, 0), P0[6], P0[7], P0[8], P0[9],     pw0[2] = PKW(P0, 4), pw0[3] = PKW(P0, 6), pw0); \
    VRD(1); SBAR(); GAPA(C0 = __builtin_amdgcn_mfma_f32_32x32x16_bf16(kf[2], qr[1], C0, 0, 0, 0),   P0[10], P0[11], P0[12], P0[13], pw1[0] = PKW(P0, 8), pw1[1] = PKW(P0, 10), pw1); \
    VRD(5); SBAR(); GAPA(C1 = __builtin_amdgcn_mfma_f32_32x32x16_bf16(kf[3], qr[1], C1, 0, 0, 0),   P0[14], P0[15], P1[0], P1[1],   pw1[2] = PKW(P0, 12), pw1[3] = PKW(P0, 14), pw1); \
    VRD(2); SBAR(); GAPA(C0 = __builtin_amdgcn_mfma_f32_32x32x16_bf16(kf[4], qr[2], C0, 0, 0, 0),   P1[2], P1[3], P1[4], P1[5],     pw2[0] = PKW(P1, 0), pw2[1] = PKW(P1, 2), pw2); \
    VRD(6); SBAR(); GAPA(C1 = __builtin_amdgcn_mfma_f32_32x32x16_bf16(kf[5], qr[2], C1, 0, 0, 0),   P1[6], P1[7], P1[8], P1[9],     pw2[2] = PKW(P1, 4), pw2[3] = PKW(P1, 6), pw2); \
    VRD(3); SBAR(); GAPA(C0 = __builtin_amdgcn_mfma_f32_32x32x16_bf16(kf[6], qr[3], C0, 0, 0, 0),   P1[10], P1[11], P1[12], P1[13], pw3[0] = PKW(P1, 8), pw3[1] = PKW(P1, 10), pw3); \
    VRD(7); SBAR(); GAPA(C1 = __builtin_amdgcn_mfma_f32_32x32x16_bf16(kf[7], qr[3], C1, 0, 0, 0),   P1[14], P1[15], 0.f, 0.f,       pw3[2] = PKW(P1, 12), pw3[3] = PKW(P1, 14), pw3); \
    l_reg += sacc; \
    _Pragma("unroll") for (int r = 0; r < 16; ++r) { C0[r] -= mhat; C1[r] -= mhat; } \
    if (GK) { DMA_K((t) + 3, sl_cur); } if (GV) { DMA_V((t) + 1, sl_next); } \
    CMASK(C0, C1, t); \
    { float a = MX3(C0[0], C0[1], C1[0]), b = MX3(C0[2], C0[3], C1[1]); a = MX3(a, C1[2], C1[3]); \
      _Pragma("unroll") for (int r = 4; r < 16; r += 4) { a = MX3(a, C0[r], C0[r + 1]); b = MX3(b, C0[r + 2], C0[r + 3]); a = MX3(a, C1[r], C1[r + 1]); b = MX3(b, C1[r + 2], C1[r + 3]); } \
      float rm = __builtin_fmaxf(a, b); { auto rr = __builtin_amdgcn_permlane32_swap(__float_as_uint(rm), __float_as_uint(rm), false, false); rm = __builtin_fmaxf(__uint_as_float(rr[0]), __uint_as_float(rr[1])); } \
      resc = false; \
      if (__builtin_expect(__any(rm > (float)THRL), 0)) { const float dl = __builtin_fmaxf(rm, 0.f); mhat += dl; \
        _Pragma("unroll") for (int r = 0; r < 16; ++r) { C0[r] -= dl; C1[r] -= dl; } \
        const float f = __builtin_amdgcn_exp2f(-dl); l_reg *= f; if (hi == 0) wsf[r32] = f; resc = true; } } \
    SBAR(); \
    GAPB(o[0] = __builtin_amdgcn_mfma_f32_32x32x16_bf16(PAF(0), VFR(0), o[0], 0, 0, 0), C0, 0); VRD2(0); \
    GAPB(o[1] = __builtin_amdgcn_mfma_f32_32x32x16_bf16(PAF(0), VFR(4), o[1], 0, 0, 0), C0, 2); VRD2(4); \
    KRD(GL, 0); GAPB(o[0] = __builtin_amdgcn_mfma_f32_32x32x16_bf16(PAF(1), VFR(1), o[0], 0, 0, 0), C0, 4); VRD2(1); \
    KRD(GL, 1); GAPB(o[1] = __builtin_amdgcn_mfma_f32_32x32x16_bf16(PAF(1), VFR(5), o[1], 0, 0, 0), C0, 6); VRD2(5); \
    KRD(GL, 2); GAPB(o[0] = __builtin_amdgcn_mfma_f32_32x32x16_bf16(PAF(2), VFR(2), o[0], 0, 0, 0), C0, 8); VRD2(2); \
    KRD(GL, 3); GAPB(o[1] = __builtin_amdgcn_mfma_f32_32x32x16_bf16(PAF(2), VFR(6), o[1], 0, 0, 0), C0, 10); VRD2(6); \
    GAPB(o[0] = __builtin_amdgcn_mfma_f32_32x32x16_bf16(PAF(3), VFR(3), o[0], 0, 0, 0), C0, 12); VRD2(3); \
    GAPB(o[1] = __builtin_amdgcn_mfma_f32_32x32x16_bf16(PAF(3), VFR(7), o[1], 0, 0, 0), C0, 14); VRD2(7); \
    GAPB(o[2] = __builtin_amdgcn_mfma_f32_32x32x16_bf16(PAF(0), VFR(0), o[2], 0, 0, 0), C1, 0); \
    GAPB(o[3] = __builtin_amdgcn_mfma_f32_32x32x16_bf16(PAF(0), VFR(4), o[3], 0, 0, 0), C1, 2); \
    GAPB(o[2] = __builtin_amdgcn_mfma_f32_32x32x16_bf16(PAF(1), VFR(1), o[2], 0, 0, 0), C1, 4); \
    GAPB(o[3] = __builtin_amdgcn_mfma_f32_32x32x16_bf16(PAF(1), VFR(5), o[3], 0, 0, 0), C1, 6); \
    GAPB(o[2] = __builtin_amdgcn_mfma_f32_32x32x16_bf16(PAF(2), VFR(2), o[2], 0, 0, 0), C1, 8); \
    GAPB(o[3] = __builtin_amdgcn_mfma_f32_32x32x16_bf16(PAF(2), VFR(6), o[3], 0, 0, 0), C1, 10); \
    GAPB(o[2] = __builtin_amdgcn_mfma_f32_32x32x16_bf16(PAF(3), VFR(3), o[2], 0, 0, 0), C1, 12); \
    GAPB(o[3] = __builtin_amdgcn_mfma_f32_32x32x16_bf16(PAF(3), VFR(7), o[3], 0, 0, 0), C1, 14); \
    } while (0)
  int t = 1;
  #undef CMASK
  #define CMASK(P0, P1, t) do {} while (0)
  for (; t + 5 < NT; t += 2) {
    STEP(pB0, pB1, pA0, pA1, t, true, true, true);     WAIT_BAR(3); RESC(); ROT();
    STEP(pA0, pA1, pB0, pB1, t + 1, true, true, true); WAIT_BAR(3); RESC(); ROT();
  }
  #undef CMASK
  #define CMASK(P0, P1, t) do { int jb_ = (t) - (NT - 4); if (jb_ >= 0) { const int ln_ = opaque_tid() & 63; cmask(P0, P1, jb_, wid * QBLK + (ln_ & 31), ln_ >> 5); } } while (0)
  #define ENDW(tt) do { if ((tt) + 3 < NT) { WAIT_BAR(3); } else if ((tt) + 2 < NT) { WAIT_BAR(2); } else { WAIT_BAR(0); } } while (0)
  for (; t + 1 < NT; t += 2) {
    STEP(pB0, pB1, pA0, pA1, t, (t + 3 < NT), (t + 1 < NT), (t + 1 < NT));         ENDW(t);     RESC(); ROT();
    STEP(pA0, pA1, pB0, pB1, t + 1, (t + 4 < NT), (t + 2 < NT), (t + 2 < NT));     ENDW(t + 1); RESC(); ROT();
  }
  STEP(pB0, pB1, pA0, pA1, NT - 1, false, false, false); RESC();
  { float sacc = pB0[0] + pB0[1]; _Pragma("unroll") for (int r = 2; r < 16; ++r) sacc += pB0[r]; _Pragma("unroll") for (int r = 0; r < 16; ++r) sacc += pB1[r]; l_reg += sacc;
    pw0 = (u32x4){PKW(pB0, 0), PKW(pB0, 2), PKW(pB0, 4), PKW(pB0, 6)}; pw1 = (u32x4){PKW(pB0, 8), PKW(pB0, 10), PKW(pB0, 12), PKW(pB0, 14)}; pw2 = (u32x4){PKW(pB1, 0), PKW(pB1, 2), PKW(pB1, 4), PKW(pB1, 6)}; pw3 = (u32x4){PKW(pB1, 8), PKW(pB1, 10), PKW(pB1, 12), PKW(pB1, 14)};
    SBAR(); const int ln_ = opaque_tid() & 63; const int vb0 = (int)(lds0 + LDS2_V) + ((ln_ >> 4) & 1) * 32 + (ln_ & 3) * 8 + (4 * (ln_ >> 5) + ((ln_ & 15) >> 2)) * 64;
    pv(o, vb0 + 2 * sl_cur, PAF(0), PAF(1), PAF(2), PAF(3)); pv(o + 2, vb0 + 2 * sl_cur + 8192, PAF(0), PAF(1), PAF(2), PAF(3)); }
  #undef PKW
  #undef PAF
  #undef VFR
  #undef PIN
  #undef MX3
  #undef GAPA
  #undef GAPB
  #undef EX
  #undef VRD
  #undef VRD2
  #undef KRD
  #undef STEP
  #undef ENDW
  { auto rr = __builtin_amdgcn_permlane32_swap(__float_as_uint(l_reg), __float_as_uint(l_reg), false, false); l_reg = __uint_as_float(rr[0]) + __uint_as_float(rr[1]); }
  if (hi == 0) wsf[32 + r32] = l_reg; asm volatile("s_waitcnt lgkmcnt(0)" ::: "memory");
  float rli[16];
  #pragma unroll
  for (int r = 0; r < 16; ++r) rli[r] = __builtin_amdgcn_rcpf(wsf[32 + crow(r, hi)]);
  bf16* Ow = O + (rowbase + q0 + wid * QBLK) * DMP + ocol;
  { bf16* stg = (bf16*)(shm + LDS2_OST) + wid * 4096;
    if (MODE == 1) {
      #pragma unroll
      for (int r = 0; r < 16; ++r) { const int orow = crow(r, hi);
        #pragma unroll
        for (int d0 = 0; d0 < 4; ++d0) stg[orow * 128 + d0 * 32 + r32] = __float2bfloat16(o[d0][r] * rli[r]); }
      asm volatile("s_waitcnt lgkmcnt(0)" ::: "memory");
    } else {
      const float* gain = (const float*)(shm + LDS2_GTAB);
      const float lam = gain[128];
      float gn[4];
      #pragma unroll
      for (int d0 = 0; d0 < 4; ++d0) gn[d0] = gain[d0 * 32 + r32];
      #pragma unroll
      for (int r = 0; r < 16; ++r) { const int orow = crow(r, hi); float sq = 0.f;
        #pragma unroll
        for (int d0 = 0; d0 < 4; ++d0) { const float d = __bfloat162float(stg[orow * 128 + d0 * 32 + r32]) - lam * (o[d0][r] * rli[r]); o[d0][r] = d; sq += d * d; }
        sq += __shfl_xor(sq, 1); sq += __shfl_xor(sq, 2); sq += __shfl_xor(sq, 4); sq += __shfl_xor(sq, 8); sq += __shfl_xor(sq, 16);
        const float rs = rsqrtf(sq * (1.0f / 128.0f) + 1e-5f);
        #pragma unroll
        for (int d0 = 0; d0 < 4; ++d0) stg[orow * 128 + d0 * 32 + r32] = __float2bfloat16(o[d0][r] * rs * gn[d0]); }
      asm volatile("s_waitcnt lgkmcnt(0)" ::: "memory");
      #pragma unroll
      for (int i = 0; i < 8; ++i) { const int row = i * 4 + (lane >> 4), ch = lane & 15; const u32x4 v = *(const u32x4*)(stg + row * 128 + ch * 8); *(u32x4*)(Ow + (long)row * DMP + ch * 8) = v; } } }
  asm volatile("s_waitcnt lgkmcnt(0)\n\ts_barrier" ::: "memory");
  #undef DMA_K
  #undef DMA_V
  #undef CMASK
  #undef START
  #undef RESC
  #undef ROT
}
#undef SBAR
#undef WAIT_BAR
}

#define XB_TMO      128
#define XB_XCNT(j)  (256  + 64 * (j))
#define XB_XSUB(j)  (1280 + 64 * (j))
#define XB_XGEN(j)  (2304 + 64 * (j))
#define XB_TOP      3328
#define XB_TOPGEN   3392
#define XCD_BAR_WORDS 3456
#define XB_SPIN_CAP (1u << 18)
__device__ __forceinline__ unsigned xb_ld(unsigned* p)              { return __hip_atomic_load(p, __ATOMIC_RELAXED, __HIP_MEMORY_SCOPE_AGENT); }
__device__ __forceinline__ unsigned xb_add(unsigned* p, unsigned v) { return __hip_atomic_fetch_add(p, v, __ATOMIC_RELAXED, __HIP_MEMORY_SCOPE_AGENT); }
__device__ __forceinline__ unsigned xb_xcc_id() { return (unsigned)__builtin_amdgcn_s_getreg((3 << 11) | 20) & 0xFu; }
#define XB_SPIN(cond, bar) do { unsigned _sp = 0; while (cond) { __builtin_amdgcn_s_sleep(1); \
    if ((++_sp & 255u) == 0u) { if (xb_ld(&(bar)[XB_TMO])) break; if (_sp > XB_SPIN_CAP) { atomicAdd(&(bar)[XB_TMO], 1u); break; } } } } while (0)
struct XcdBarrier { unsigned* bar; unsigned x; volatile LAS unsigned* st; };
__device__ __forceinline__ XcdBarrier xcd_barrier_post(unsigned* bar, volatile LAS unsigned* st) {
    XcdBarrier b; b.bar = bar; b.x = xb_xcc_id(); b.st = st;
    if (threadIdx.x == 0) (void)xb_add(&bar[XB_XCNT(b.x)], 1u);
    return b;
}
__device__ __forceinline__ void xcd_barrier_complete(unsigned* bar, unsigned x, unsigned& nloc, unsigned& nx) {
    const unsigned G = gridDim.x * gridDim.y * gridDim.z;
    unsigned sum, cnt, mine, sp = 0u;
    for (;;) {
        sum = 0u; cnt = 0u; mine = 0u;
#pragma unroll
        for (unsigned j = 0; j < 16; ++j) { const unsigned c = xb_ld(&bar[XB_XCNT(j)]); sum += c; cnt += (c > 0u) ? 1u : 0u; mine = (j == x) ? c : mine; }
        if (sum == G) break;
        __builtin_amdgcn_s_sleep(1);
        if ((++sp & 255u) == 0u) { if (xb_ld(&bar[XB_TMO])) break; if (sp > XB_SPIN_CAP) { atomicAdd(&bar[XB_TMO], 1u); break; } }
    }
    nloc = mine > 0u ? mine : 1u; nx = cnt > 0u ? cnt : 1u;
}
__device__ __forceinline__ void xcd_barrier(const XcdBarrier& b) {
    asm volatile("s_waitcnt vmcnt(0)" ::: "memory");
    __syncthreads();
    if (threadIdx.x == 0) {
        unsigned* bar = b.bar;
        __builtin_amdgcn_s_waitcnt(0);
        unsigned nloc = b.st[0], nx = b.st[1];
        if (nloc == 0u) { xcd_barrier_complete(bar, b.x, nloc, nx); b.st[0] = nloc; b.st[1] = nx; }
        const unsigned old = xb_add(&bar[XB_XSUB(b.x)], 1u);
        const unsigned gen = old / nloc;
        if (old + 1u == (gen + 1u) * nloc) {
            __builtin_amdgcn_fence(__ATOMIC_RELEASE, "agent");
            asm volatile("s_waitcnt vmcnt(0)" ::: "memory");
            const unsigned og = xb_add(&bar[XB_TOP], 1u);
            const unsigned tg = og / nx;
            if (og + 1u == (tg + 1u) * nx) xb_add(&bar[XB_TOPGEN], 1u);
            else XB_SPIN(xb_ld(&bar[XB_TOPGEN]) == tg, bar);
            __builtin_amdgcn_fence(__ATOMIC_ACQUIRE, "agent");
            xb_add(&bar[XB_XGEN(b.x)], 1u);
            asm volatile("s_waitcnt vmcnt(0)" ::: "memory");
        } else {
            XB_SPIN(xb_ld(&bar[XB_XGEN(b.x)]) == gen, bar);
            __builtin_amdgcn_fence(__ATOMIC_ACQUIRE, "agent");
            asm volatile("s_waitcnt vmcnt(0)" ::: "memory");
        }
    }
    __syncthreads();
}

__device__ __forceinline__ int map_row(int n, int mode, int arg) {
    if (mode == 1) return (n >> 7) * 256 + arg * 128 + (n & 127);
    if (mode == 2) { const int d = n & 63; if (d < 16) { const int dp = d < 8 ? 2 * d : 2 * (d - 8) + 1; return n - d + dp; } return n; }
    return n;
}
__device__ __forceinline__ void cvt_item(const float* W, int ldw, int K, int ncols, bf16_t* WT, const float* g, float scale, int mode, int arg, LAS float* scr, int item, int lane, int f16 = 0) {
    const int nblk = ncols / 64, kb = item / nblk, nb = item % nblk, k0 = 64 * kb, n0 = 64 * nb;
#pragma unroll
    for (int i = 0; i < 16; ++i) { const int kk = 4 * i + (lane >> 4); const float gs = g ? g[k0 + kk] * scale : scale;
        const f32x4 v = *(const f32x4*)(W + (size_t)(k0 + kk) * ldw + n0 + (lane & 15) * 4) * gs;
        LAS float* d = scr + kk * 65 + (lane & 15) * 4; d[0] = v[0]; d[1] = v[1]; d[2] = v[2]; d[3] = v[3]; }
    asm volatile("s_waitcnt lgkmcnt(0)" ::: "memory");
    const int c = lane & 7;
#pragma unroll
    for (int j = 0; j < 8; ++j) { const int n = (lane >> 3) + 8 * j; const LAS float* s = scr + (8 * c) * 65 + n;
        u32x4 o;
        if (f16) { o.x = cvt_pk_f16(s[0 * 65], s[1 * 65]); o.y = cvt_pk_f16(s[2 * 65], s[3 * 65]); o.z = cvt_pk_f16(s[4 * 65], s[5 * 65]); o.w = cvt_pk_f16(s[6 * 65], s[7 * 65]); }
        else { o.x = cvt_pk_bf16(s[0 * 65], s[1 * 65]); o.y = cvt_pk_bf16(s[2 * 65], s[3 * 65]); o.z = cvt_pk_bf16(s[4 * 65], s[5 * 65]); o.w = cvt_pk_bf16(s[6 * 65], s[7 * 65]); }
        *(u32x4*)(WT + (size_t)map_row(n0 + n, mode, arg) * K + k0 + 8 * c) = o; }
    asm volatile("s_waitcnt lgkmcnt(0)" ::: "memory");
}

struct Args { const void* in[34]; int ph_lo, ph_hi; };
__device__ __forceinline__ const void* ldarg(const Args& a, int k) { asm volatile("" : "+s"(k)); return a.in[k]; }
#define FARG(k) ((const float*)ldarg(args, k))
#define WSP(off) ((bf16_t*)((unsigned char*)ldarg(args, 33) + (off)))

__device__ __forceinline__ void convert_layer(const Args& args, int l, int parts, LAS float* scr, int gw, int NGW, int lane, int gtid, int NGT) {
    const int I1K = 16 * 16;
    const int IGU = 16 * (FF / 64), IDN = (FF / 64) * 16;
    const int n0 = 4 * I1K + I1K, n1 = n0 + 2 * IGU, total = n1 + IDN;
    for (int seg = 0; seg < 3; ++seg) {
        const int bit = seg == 0 ? 1 : (seg == 1 ? 4 : 2); if (!(parts & bit)) continue;
        const int it_lo = seg == 0 ? 0 : (seg == 1 ? n0 : n1), it_hi = seg == 0 ? n0 : (seg == 1 ? n1 : total);
    for (int it = it_lo + gw; it < it_hi; it += NGW) {
        int r = it;
#define CVT(Wp, ldw, K, ncols, WTp, gp, sc, mode, arg, F16_) { const int ni = ((K) / 64) * ((ncols) / 64); if (r >= 0 && r < ni) cvt_item(Wp, ldw, K, ncols, WTp, gp, sc, mode, arg, scr, r, lane, F16_); r -= ni; }
        if (l < 2) {
            CVT(FARG(7) + (size_t)l * DM * 2 * DM, 2 * DM, DM, DM, WSP(WS_WMIX), FARG(3) + l * DM, 1.f, 1, 0, 1);
            CVT(FARG(7) + (size_t)l * DM * 2 * DM + DM, 2 * DM, DM, DM, WSP(WS_WMIX), FARG(3) + l * DM, 1.f, 1, 1, 1);
            CVT(FARG(13) + (size_t)l * DM * DM, DM, DM, DM, WSP(WS_WMIX) + (size_t)2 * DM * DM, nullptr, 1.f, 0, 0, 0);
            r -= I1K;
        } else {
            const int b = l - 2;
            CVT(FARG(18) + (size_t)b * DM * DM, DM, DM, DM, WSP(WS_WMIX), FARG(3) + l * DM, 1.f, 2, 0, 1);
            CVT(FARG(24) + (size_t)b * DM * DM, DM, DM, DM, WSP(WS_WMIX) + (size_t)3 * DM * DM, nullptr, 1.f, 0, 0, 0);
            if (l == 2) {
                CVT(FARG(16), DM, DM, DM, WSP(WS_WMIX) + (size_t)DM * DM, FARG(15), 1.f, 2, 0, 1);
                CVT(FARG(17), DM, DM, DM, WSP(WS_WMIX) + (size_t)2 * DM * DM, FARG(15), 1.f, 0, 0, 1);
            } else r -= 2 * I1K;
        }
        CVT(FARG(28) + (size_t)l * DM * DM, DM, DM, DM, WSP(WS_WOT), nullptr, 1.f, 0, 0, 0);
        CVT(FARG(29) + (size_t)l * DM * FF, FF, DM, FF, WSP(WS_WGU), FARG(5) + l * DM, 1.f, 1, 0, 1);
        CVT(FARG(30) + (size_t)l * DM * FF, FF, DM, FF, WSP(WS_WGU), FARG(5) + l * DM, 1.f, 1, 1, 1);
        CVT(FARG(31) + (size_t)l * FF * DM, DM, FF, DM, WSP(WS_WD), nullptr, 1.f, 0, 0, 0);
#undef CVT
    } }
    if (parts & 1) { const float* wq = FARG(25) + (size_t)l * DM * DM; bf16_t* o = WSP(WS_WQS); const float* norm_mem = FARG(4) + l * DM;
      for (int i = gtid; i < DM * DM / 8; i += NGT) { const int k = i >> 7; const float gs = norm_mem[k] * (0.0625f * LOG2E);
          const f32x4 v0 = *(const f32x4*)(wq + (size_t)i * 8) * gs, v1 = *(const f32x4*)(wq + (size_t)i * 8 + 4) * gs;
          u32x4 w; w.x = cvt_pk_bf16(v0[0], v0[1]); w.y = cvt_pk_bf16(v0[2], v0[3]); w.z = cvt_pk_bf16(v1[0], v1[1]); w.w = cvt_pk_bf16(v1[2], v1[3]);
          *(u32x4*)(o + (size_t)i * 8) = w; } }
}

__device__ __forceinline__ void conv_phase(const bf16_t* Gin, bf16_t* CV, const float* wdw, const float* bdw, const float* lng, const float* lnb, LAS unsigned char* lds, int G, int c) {
    constexpr int CT = 16;
    const int tid = opaque_tid(), lane = tid & 63, wid = tid >> 6, ch = 2 * tid;
    LAS float* red = (LAS float*)lds;
    LAS float* st = (LAS float*)(lds + 4096);
    f32x2 w2[31];
#pragma unroll
    for (int j = 0; j < 31; ++j) w2[j] = *(const f32x2*)(wdw + j * DM + ch);
    const f32x2 bd = *(const f32x2*)(bdw + ch), gg = *(const f32x2*)(lng + ch), bb = *(const f32x2*)(lnb + ch);
    for (int unit = c; unit < TR / CT; unit += G) {
        const int row0 = unit * CT, t0 = row0 & (SEQ - 1);
        f32x2 x2[CT + 30];
#pragma unroll
        for (int j = 0; j < CT + 30; ++j) { const bool ok = (t0 - 30 + j) >= 0; const unsigned v = ok ? *(const unsigned*)(Gin + (size_t)(row0 - 30 + j) * DM + ch) : 0u; x2[j] = (f32x2){bf_lo(v), bf_hi(v)}; }
        float u0[CT], u1[CT];
#pragma unroll
        for (int t = 0; t < CT; ++t) { f32x2 a = bd;
#pragma unroll
            for (int j = 0; j < 31; ++j) a = __builtin_elementwise_fma(w2[j], x2[t + j], a);
            u0[t] = a[0]; u1[t] = a[1]; }
#pragma unroll
        for (int t = 0; t < CT; ++t) { float s = u0[t] + u1[t], q = u0[t] * u0[t] + u1[t] * u1[t]; s = wave_sum(s); q = wave_sum(q);
            if (lane == 0) { red[(wid * CT + t) * 2] = s; red[(wid * CT + t) * 2 + 1] = q; } }
        __syncthreads();
        if (tid < CT) { float s = 0.f, q = 0.f;
#pragma unroll
            for (int w = 0; w < 8; ++w) { s += red[(w * CT + tid) * 2]; q += red[(w * CT + tid) * 2 + 1]; }
            const float mean = s * (1.0f / DM), var = q * (1.0f / DM) - mean * mean;
            st[tid * 2] = mean; st[tid * 2 + 1] = rsqrtf(fmaxf(var, 0.f) + LN_EPS); }
        __syncthreads();
#pragma unroll
        for (int t = 0; t < CT; ++t) { const float mean = st[t * 2], rstd = st[t * 2 + 1];
            float y0 = (u0[t] - mean) * rstd * gg[0] + bb[0], y1 = (u1[t] - mean) * rstd * gg[1] + bb[1];
            y0 *= fast_sigmoid(y0); y1 *= fast_sigmoid(y1);
            *(unsigned*)(CV + (size_t)(row0 + t) * DM + ch) = cvt_pk_bf16(y0, y1); }
        __syncthreads();
    }
}

__global__ void __launch_bounds__(512, 2) yoco_fwd(Args args) {
    extern __shared__ __attribute__((aligned(16))) unsigned char lds_raw[];
    LAS unsigned char* lds = (LAS unsigned char*)lds_raw;
    cg::grid_group grid = cg::this_grid();
    const int G = gridDim.x, bx = blockIdx.x;
#define THIN_IDS const int tid = opaque_tid(), lane = tid & 63, wave = __builtin_amdgcn_readfirstlane(tid >> 6); const int gw = bx * 8 + wave, NGW = G * 8, gtid = bx * 512 + tid, NGT = G * 512; LAS float* scr = (LAS float*)(lds + wave * 16640); (void)lane; (void)gw; (void)NGW; (void)gtid; (void)NGT; (void)scr;
#define XRES ((float*)ldarg(args, 32))
#define SSP  ((float*)WSP(WS_SS))
#define HB   WSP(WS_HB)

    { const int t0 = opaque_tid(); if (t0 < 4) ((LAS unsigned*)(lds + LDS_BARST))[t0] = 0u; }
    __syncthreads();
    (void)xcd_barrier_post((unsigned*)WSP(WS_BAR), (volatile LAS unsigned*)(lds + LDS_BARST));
#define SEAM() do { if (args.ph_hi < 0) grid.sync();     \
        XcdBarrier xb_; xb_.bar = (unsigned*)WSP(WS_BAR); xb_.x = xb_xcc_id(); xb_.st = (volatile LAS unsigned*)(lds + LDS_BARST); xcd_barrier(xb_); } while (0)
#ifndef PROBE_MASK
#define PROBE_MASK 0u
#endif
    bool last_phase_ = false;
#define PH_BEGIN(kind) { const bool probe_ = (PROBE_MASK >> (kind)) & 1u; const unsigned long long pt0_ = probe_ ? __builtin_amdgcn_s_memrealtime() : 0ull;
#define PH_END   if (probe_) { __syncthreads(); const unsigned long long pt1_ = __builtin_amdgcn_s_memrealtime(); while (__builtin_amdgcn_s_memrealtime() - pt1_ < 3ull * (pt1_ - pt0_)) __builtin_amdgcn_s_sleep(8); } \
                 if (!last_phase_) SEAM(); }

    PH_BEGIN(0)
    {   THIN_IDS
        const float* x = FARG(0); const float* mem = FARG(1); const int* pos = (const int*)ldarg(args, 2);
        float* ss = SSP; bf16_t* xb = WSP(WS_XB); bf16_t* memb = WSP(WS_MEMB);
        for (int m0 = gw; m0 < TR + NBATCH * NMEM; m0 += 2 * NGW) {
            f32x4 v[2][4]; bool ok[2];
#pragma unroll
            for (int q = 0; q < 2; ++q) { const int m = m0 + q * NGW; ok[q] = m < TR + NBATCH * NMEM; const bool isx = m < TR;
                const float* src = isx ? x + (size_t)m * DM : mem + (size_t)(m - TR) * DM;
#pragma unroll
                for (int j = 0; j < 4; ++j) v[q][j] = ok[q] ? *((const f32x4*)src + lane + 64 * j) : (f32x4){0.f, 0.f, 0.f, 0.f}; }
#pragma unroll
            for (int q = 0; q < 2; ++q) { const int m = m0 + q * NGW; if (!ok[q]) continue; const bool isx = m < TR;
                bf16_t* dst = isx ? xb + (size_t)m * DM : memb + (size_t)(m - TR) * DM; float sq = 0.f;
#pragma unroll
                for (int j = 0; j < 4; ++j) { const f32x4 w4 = v[q][j]; sq += (w4[0] * w4[0] + w4[1] * w4[1]) + (w4[2] * w4[2] + w4[3] * w4[3]);
                    u32x2 w; if (isx) { w.x = cvt_pk_f16(w4[0], w4[1]); w.y = cvt_pk_f16(w4[2], w4[3]); } else { w.x = cvt_pk_bf16(w4[0], w4[1]); w.y = cvt_pk_bf16(w4[2], w4[3]); } *((u32x2*)dst + lane + 64 * j) = w; }
                sq = wave_sum(sq);
                if (isx && lane < 4) ss[(size_t)m * 4 + lane] = lane == 0 ? sq : 0.f; }
        }
        float* cosT = (float*)WSP(WS_COS); float* sinT = (float*)WSP(WS_SIN);
        for (int i = gtid; i < TR * 8; i += NGT) { const int row = i >> 3, k = i & 7; const float inv = powf(500000.0f, -(float)(2 * k) / 16.0f); const float ang = (float)pos[row] * inv;
            cosT[i] = cosf(ang); sinT[i] = sinf(ang); }
        for (int it = gw; it < 8 * 256; it += NGW) { const int j = it >> 8, l = j >> 1, kv = j & 1;
            cvt_item(FARG(kv ? 27 : 26) + (size_t)l * DM * DM, DM, DM, DM, HB + (size_t)j * DM * DM, nullptr, 1.f, 0, 0, scr, it & 255, lane); }
        convert_layer(args, 0, 7, scr, gw, NGW, lane, gtid, NGT);
    }
    PH_END

    PH_BEGIN(1)
    {   pg8::Gemm g{WSP(WS_MEMB), HB, DM, DM, DM, 0, (long)NMEM * DM, (long)DM * DM, 0, 0, 4};
        pg8::Order S; S.init(1, 4, 32, G, bx);
        pg8::EpiPlain E{WSP(WS_KV), DM, (long)4 * NMEM * DM, (long)NMEM * DM, 4, 0};
        pg8::gemm_phase(lds, g, S, E);
    }
    PH_END

    for (int l = 0; l < 4; ++l) {
        const bool is_conv = l < 2;

        PH_BEGIN(3)
        if (is_conv) {
            pg8::Gemm g{WSP(WS_XB), WSP(WS_WMIX), DM, DM, DM, 0, 0, 0, 0, 0, 1}; pg8::Order S; S.init(TR / 256, 8, 1, G, bx);
            pg8::EpiGated<0> E{WSP(WS_R1), DM, SSP, FARG(8) + l * 2 * DM, DM};
            pg8::gemm_phase<pg8::EpiGated<0>, true>(lds, g, S, E);
        } else {
            pg8::Gemm g{WSP(WS_XB), WSP(WS_WMIX), DM, DM, DM, 0, 0, 0, 0, 0, 1}; pg8::Order S; S.init(TR / 256, l == 2 ? 12 : 4, 1, G, bx);
            pg8::EpiQKV E{WSP(WS_R1), (size_t)(WS_KSH - WS_R1) / 2, SSP, (const float*)WSP(WS_COS), (const float*)WSP(WS_SIN)};
            pg8::gemm_phase<pg8::EpiQKV, true>(lds, g, S, E);
        }
        {
            pg8::Gemm g1{WSP(WS_KV) + (size_t)(l * 2 + 0) * 4 * NMEM * DM, WSP(WS_WQS), DM, DM, 256, (long)NMEM * DM, 256, 0, 256, 0, 4}; pg8::Order S1; S1.init(1, 4, 16, G, bx);
            pg8::EpiPlain E1{WSP(WS_BTS), DM, (long)DM * DM, (long)256 * DM, 4, 1};
            pg8::gemm_phase(lds, g1, S1, E1);
            pg8::Gemm g2{WSP(WS_WOT), WSP(WS_KV) + (size_t)(l * 2 + 1) * 4 * NMEM * DM, DM, DM, 256, 0, 256, (long)NMEM * DM, 256, 0, 4}; pg8::Order S2; S2.init(4, 1, 16, G, G - 1 - bx);
            pg8::EpiPlain E2{WSP(WS_BTO), DM, (long)DM * DM, 256, 4, 0};
            pg8::gemm_phase(lds, g2, S2, E2);
        }
        PH_END

        PH_BEGIN((is_conv ? 4 : 5))
        if (is_conv) {
#ifndef NO_CONV
            conv_phase(WSP(WS_R1), HB, FARG(9) + l * 31 * DM, FARG(10) + l * DM, FARG(11) + l * DM, FARG(12) + l * DM, lds, G, bx);
#endif
        } else {
#ifndef NO_ATTN
            const attn_body::bf16* qd = (const attn_body::bf16*)WSP(WS_R1); const attn_body::bf16* kd = (const attn_body::bf16*)WSP(WS_KSH); const attn_body::bf16* vd = (const attn_body::bf16*)WSP(WS_VSH);
            attn_body::bf16* od = (attn_body::bf16*)WSP(WS_R1);
            float lam, li1;
            {   const int ln = opaque_tid() & 63; const int bb = l - 2; const float lambda_init = 0.8f - 0.6f * expf(-0.3f * (float)l);
                const float d1 = wave_sum(FARG(19)[bb * 64 + ln] * FARG(20)[bb * 64 + ln]), d2 = wave_sum(FARG(21)[bb * 64 + ln] * FARG(22)[bb * 64 + ln]);
                lam = expf(d1) - expf(d2) + lambda_init; li1 = 1.0f - lambda_init; }
            float* gtab = (float*)((char*)lds_raw + LDS_GTAB);
            { const int t = opaque_tid(); if (t < 128) gtab[t] = FARG(23)[(l - 2) * 128 + t] * li1; if (t == 128) gtab[128] = lam; }
            __syncthreads();
#define ATT_PAIR(B_, H_, QB_) do { \
                attn_body::attn_unit2<8, 1>(B_, (H_) * 128, (H_) * 128, (H_) * 128, (H_) * 128, QB_, qd, kd, vd, od, (char*)lds_raw); \
                attn_body::attn_unit2<8, 2>(B_, (H_) * 128 + 64, (H_) * 128 + 64, (H_) * 128, (H_) * 128, QB_, qd, kd, vd, od, (char*)lds_raw); } while (0)
            for (int i = 0;; ++i) { int b, h, qb;
                if (G == 256) {
                    if (i >= 2) break; const int xk = bx >> 3, bh = (bx & 7) * 4 + (xk >> 3), p = xk & 7; b = bh >> 3; h = bh & 7; qb = i == 0 ? 15 - p : p;
                } else {
                    const int pp = (i & 1) ? (G - 1 - bx) : bx; const int idx = i * G + pp; if (idx >= 512) break; qb = 15 - (idx >> 5); const int j = idx & 31; b = j >> 3; h = j & 7; }
                ATT_PAIR(b, h, qb); }
#undef ATT_PAIR
#endif
        }
        if (l > 0) { THIN_IDS convert_layer(args, l, 2, scr, gw, NGW, lane, gtid, NGT); }
        PH_END

        PH_BEGIN(7)
        {   pg8::Gemm g{is_conv ? HB : WSP(WS_R1), WSP(WS_WMIX) + (size_t)(is_conv ? 2 : 3) * DM * DM, DM, DM, DM, 0, 0, 0, 0, 0, 1}; pg8::Order S; S.init(TR / 256, 4, 1, G, bx);
            pg8::EpiResid E{WSP(WS_XB), SSP, is_conv ? FARG(14) + l * DM : nullptr};
            pg8::gemm_phase(lds, g, S, E);
        }
        PH_END

        PH_BEGIN(8)
        {   pg8::Gemm g{WSP(WS_XB), WSP(WS_BTS), DM, DM, DM, 0, 0, 0, 0, (long)DM * DM, 1}; pg8::Order S; S.init(TR / 256, 4, 1, G, bx);
            pg8::EpiSoftmax E{WSP(WS_R1), SSP};
            pg8::gemm_phase<pg8::EpiSoftmax, true>(lds, g, S, E);
        }
        PH_END

        PH_BEGIN(9)
        {   pg8::Gemm g{WSP(WS_R1), WSP(WS_BTO), DM, DM, DM, 0, 0, 0, 0, (long)DM * DM, 1}; pg8::Order S; S.init(TR / 256, 4, 1, G, bx);
            pg8::EpiResid E{WSP(WS_XB), SSP, nullptr};
            pg8::gemm_phase(lds, g, S, E);
        }
        PH_END

        PH_BEGIN(10)
        {   pg8::Gemm g{WSP(WS_XB), WSP(WS_WGU), DM, DM, DM, 0, 0, 0, 0, 0, 1}; pg8::Order S; S.init(TR / 256, 2 * FF / 256, 1, G, bx);
            pg8::EpiGated<1> E{HB, FF, SSP, nullptr, 0};
            pg8::gemm_phase<pg8::EpiGated<1>, true>(lds, g, S, E);
            {   const int nun = (TR / 256) * (2 * FF / 256), tail = nun % G;
                if (l < 3) { if (tail > 0 && bx >= tail) { const int tid = opaque_tid(), lane = tid & 63, wave = __builtin_amdgcn_readfirstlane(tid >> 6); LAS float* scr = (LAS float*)(lds + wave * 16640);
                        convert_layer(args, l + 1, 1, scr, (bx - tail) * 8 + wave, (G - tail) * 8, lane, (bx - tail) * 512 + tid, (G - tail) * 512); }
                    else if (tail == 0) { THIN_IDS convert_layer(args, l + 1, 1, scr, gw, NGW, lane, gtid, NGT); } } }
        }
        PH_END

        PH_BEGIN(11)
        {   pg8::Gemm g{HB, WSP(WS_WD), FF, FF, FF, 0, 0, 0, 0, 0, 1}; pg8::Order S; S.init(TR / 256, 4, 1, G, bx);
            pg8::EpiResid E{WSP(WS_XB), SSP, nullptr};
            pg8::gemm_phase(lds, g, S, E);
            if (l < 3) { THIN_IDS convert_layer(args, l + 1, 4, scr, gw, NGW, lane, gtid, NGT); }
        }
        PH_END
    }

    last_phase_ = true;
    PH_BEGIN(12)
    {   THIN_IDS
        const float* gfin = FARG(6); float* outp = XRES; const bf16_t* xb = WSP(WS_XB);
        for (int m0 = gw; m0 < TR; m0 += 2 * NGW) {
            u32x4 ra[2][2]; bool ok[2];
#pragma unroll
            for (int q = 0; q < 2; ++q) { const int m = m0 + q * NGW; ok[q] = m < TR; const u32x4* p = (const u32x4*)(xb + (size_t)(ok[q] ? m : m0) * DM); ra[q][0] = p[lane]; ra[q][1] = p[64 + lane]; }
#pragma unroll
            for (int q = 0; q < 2; ++q) { const int m = m0 + q * NGW; if (!ok[q]) continue; const u32x4 a = ra[q][0], b = ra[q][1];
            float v[16];
#pragma unroll
            for (int j = 0; j < 4; ++j) { v[2 * j] = h_lo(a[j]); v[2 * j + 1] = h_hi(a[j]); v[8 + 2 * j] = h_lo(b[j]); v[8 + 2 * j + 1] = h_hi(b[j]); }
            float sq = 0.f;
#pragma unroll
            for (int j = 0; j < 16; ++j) sq += v[j] * v[j];
            const float rs = rsqrtf(wave_sum(sq) * (1.0f / DM) + RMS_EPS);
            float* orow = outp + (size_t)m * DM;
#pragma unroll
            for (int h = 0; h < 2; ++h) { const int c0 = h * 512 + lane * 8; const f32x4 g0 = *(const f32x4*)(gfin + c0), g1 = *(const f32x4*)(gfin + c0 + 4);
                *(f32x4*)(orow + c0) = (f32x4){v[8 * h + 0] * rs * g0[0], v[8 * h + 1] * rs * g0[1], v[8 * h + 2] * rs * g0[2], v[8 * h + 3] * rs * g0[3]};
                *(f32x4*)(orow + c0 + 4) = (f32x4){v[8 * h + 4] * rs * g1[0], v[8 * h + 5] * rs * g1[1], v[8 * h + 6] * rs * g1[2], v[8 * h + 7] * rs * g1[3]}; } } }
    }
    PH_END
#undef PH_BEGIN
#undef PH_END
}

extern "C" void kernel_launch(void* const* d_in, const int* in_sizes, int n_in, void* d_out, int out_size, void* d_ws, size_t ws_size, hipStream_t stream) {
    static int grid = 0;
    if (grid == 0) {
        if (n_in != 32 || out_size != TR * DM || ws_size < WS_END) { fprintf(stderr, "kernel_launch: unexpected shapes (n_in %d out %d ws %zu)\n", n_in, out_size, ws_size); grid = -1; return; }
        int dev = 0, cus = 0, per_cu = 0;
        hipGetDevice(&dev); hipDeviceGetAttribute(&cus, hipDeviceAttributeMultiprocessorCount, dev);
        if (hipFuncSetAttribute((const void*)yoco_fwd, hipFuncAttributeMaxDynamicSharedMemorySize, LDS_BYTES) != hipSuccess) { fprintf(stderr, "kernel_launch: hipFuncSetAttribute failed\n"); grid = -1; return; }
        if (hipOccupancyMaxActiveBlocksPerMultiprocessor(&per_cu, (const void*)yoco_fwd, 512, LDS_BYTES) != hipSuccess || per_cu < 1) { fprintf(stderr, "kernel_launch: occupancy query gave %d\n", per_cu); per_cu = 1; (void)hipGetLastError(); }
        grid = cus * per_cu;
    }
    if (grid < 0) return;
    if (hipMemsetAsync((char*)d_ws + WS_BAR, 0, XCD_BAR_WORDS * 4, stream) != hipSuccess) { fprintf(stderr, "kernel_launch: memset failed\n"); return; }
    Args a{};
    for (int i = 0; i < 32; ++i) a.in[i] = d_in[i];
    a.in[32] = d_out; a.in[33] = d_ws;
    a.ph_lo = 0; a.ph_hi = 1;
    void* kargs[] = {&a};
    hipError_t e = hipLaunchCooperativeKernel((const void*)yoco_fwd, dim3(grid), dim3(512), kargs, LDS_BYTES, stream);
    if (e != hipSuccess) fprintf(stderr, "kernel_launch: cooperative launch failed: %s (grid %d)\n", hipGetErrorString(e), grid);
}
```

```cpp
#include <hip/hip_runtime.h>
#include <hip/hip_cooperative_groups.h>
#include <hip/hip_bf16.h>
#include <cstdio>
#include <cstdint>
#include <cmath>
namespace cg = cooperative_groups;

#define LAS __attribute__((address_space(3)))
typedef unsigned short bf16_t;
typedef short bf16x8 __attribute__((ext_vector_type(8)));
typedef float f32x4 __attribute__((ext_vector_type(4)));
typedef float f32x2 __attribute__((ext_vector_type(2)));
typedef unsigned u32x4 __attribute__((ext_vector_type(4)));
typedef unsigned u32x2 __attribute__((ext_vector_type(2)));

constexpr int TR = 16384, DM = 1024, FF = 2816, SEQ = 4096, NBATCH = 4, NMEM = 256;
constexpr float RMS_EPS = 1e-6f, LN_EPS = 1e-5f, SUBLN_EPS = 1e-5f;
constexpr float LOG2E = 1.4426950408889634f;
constexpr float C2 = 0.125f * LOG2E;

constexpr size_t MiB = 1u << 20;
constexpr size_t WS_SS = 0;
constexpr size_t WS_BAR = 512 * 1024;
constexpr size_t WS_COS = 1 * MiB;
constexpr size_t WS_SIN = 1 * MiB + 512 * 1024;
constexpr size_t WS_MEMB = 2 * MiB;
constexpr size_t WS_W = 4 * MiB;
constexpr size_t WS_WMIX = WS_W;
constexpr size_t WS_WQS = WS_W + 8 * MiB;
constexpr size_t WS_WOT = WS_W + 10 * MiB;
constexpr size_t WS_WGU = WS_W + 12 * MiB;
constexpr size_t WS_WD = WS_W + 24 * MiB;
constexpr size_t WS_BTS = 36 * MiB;
constexpr size_t WS_BTO = 44 * MiB;
constexpr size_t WS_KV = 52 * MiB;
constexpr size_t WS_XB = 68 * MiB;
constexpr size_t WS_R1 = 100 * MiB;
constexpr size_t WS_KSH = 132 * MiB;
constexpr size_t WS_VSH = 164 * MiB;
constexpr size_t WS_HB = 196 * MiB;
constexpr size_t WS_END = 284 * MiB;
static_assert(WS_KSH - WS_R1 == WS_VSH - WS_KSH, "q | k | v buffers equally spaced");

constexpr int LDS_STAGE = 131072, LDS_XCH = 131072, LDS_RS = 139264, LDS_GTAB = 142336, LDS_BARST = 143360, LDS_BYTES = 147456;

typedef __bf16 bf16x2_hw __attribute__((ext_vector_type(2)));
__device__ __forceinline__ unsigned cvt_pk_bf16(float lo, float hi) { const f32x2 v = {lo, hi}; const bf16x2_hw b = __builtin_convertvector(v, bf16x2_hw); return __builtin_bit_cast(unsigned, b); }
__device__ __forceinline__ int opaque_tid() { int t = threadIdx.x; asm volatile("" : "+v"(t)); return t; }
typedef _Float16 f16x8 __attribute__((ext_vector_type(8)));
typedef _Float16 f16x2 __attribute__((ext_vector_type(2)));
__device__ __forceinline__ unsigned cvt_pk_f16(float lo, float hi) { const f32x2 v = {lo, hi}; const f16x2 h = __builtin_convertvector(v, f16x2); return __builtin_bit_cast(unsigned, h); }
__device__ __forceinline__ float h_lo(unsigned u) { return (float)__builtin_bit_cast(f16x2, u)[0]; }
__device__ __forceinline__ float h_hi(unsigned u) { return (float)__builtin_bit_cast(f16x2, u)[1]; }
__device__ __forceinline__ float bf_lo(unsigned u) { return __uint_as_float(u << 16); }
__device__ __forceinline__ float bf_hi(unsigned u) { return __uint_as_float(u & 0xffff0000u); }
__device__ __forceinline__ float wave_sum(float v) {
#pragma unroll
    for (int o = 1; o < 64; o <<= 1) v += __shfl_xor(v, o);
    return v;
}
__device__ __forceinline__ float fast_sigmoid(float x) { return __builtin_amdgcn_rcpf(1.0f + __builtin_amdgcn_exp2f(-x * LOG2E)); }
__device__ __forceinline__ float row_rs_lds(LAS unsigned char* lds, int r) {
    const f32x4 a = *(const LAS f32x4*)(lds + LDS_RS + r * 16);
    return rsqrtf(((a[0] + a[1]) + (a[2] + a[3])) * (1.0f / DM) + RMS_EPS);
}
__device__ __forceinline__ float row_rs(const float* ss, int row) {
    const f32x4 a = *(const f32x4*)(ss + (size_t)row * 4);
    return rsqrtf(((a[0] + a[1]) + (a[2] + a[3])) * (1.0f / DM) + RMS_EPS);
}

namespace pg8 {
constexpr int BM = 256, BK = 64, HALF = 128, HTB = HALF * BK * 2, NXCD = 8, WGM = 8;
__host__ __device__ __forceinline__ int lds_byte(int r, int c) { const int st = (r >> 4) * 2 + (c >> 5), rr = r & 15, cc = c & 31, ob = rr * 64 + cc * 2; return st * 1024 + (ob ^ (((ob >> 9) & 1) << 5)); }
__host__ __device__ __forceinline__ void stage_rc(int b, int& R, int& C) { const int st = b / 1024, sb = b % 1024, swz = sb ^ (((sb >> 9) & 1) << 5); R = (st >> 1) * 16 + swz / 64; C = (st & 1) * 32 + (swz % 64) / 2; }
__host__ __device__ __forceinline__ int perm32(int rho) { const int n = rho >> 4, i = rho & 15; return 8 * (i >> 2) + 4 * n + (i & 3); }

struct Unit { int pm, pn, z; };
struct Gemm { const bf16_t* A; const bf16_t* Bt; int lda, ldb, K; long a_s1, a_s0, b_s1, b_s0, b_sb; int nz0; };
__device__ __forceinline__ const char* a_ptr(const Gemm& g, const Unit& u) { const int z1 = u.z / g.nz0, z0 = u.z % g.nz0; return (const char*)(g.A + z1 * g.a_s1 + z0 * g.a_s0 + (long)u.pm * BM * g.lda); }
__device__ __forceinline__ const char* b_ptr(const Gemm& g, const Unit& u) { const int z1 = u.z / g.nz0, z0 = u.z % g.nz0; return (const char*)(g.Bt + z1 * g.b_s1 + z0 * g.b_s0 + (long)(u.pm >> 4) * g.b_sb + (long)u.pn * BM * g.ldb); }

struct Order {
    int nM, nN, nz, nwg, G, c;
    __device__ void init(int nM_, int nN_, int nz_, int G_, int c_) { nM = nM_; nN = nN_; nz = nz_; nwg = nM * nN; G = G_; c = c_; }
    __device__ bool next(int i, Unit& u) const {
        const long L = (long)i * G + c; if (L >= (long)nwg * nz) return false;
        if (nz == 1) {
            int wgid = (int)L; { const int q = nwg / NXCD, r = nwg % NXCD, xcd = wgid % NXCD, off = wgid / NXCD; wgid = (xcd < r ? xcd * (q + 1) : r * (q + 1) + (xcd - r) * q) + off; }
            const int nig = WGM * nN, gid = wgid / nig, fm = gid * WGM, gsz = (nM - fm) < WGM ? (nM - fm) : WGM;
            u.pm = fm + ((wgid % nig) % gsz); u.pn = (wgid % nig) / gsz; u.z = 0;
        } else {
            const int l = (int)L; u.z = l / nwg; const int r = l % nwg; u.pm = r / nN; u.pn = r % nN;
        }
        return true;
    }
};

template <bool F16> __device__ __forceinline__ f32x4 mma16(bf16x8 a, bf16x8 b, f32x4 c) {
    if constexpr (F16) return __builtin_amdgcn_mfma_f32_16x16x32_f16(__builtin_bit_cast(f16x8, a), __builtin_bit_cast(f16x8, b), c, 0, 0, 0);
    else return __builtin_amdgcn_mfma_f32_16x16x32_bf16(a, b, c, 0, 0, 0);
}
template <class Epi, bool F16 = false>
__device__ __forceinline__ void gemm_phase(LAS unsigned char* lds, const Gemm g, const Order& S, const Epi& E) {
    const int tid = opaque_tid(), wid = __builtin_amdgcn_readfirstlane(tid >> 6), lane = tid & 63, wr = wid >> 2, wc = wid & 3, fr = lane & 15, fq = lane >> 4;
    const int K = g.K, nt = K / BK;
    unsigned voffA[2], voffB[2];
#pragma unroll
    for (int i = 0; i < 2; ++i) { int R, C; stage_rc(tid * 16 + i * 8192, R, C); const int Rb = (R & ~31) + perm32(R & 31);
        voffA[i] = (unsigned)(R * g.lda + C) * 2u; voffB[i] = (unsigned)(Rb * g.ldb + C) * 2u; }
    const size_t kstep = (size_t)(BK * 2);
    const size_t hstepA = (size_t)HALF * g.lda * 2, hstepB = (size_t)HALF * g.ldb * 2;
    const unsigned ldsw = (unsigned)wid * 1024u;
    const int aoff = lds_byte(wr * 64 + fr, fq * 8), boff = lds_byte(wc * 32 + fr, fq * 8);
#define PG8_SA(b, h) (((b) * 2 + (h)) * HTB)
#define PG8_SB(b, h) ((4 + (b) * 2 + (h)) * HTB)
#define PG8_STAGE(bufoff, gbase, voff) do { _Pragma("unroll") for (int _i = 0; _i < 2; ++_i) \
        __builtin_amdgcn_global_load_lds((const unsigned*)((const char*)(gbase) + (voff)[_i]), (LAS unsigned*)(lds + (bufoff) + ldsw + _i * 8192), 16, 0, 0); } while (0)
#define PG8_LDA(dst, b, h) do { _Pragma("unroll") for (int m = 0; m < 4; ++m) _Pragma("unroll") for (int k = 0; k < 2; ++k) dst[m][k] = *(const LAS bf16x8*)(lds + PG8_SA(b, h) + aoff + m * 2048 + k * 1024); } while (0)
#define PG8_LDB(dst, b, h) do { _Pragma("unroll") for (int n = 0; n < 2; ++n) _Pragma("unroll") for (int k = 0; k < 2; ++k) dst[n][k] = *(const LAS bf16x8*)(lds + PG8_SB(b, h) + boff + n * 2048 + k * 1024); } while (0)
#define PG8_MMA(ai, bj, At, Bt) do { __builtin_amdgcn_s_setprio(1); _Pragma("unroll") for (int m = 0; m < 4; ++m) _Pragma("unroll") for (int n = 0; n < 2; ++n) _Pragma("unroll") for (int k = 0; k < 2; ++k) \
        acc[ai][bj][m][n] = mma16<F16>(Bt[n][k], At[m][k], acc[ai][bj][m][n]); __builtin_amdgcn_s_setprio(0); } while (0)
#define PG8_WAIT_V(n) asm volatile("s_waitcnt vmcnt(" #n ")" ::: "memory")
#define PG8_WAIT_L(n) asm volatile("s_waitcnt lgkmcnt(" #n ")" ::: "memory")
#define PG8_BAR __builtin_amdgcn_s_barrier()
#define PG8_SCHED __builtin_amdgcn_sched_barrier(0)
    Unit cur, nxt; int ui = 0;
    if (!S.next(0, cur)) return;
    f32x4 acc[2][2][4][2];
#pragma unroll
    for (int a = 0; a < 2; ++a)
#pragma unroll
        for (int b = 0; b < 2; ++b)
#pragma unroll
            for (int m = 0; m < 4; ++m)
#pragma unroll
                for (int n = 0; n < 2; ++n) acc[a][b][m][n] = (f32x4){0.f, 0.f, 0.f, 0.f};
    bf16x8 At[4][2], B0[2][2], B1[2][2];
    const char* cA = a_ptr(g, cur); const char* cB = b_ptr(g, cur);
    PG8_STAGE(PG8_SB(0, 0), cB, voffB); PG8_STAGE(PG8_SB(0, 1), cB + hstepB, voffB); PG8_STAGE(PG8_SA(0, 0), cA, voffA); PG8_STAGE(PG8_SA(0, 1), cA + hstepA, voffA);
    if (wr == 1) PG8_BAR;
    PG8_WAIT_V(2); PG8_BAR;
    PG8_STAGE(PG8_SB(1, 0), cB + kstep, voffB); PG8_STAGE(PG8_SA(1, 0), cA + kstep, voffA); PG8_STAGE(PG8_SB(1, 1), cB + hstepB + kstep, voffB);
    PG8_WAIT_V(6); PG8_BAR;
    for (;;) {
        const bool has_next = S.next(ui + 1, nxt);
        const char* nA = has_next ? a_ptr(g, nxt) : cA; const char* nB = has_next ? b_ptr(g, nxt) : cB;
        for (int t = 0; t < nt; t += 2) {
            const bool last = (t == nt - 2);
            const char* a1 = cA + (size_t)(t + 1) * kstep;
            const char* a2 = last ? nA : cA + (size_t)(t + 2) * kstep; const char* b2 = last ? nB : cB + (size_t)(t + 2) * kstep;
            const char* a3 = a2 + kstep; const char* b3 = b2 + kstep;
            if constexpr (Epi::NEEDS_RS) { if (last && wid < 4) __builtin_amdgcn_global_load_lds((const unsigned*)(E.ss + ((size_t)cur.pm * BM + wid * 64 + lane) * 4), (LAS unsigned*)(lds + LDS_RS + wid * 1024), 16, 0, 0); }
            PG8_LDB(B0, 0, 0); PG8_LDB(B1, 0, 1); PG8_SCHED; PG8_LDA(At, 0, 0); PG8_STAGE(PG8_SA(1, 1), a1 + hstepA, voffA);
            PG8_WAIT_V(8); PG8_WAIT_L(0); PG8_BAR; PG8_MMA(0, 0, At, B0); PG8_MMA(0, 1, At, B1); PG8_BAR; PG8_SCHED;
            PG8_LDA(At, 0, 1); PG8_STAGE(PG8_SB(0, 0), b2, voffB); PG8_STAGE(PG8_SB(0, 1), b2 + hstepB, voffB); PG8_STAGE(PG8_SA(0, 0), a2, voffA);
            PG8_WAIT_V(8); PG8_WAIT_L(0); PG8_BAR; PG8_MMA(1, 0, At, B0); PG8_MMA(1, 1, At, B1); PG8_BAR; PG8_SCHED;
            PG8_LDB(B0, 1, 0); PG8_LDB(B1, 1, 1); PG8_SCHED; PG8_LDA(At, 1, 0); PG8_STAGE(PG8_SA(0, 1), a2 + hstepA, voffA);
            PG8_WAIT_V(8); PG8_WAIT_L(0); PG8_BAR; PG8_MMA(0, 0, At, B0); PG8_MMA(0, 1, At, B1); PG8_BAR; PG8_SCHED;
            PG8_LDA(At, 1, 1); PG8_STAGE(PG8_SB(1, 0), b3, voffB); PG8_STAGE(PG8_SB(1, 1), b3 + hstepB, voffB); PG8_STAGE(PG8_SA(1, 0), a3, voffA);
            PG8_WAIT_V(8); PG8_WAIT_L(0); PG8_BAR; PG8_MMA(1, 0, At, B0); PG8_MMA(1, 1, At, B1); PG8_BAR; PG8_SCHED;
        }
        if (wr == 0) PG8_BAR;
        E(acc, cur, wr, wc, fr, fq, lds);
        if (!has_next) break;
#pragma unroll
        for (int a = 0; a < 2; ++a)
#pragma unroll
            for (int b = 0; b < 2; ++b)
#pragma unroll
                for (int m = 0; m < 4; ++m)
#pragma unroll
                    for (int n = 0; n < 2; ++n) acc[a][b][m][n] = (f32x4){0.f, 0.f, 0.f, 0.f};
        cur = nxt; cA = nA; cB = nB; ++ui;
        if (wr == 1) PG8_BAR;
    }
    PG8_WAIT_V(0);
    PG8_BAR;
#undef PG8_SA
#undef PG8_SB
#undef PG8_STAGE
#undef PG8_LDA
#undef PG8_LDB
#undef PG8_MMA
#undef PG8_WAIT_V
#undef PG8_WAIT_L
#undef PG8_BAR
#undef PG8_SCHED
}

typedef f32x4 Acc[2][2][4][2];

struct EpiPlain {
    static constexpr bool NEEDS_RS = false;
    bf16_t* O; int ldc; long c_s1, c_s0; int nz0; int f16;
    __device__ __forceinline__ void operator()(Acc& acc, const Unit& u, int wr, int wc, int fr, int fq, LAS unsigned char*) const {
        const int z1 = u.z / nz0, z0 = u.z % nz0;
        bf16_t* base = O + z1 * c_s1 + z0 * c_s0;
        const int row0 = u.pm * BM + wr * 64 + fr, col0 = u.pn * BM + wc * 32 + 8 * fq;
#pragma unroll
        for (int ai = 0; ai < 2; ++ai)
#pragma unroll
            for (int m = 0; m < 4; ++m) { bf16_t* rowp = base + (size_t)(row0 + ai * HALF + m * 16) * ldc + col0;
#pragma unroll
                for (int bj = 0; bj < 2; ++bj) { const f32x4 v0 = acc[ai][bj][m][0], v1 = acc[ai][bj][m][1];
                    u32x4 w;
                    if (f16) { w.x = cvt_pk_f16(v0[0], v0[1]); w.y = cvt_pk_f16(v0[2], v0[3]); w.z = cvt_pk_f16(v1[0], v1[1]); w.w = cvt_pk_f16(v1[2], v1[3]); }
                    else { w.x = cvt_pk_bf16(v0[0], v0[1]); w.y = cvt_pk_bf16(v0[2], v0[3]); w.z = cvt_pk_bf16(v1[0], v1[1]); w.w = cvt_pk_bf16(v1[2], v1[3]); }
                    *(u32x4*)(rowp + bj * HALF) = w; } }
    }
};

template <int MODE> struct EpiGated {
    static constexpr bool NEEDS_RS = true;
    bf16_t* O; int ldc; const float* ss; const float* bias; int bias_half;
    __device__ __forceinline__ void operator()(Acc& acc, const Unit& u, int wr, int wc, int fr, int fq, LAS unsigned char* lds) const {
        const int row0 = u.pm * BM + wr * 64 + fr, col0 = u.pn * HALF + wc * 32 + 8 * fq;
        f32x4 ba[2], bg[2];
#pragma unroll
        for (int n = 0; n < 2; ++n) { if (MODE == 0) { ba[n] = *(const f32x4*)(bias + col0 + 4 * n); bg[n] = *(const f32x4*)(bias + bias_half + col0 + 4 * n); } else { ba[n] = (f32x4){0.f, 0.f, 0.f, 0.f}; bg[n] = ba[n]; } }
        float rsv[2][4];
#pragma unroll
        for (int ai = 0; ai < 2; ++ai)
#pragma unroll
            for (int m = 0; m < 4; ++m) rsv[ai][m] = row_rs_lds(lds, ai * HALF + wr * 64 + m * 16 + fr);
#pragma unroll
        for (int ai = 0; ai < 2; ++ai)
#pragma unroll
            for (int m = 0; m < 4; ++m) { const int row = row0 + ai * HALF + m * 16; const float rs = rsv[ai][m];
                float o[8];
                const f32x2 rs2 = (f32x2){rs, rs};
#pragma unroll
                for (int n = 0; n < 2; ++n)
#pragma unroll
                    for (int p = 0; p < 2; ++p) {
                        const f32x2 a2 = (f32x2){acc[ai][0][m][n][2 * p], acc[ai][0][m][n][2 * p + 1]}, g2 = (f32x2){acc[ai][1][m][n][2 * p], acc[ai][1][m][n][2 * p + 1]};
                        const f32x2 va = __builtin_elementwise_fma(a2, rs2, (f32x2){ba[n][2 * p], ba[n][2 * p + 1]}), vg = __builtin_elementwise_fma(g2, rs2, (f32x2){bg[n][2 * p], bg[n][2 * p + 1]});
                        const f32x2 sx = (MODE == 0 ? vg : va) * (f32x2){-LOG2E, -LOG2E};
                        f32x2 e; e[0] = __builtin_amdgcn_exp2f(sx[0]); e[1] = __builtin_amdgcn_exp2f(sx[1]);
                        const f32x2 den = e + (f32x2){1.0f, 1.0f};
                        f32x2 rc; rc[0] = __builtin_amdgcn_rcpf(den[0]); rc[1] = __builtin_amdgcn_rcpf(den[1]);
                        const f32x2 res = (MODE == 0) ? va * rc : (va * vg) * rc;
                        o[4 * n + 2 * p] = res[0]; o[4 * n + 2 * p + 1] = res[1]; }
                u32x4 w; w.x = cvt_pk_bf16(o[0], o[1]); w.y = cvt_pk_bf16(o[2], o[3]); w.z = cvt_pk_bf16(o[4], o[5]); w.w = cvt_pk_bf16(o[6], o[7]);
                *(u32x4*)(O + (size_t)row * ldc + col0) = w; }
    }
};

struct EpiResid {
    static constexpr bool NEEDS_RS = false;
    bf16_t* xb; float* ss; const float* bias;
    __device__ __forceinline__ void operator()(Acc& acc, const Unit& u, int wr, int wc, int fr, int fq, LAS unsigned char* lds) const {
        LAS float* X = (LAS float*)(lds + LDS_XCH);
        const int row0 = u.pm * BM + wr * 64 + fr, col0 = u.pn * BM + wc * 32 + 8 * fq;
        f32x4 bv[2][2];
#pragma unroll
        for (int bj = 0; bj < 2; ++bj)
#pragma unroll
            for (int n = 0; n < 2; ++n) bv[bj][n] = bias ? *(const f32x4*)(bias + col0 + bj * HALF + 4 * n) : (f32x4){0.f, 0.f, 0.f, 0.f};
#pragma unroll
        for (int ai = 0; ai < 2; ++ai) {
            u32x4 xpre[1][4][2];
#pragma unroll
            for (int m = 0; m < 4; ++m)
#pragma unroll
                for (int bj = 0; bj < 2; ++bj) xpre[0][m][bj] = *(const u32x4*)(xb + (size_t)(row0 + ai * HALF + m * 16) * DM + col0 + bj * HALF);
#pragma unroll
            for (int m = 0; m < 4; ++m) { const int row = row0 + ai * HALF + m * 16; const size_t ro = (size_t)row * DM + col0; float sq = 0.f;
#pragma unroll
                for (int bj = 0; bj < 2; ++bj) {
                    const u32x4 xin = xpre[0][m][bj];
                    const f32x4 x0 = (f32x4){h_lo(xin.x), h_hi(xin.x), h_lo(xin.y), h_hi(xin.y)}, x1 = (f32x4){h_lo(xin.z), h_hi(xin.z), h_lo(xin.w), h_hi(xin.w)};
                    const f32x4 v0 = acc[ai][bj][m][0] + bv[bj][0] + x0, v1 = acc[ai][bj][m][1] + bv[bj][1] + x1;
                    u32x4 w; w.x = cvt_pk_f16(v0[0], v0[1]); w.y = cvt_pk_f16(v0[2], v0[3]); w.z = cvt_pk_f16(v1[0], v1[1]); w.w = cvt_pk_f16(v1[2], v1[3]);
                    *(u32x4*)(xb + ro + bj * HALF) = w;
                    sq += (v0[0] * v0[0] + v0[1] * v0[1]) + (v0[2] * v0[2] + v0[3] * v0[3]) + (v1[0] * v1[0] + v1[1] * v1[1]) + (v1[2] * v1[2] + v1[3] * v1[3]); }
                sq += __shfl_xor(sq, 16); sq += __shfl_xor(sq, 32);
                if (fq == 0) X[(ai * HALF + wr * 64 + m * 16 + fr) * 4 + wc] = sq; } }
        asm volatile("s_waitcnt lgkmcnt(0)" ::: "memory"); __builtin_amdgcn_s_barrier(); asm volatile("" ::: "memory");
        { const int t = opaque_tid(); if (t < 256) { const f32x4 v = *(const LAS f32x4*)(X + t * 4); ss[(size_t)(u.pm * BM + t) * 4 + u.pn] = (v[0] + v[1]) + (v[2] + v[3]); } }
    }
};

struct EpiSoftmax {
    static constexpr bool NEEDS_RS = true;
    bf16_t* P; const float* ss;
    __device__ __forceinline__ void operator()(Acc& acc, const Unit& u, int wr, int wc, int fr, int fq, LAS unsigned char* lds) const {
        LAS f32x2* X = (LAS f32x2*)(lds + LDS_XCH);
        float mloc[2][4];
#pragma unroll
        for (int ai = 0; ai < 2; ++ai)
#pragma unroll
            for (int m = 0; m < 4; ++m) mloc[ai][m] = row_rs_lds(lds, ai * HALF + wr * 64 + m * 16 + fr);
#pragma unroll
        for (int ai = 0; ai < 2; ++ai)
#pragma unroll
            for (int m = 0; m < 4; ++m) { const int r = ai * HALF + wr * 64 + m * 16 + fr; const float rs = mloc[ai][m];
                float mx = -INFINITY;
#pragma unroll
                for (int bj = 0; bj < 2; ++bj)
#pragma unroll
                    for (int n = 0; n < 2; ++n) { f32x4 v = acc[ai][bj][m][n] * rs; acc[ai][bj][m][n] = v; mx = fmaxf(mx, fmaxf(fmaxf(v[0], v[1]), fmaxf(v[2], v[3]))); }
                mx = fmaxf(mx, __shfl_xor(mx, 16)); mx = fmaxf(mx, __shfl_xor(mx, 32));
                float sum = 0.f;
#pragma unroll
                for (int bj = 0; bj < 2; ++bj)
#pragma unroll
                    for (int n = 0; n < 2; ++n) { f32x4 v = acc[ai][bj][m][n];
#pragma unroll
                        for (int j = 0; j < 4; ++j) { v[j] = __builtin_amdgcn_exp2f(v[j] - mx); sum += v[j]; }
                        acc[ai][bj][m][n] = v; }
                sum += __shfl_xor(sum, 16); sum += __shfl_xor(sum, 32);
                if (fq == 0) X[r * 4 + wc] = (f32x2){mx, sum};
                mloc[ai][m] = mx; }
        asm volatile("s_waitcnt lgkmcnt(0)" ::: "memory"); __builtin_amdgcn_s_barrier(); asm volatile("" ::: "memory");
        const int col0 = u.pn * BM + wc * 32 + 8 * fq;
#pragma unroll
        for (int ai = 0; ai < 2; ++ai)
#pragma unroll
            for (int m = 0; m < 4; ++m) { const int r = ai * HALF + wr * 64 + m * 16 + fr;
                const f32x2 a = X[r * 4 + 0], b = X[r * 4 + 1], c = X[r * 4 + 2], d = X[r * 4 + 3];
                const float M = fmaxf(fmaxf(a[0], b[0]), fmaxf(c[0], d[0]));
                const float L = a[1] * __builtin_amdgcn_exp2f(a[0] - M) + b[1] * __builtin_amdgcn_exp2f(b[0] - M) + c[1] * __builtin_amdgcn_exp2f(c[0] - M) + d[1] * __builtin_amdgcn_exp2f(d[0] - M);
                const float f = __builtin_amdgcn_exp2f(mloc[ai][m] - M) / L;
                bf16_t* rowp = P + (size_t)(u.pm * BM + r) * DM + col0;
#pragma unroll
                for (int bj = 0; bj < 2; ++bj) { const f32x4 v0 = acc[ai][bj][m][0] * f, v1 = acc[ai][bj][m][1] * f;
                    u32x4 w; w.x = cvt_pk_bf16(v0[0], v0[1]); w.y = cvt_pk_bf16(v0[2], v0[3]); w.z = cvt_pk_bf16(v1[0], v1[1]); w.w = cvt_pk_bf16(v1[2], v1[3]);
                    *(u32x4*)(rowp + bj * HALF) = w; } }
        asm volatile("s_waitcnt lgkmcnt(0)" ::: "memory"); __builtin_amdgcn_s_barrier(); asm volatile("" ::: "memory");
    }
};

struct EpiQKV {
    static constexpr bool NEEDS_RS = true;
    bf16_t* Q; size_t sel_stride; const float* ss; const float* cs; const float* sn;
    __device__ __forceinline__ void operator()(Acc& acc, const Unit& u, int wr, int wc, int fr, int fq, LAS unsigned char* lds) const {
        const int sel = u.pn >> 2; bf16_t* dst = Q + (size_t)sel * sel_stride;
        const float scl = sel == 0 ? C2 : 1.0f;
        const bool rot = (sel < 2) && ((wc & 1) == 0) && (fq < 2);
        const int row0 = u.pm * BM + wr * 64 + fr, col0 = (u.pn & 3) * BM + wc * 32 + 8 * fq;
        float rsv[2][4];
#pragma unroll
        for (int ai = 0; ai < 2; ++ai)
#pragma unroll
            for (int m = 0; m < 4; ++m) rsv[ai][m] = row_rs_lds(lds, ai * HALF + wr * 64 + m * 16 + fr) * scl;
#pragma unroll
        for (int ai = 0; ai < 2; ++ai) {
            f32x4 cpre[4], spre[4];
#pragma unroll
            for (int m = 0; m < 4; ++m) { cpre[m] = (f32x4){1.f, 1.f, 1.f, 1.f}; spre[m] = (f32x4){0.f, 0.f, 0.f, 0.f};
                if (rot) { const size_t ro = (size_t)(row0 + ai * HALF + m * 16) * 8 + 4 * fq; cpre[m] = *(const f32x4*)(cs + ro); spre[m] = *(const f32x4*)(sn + ro); } }
#pragma unroll
            for (int m = 0; m < 4; ++m) { const int row = row0 + ai * HALF + m * 16; const float rs = rsv[ai][m];
                const f32x4 c4 = cpre[m], s4 = spre[m];
                bf16_t* rowp = dst + (size_t)row * DM + col0;
#pragma unroll
                for (int bj = 0; bj < 2; ++bj) { const f32x4 a0 = acc[ai][bj][m][0] * rs, a1 = acc[ai][bj][m][1] * rs;
                    f32x4 v0, v1;
                    v0[0] = a0[0] * c4[0] - a0[1] * s4[0]; v0[1] = a0[0] * s4[0] + a0[1] * c4[0];
                    v0[2] = a0[2] * c4[1] - a0[3] * s4[1]; v0[3] = a0[2] * s4[1] + a0[3] * c4[1];
                    v1[0] = a1[0] * c4[2] - a1[1] * s4[2]; v1[1] = a1[0] * s4[2] + a1[1] * c4[2];
                    v1[2] = a1[2] * c4[3] - a1[3] * s4[3]; v1[3] = a1[2] * s4[3] + a1[3] * c4[3];
                    u32x4 w; w.x = cvt_pk_bf16(v0[0], v0[1]); w.y = cvt_pk_bf16(v0[2], v0[3]); w.z = cvt_pk_bf16(v1[0], v1[1]); w.w = cvt_pk_bf16(v1[2], v1[3]);
                    *(u32x4*)(rowp + bj * HALF) = w; } } }
    }
};
}

namespace attn_body {
using bf16 = __hip_bfloat16;
using s16x4 = __attribute__((ext_vector_type(4))) short;
using f32x16 = __attribute__((ext_vector_type(16))) float;
constexpr int PITCH = 1024;
constexpr int NW = 8, QBLK = 32, QB = QBLK * NW, KVBLK = 64;
__device__ __forceinline__ int crow(int r, int hi) { return (r & 3) + 8 * (r >> 2) + 4 * hi; }
#define SBAR() __builtin_amdgcn_sched_barrier(0)
__device__ __forceinline__ void cmask(f32x16& p0, f32x16& p1, int jb, int qrel, int hi) {
  const float NEG = -INFINITY; int kb = 64 * jb + 4 * hi;
  #pragma unroll
  for (int r = 0; r < 16; ++r) { int kv = kb + (r & 3) + 8 * (r >> 2); if (kv > qrel) p0[r] = NEG; if (kv + 32 > qrel) p1[r] = NEG; }
}
constexpr int NSLOT = 3, SLOTB = 8192;
constexpr int LDS_K = 0, LDS_V = NSLOT * SLOTB, LDS_WS = 2 * NSLOT * SLOTB, LDS_OST = LDS_WS + NW * 64 * 4, LDS_ATT_BYTES = LDS_OST + NW * 4096;
__device__ __forceinline__ void glds16(const void* gsrc, unsigned lds_dst) { unsigned keep;
  asm volatile("s_mov_b32 %0, m0\n\ts_mov_b32 m0, %2\n\ts_nop 0\n\tglobal_load_lds_dwordx4 %1, off\n\ts_mov_b32 m0, %0" : "=&s"(keep) : "v"(gsrc), "s"(lds_dst) : "memory"); }
__device__ __forceinline__ void glds16s(const void* sbase, unsigned voff, unsigned lds_dst) { unsigned keep;
  asm volatile("s_mov_b32 %0, m0\n\ts_mov_b32 m0, %3\n\ts_nop 0\n\tglobal_load_lds_dwordx4 %1, %2\n\ts_mov_b32 m0, %0" : "=&s"(keep) : "v"(voff), "s"(sbase), "s"(lds_dst) : "memory"); }
__device__ __forceinline__ float max3f(float a, float b, float c) { float r; asm("v_max3_f32 %0, %1, %2, %3" : "=v"(r) : "v"(a), "v"(b), "v"(c)); return r; }
__device__ __forceinline__ float max2f(float a, float b) { float r; asm("v_max_f32_e32 %0, %1, %2" : "=v"(r) : "v"(a), "v"(b)); return r; }
__device__ __forceinline__ float fadd_s(float a, float b) { float r; asm("v_add_f32_e32 %0, %1, %2" : "=v"(r) : "v"(a), "v"(b)); return r; }
__device__ __forceinline__ float fsub_s(float a, float b) { float r; asm("v_sub_f32_e32 %0, %1, %2" : "=v"(r) : "v"(a), "v"(b)); return r; }
typedef float f32x2_t __attribute__((ext_vector_type(2))); typedef __bf16 bf16x2_t __attribute__((ext_vector_type(2)));
__device__ __forceinline__ unsigned cvtpk_s(float lo, float hi) { f32x2_t v = {lo, hi}; bf16x2_t b = __builtin_convertvector(v, bf16x2_t); return __builtin_bit_cast(unsigned, b); }
#define WAIT_BAR(N) asm volatile("s_waitcnt vmcnt(" #N ") lgkmcnt(0)\n\ts_barrier" ::: "memory")

__device__ __forceinline__ void qkt(f32x16& p0, f32x16& p1, const char* Kslot, const bf16x8* qr, const f32x16& negm, int r32, int hi) {
  const char* kb = Kslot + hi * 1024 + r32 * 16;
  #pragma unroll
  for (int d0 = 0; d0 < 4; ++d0) {
    const bf16x8 b0 = *reinterpret_cast<const bf16x8*>(kb + d0 * 2048);
    const bf16x8 b1 = *reinterpret_cast<const bf16x8*>(kb + d0 * 2048 + 512);
    if (d0 == 0) { p0 = __builtin_amdgcn_mfma_f32_32x32x16_bf16(b0, qr[0], negm, 0, 0, 0); p1 = __builtin_amdgcn_mfma_f32_32x32x16_bf16(b1, qr[0], negm, 0, 0, 0); }
    else { p0 = __builtin_amdgcn_mfma_f32_32x32x16_bf16(b0, qr[d0], p0, 0, 0, 0); p1 = __builtin_amdgcn_mfma_f32_32x32x16_bf16(b1, qr[d0], p1, 0, 0, 0); } }
}
typedef __attribute__((address_space(3))) const char* lds_cptr;
typedef short v4i16_t __attribute__((ext_vector_type(4)));
__device__ __forceinline__ void kload8(bf16x8* kf, lds_cptr kp) {
  kf[0] = *(const __attribute__((address_space(3))) bf16x8*)(kp);        kf[1] = *(const __attribute__((address_space(3))) bf16x8*)(kp + 512);
  kf[2] = *(const __attribute__((address_space(3))) bf16x8*)(kp + 2048); kf[3] = *(const __attribute__((address_space(3))) bf16x8*)(kp + 2560);
  kf[4] = *(const __attribute__((address_space(3))) bf16x8*)(kp + 4096); kf[5] = *(const __attribute__((address_space(3))) bf16x8*)(kp + 4608);
  kf[6] = *(const __attribute__((address_space(3))) bf16x8*)(kp + 6144); kf[7] = *(const __attribute__((address_space(3))) bf16x8*)(kp + 6656);
}
__device__ __forceinline__ void kload2(bf16x8* kf, lds_cptr kp, int j) { kf[2 * j] = *(const __attribute__((address_space(3))) bf16x8*)(kp + j * 2048); kf[2 * j + 1] = *(const __attribute__((address_space(3))) bf16x8*)(kp + j * 2048 + 512); }
__device__ __forceinline__ s16x4 vtr(lds_cptr p) { return __builtin_bit_cast(s16x4, __builtin_amdgcn_ds_read_tr16_b64_v4i16((__attribute__((address_space(3))) v4i16_t*)p)); }
__device__ __forceinline__ float rowmax(const f32x16& p0, const f32x16& p1) {
  float a = max3f(p0[0], p0[1], p1[0]), b = max3f(p0[2], p0[3], p1[1]); a = max3f(a, p1[2], p1[3]);
  #pragma unroll
  for (int r = 4; r < 16; r += 4) { a = max3f(a, p0[r], p0[r + 1]); b = max3f(b, p0[r + 2], p0[r + 3]); a = max3f(a, p1[r], p1[r + 1]); b = max3f(b, p1[r + 2], p1[r + 3]); }
  const float m = max2f(a, b);
  auto rr = __builtin_amdgcn_permlane32_swap(__float_as_uint(m), __float_as_uint(m), false, false);
  return max2f(__uint_as_float(rr[0]), __uint_as_float(rr[1]));
}
__device__ __forceinline__ void pv(f32x16* o, int vb, bf16x8 pa0, bf16x8 pa1, bf16x8 pa2, bf16x8 pa3) {
  #pragma unroll
  for (int d0 = 0; d0 < 2; ++d0) { s16x4 lo[4], hi[4];
    #pragma unroll
    for (int ks = 0; ks < 4; ++ks) {
      asm volatile("ds_read_b64_tr_b16 %0,%1 offset:%c2" : "=&v"(lo[ks]) : "v"(vb), "i"(d0 * 4096 + ks * 1024) : "memory");
      asm volatile("ds_read_b64_tr_b16 %0,%1 offset:%c2" : "=&v"(hi[ks]) : "v"(vb), "i"(d0 * 4096 + ks * 1024 + 512) : "memory"); }
    asm volatile("s_waitcnt lgkmcnt(0)" ::: "memory"); SBAR();
    #define PK(k) (bf16x8){lo[k][0], lo[k][1], lo[k][2], lo[k][3], hi[k][0], hi[k][1], hi[k][2], hi[k][3]}
    o[d0] = __builtin_amdgcn_mfma_f32_32x32x16_bf16(pa0, PK(0), o[d0], 0, 0, 0);
    o[d0] = __builtin_amdgcn_mfma_f32_32x32x16_bf16(pa1, PK(1), o[d0], 0, 0, 0);
    o[d0] = __builtin_amdgcn_mfma_f32_32x32x16_bf16(pa2, PK(2), o[d0], 0, 0, 0);
    o[d0] = __builtin_amdgcn_mfma_f32_32x32x16_bf16(pa3, PK(3), o[d0], 0, 0, 0);
    #undef PK
  }
}

constexpr int LDS2_GTAB = 142336;
static_assert(LDS2_GTAB == LDS_GTAB, "attention gain table offset");
constexpr int LDS2_V = NSLOT * SLOTB, LDS2_WS = LDS2_V + NSLOT * 2 * SLOTB, LDS2_OST = LDS2_WS + NW * 64 * 4, LDS_ATT2_BYTES = LDS2_OST + NW * 8192;
template<int THRL, int MODE> __device__ __forceinline__ void attn_unit2(int b, int qcol, int kcol, int vcol, int ocol, int qb, const bf16* Q, const bf16* __restrict__ K, const bf16* __restrict__ V, bf16* O, char* shm, bool pre, const bf16* Knext, const bf16* Vnext) {
  constexpr int DMP = PITCH;
  const int tid = opaque_tid(), lane = tid & 63, r32 = lane & 31, hi = lane >> 5; const int wid = __builtin_amdgcn_readfirstlane(tid >> 6);
  const long rowbase = (long)b * SEQ; const int q0 = qb * QB;
  const bf16* Qw = Q + (rowbase + q0 + wid * QBLK) * DMP + qcol;
  const bf16* Kh = K + rowbase * DMP + kcol, *Vh = V + rowbase * DMP + vcol;
  const unsigned lds0 = (unsigned)(uintptr_t)shm;
  float* wsf = (float*)(shm + LDS2_WS) + wid * 64;
  const unsigned koff = (unsigned)(lane * DMP + wid * 8) * 2u;
  const unsigned voff = (unsigned)((16 * (wid & 3) + (lane >> 2)) * DMP + (wid >> 2) * 32 + (lane & 3) * 8) * 2u;
  const unsigned kdst = lds0 + LDS_K + wid * 1024, vdst = lds0 + LDS2_V + wid * 1024;
  #define DMA_K(t, slot) glds16s(Kh + (long)(t) * KVBLK * DMP, koff, (unsigned)__builtin_amdgcn_readfirstlane(kdst + (slot)))
  #define DMA_V(t, slot) do { glds16s(Vh + (long)(t) * KVBLK * DMP, voff, (unsigned)__builtin_amdgcn_readfirstlane(vdst + 2 * (slot))); \
    glds16s(Vh + (long)(t) * KVBLK * DMP + 64, voff, (unsigned)__builtin_amdgcn_readfirstlane(vdst + 2 * (slot) + 8192)); } while (0)
  const char* Kbase = shm + LDS_K; bf16x8 kf[8];
  const lds_cptr shm3 = (lds_cptr)shm; const lds_cptr kp0 = shm3 + LDS_K + hi * 1024 + r32 * 16; const lds_cptr vp0 = shm3 + LDS2_V + ((lane >> 4) & 1) * 32 + (lane & 3) * 8 + (4 * hi + ((lane & 15) >> 2)) * 64;
  const int NT = (q0 + QB) / KVBLK;
  if (!pre) { DMA_K(0, 0); DMA_V(0, 0); DMA_K(1, SLOTB); }
  bf16x8 qr[4];
  #pragma unroll
  for (int d0 = 0; d0 < 4; ++d0) qr[d0] = *reinterpret_cast<const bf16x8*>(&Qw[(long)r32 * DMP + d0 * 16 + hi * 8]);
  float mhat = 0.f, l_reg = 0.f; f32x16 o[4]; o[0] = f32x16{}; o[1] = f32x16{}; o[2] = f32x16{}; o[3] = f32x16{}; const f32x16 zc = f32x16{};
  #define CMASK(P0, P1, t) do { int jb_ = (t) - (NT - 4); if (jb_ >= 0) { const int ln_ = opaque_tid() & 63; cmask(P0, P1, jb_, wid * QBLK + (ln_ & 31), ln_ >> 5); } } while (0)
  bool resc = false;
  #define START(P0, P1) do { const float rm = rowmax(P0, P1); resc = false; \
    { const float dl = rm; mhat = fadd_s(mhat, dl); \
      _Pragma("unroll") for (int r = 0; r < 16; ++r) { P0[r] = fsub_s(P0[r], dl); P1[r] = fsub_s(P1[r], dl); } \
      } \
    _Pragma("unroll") for (int r = 0; r < 16; ++r) P0[r] = __builtin_amdgcn_exp2f(P0[r]); } while (0)
  #define RESC() do { if (resc) { asm volatile("s_waitcnt lgkmcnt(0)" ::: "memory"); \
      _Pragma("unroll") for (int d_ = 0; d_ < 4; ++d_) _Pragma("unroll") for (int r = 0; r < 16; ++r) o[d_][r] *= wsf[crow(r, hi)]; } } while (0)
  f32x16 pA0, pA1, pB0, pB1;
  int sl_prev = 0, sl_cur = 0, sl_next = SLOTB;
  #define ROT() do { sl_prev = sl_cur; sl_cur = sl_next; sl_next = (sl_next == (NSLOT - 1) * SLOTB) ? 0 : sl_next + SLOTB; } while (0)
  DMA_K(2, 2 * SLOTB);
  WAIT_BAR(3);
  qkt(pA0, pA1, Kbase, qr, zc, r32, hi); asm volatile("s_nop 15\n\ts_nop 7" : "+v"(pA0), "+v"(pA1)); CMASK(pA0, pA1, 0);
  START(pA0, pA1);
  _Pragma("unroll") for (int r = 0; r < 16; ++r) pA1[r] = __builtin_amdgcn_exp2f(pA1[r]);
  WAIT_BAR(0);
  DMA_K(3, 0); DMA_V(1, SLOTB);
  ROT();
  kload8(kf, kp0 + sl_cur);
  WAIT_BAR(3);
  s16x4 vlo[8], vhi[8]; u32x4 pw0, pw1, pw2, pw3;
  #define PKW(P, B) cvtpk_s(P[B], P[B + 1])
  #define PAF(k) __builtin_bit_cast(bf16x8, pw##k)
  #define VFR(i) (bf16x8){vlo[i][0], vlo[i][1], vlo[i][2], vlo[i][3], vhi[i][0], vhi[i][1], vhi[i][2], vhi[i][3]}
  #define PIN(x) asm volatile("" : "+v"(x))
  #define MX3(a, b, c) __builtin_fmaxf(__builtin_fmaxf((a), (b)), (c))
  #define GAPA(MF, A0, A1, A2, A3, W0, W1, PW) do { MF; sacc += A0; sacc += A1; sacc += A2; sacc += A3; PIN(sacc); W0; W1; PIN(PW); SBAR(); } while (0)
  #define EX(v) __builtin_amdgcn_exp2f(v)
  #define GAPB(MF, X, B) do { MF; X[B] = EX(X[B]); X[B + 1] = EX(X[B + 1]); PIN(X); SBAR(); } while (0)
  #define VRD(i) do { vlo[i] = vtr(vp_ + (((i) >> 2) * 4096 + ((i) & 3) * 1024)); vhi[i] = vtr(vp_ + (((i) >> 2) * 4096 + ((i) & 3) * 1024 + 512)); } while (0)
  #define VRD2(i) do { vlo[i] = vtr(vp_ + (8192 + ((i) >> 2) * 4096 + ((i) & 3) * 1024)); vhi[i] = vtr(vp_ + (8192 + ((i) >> 2) * 4096 + ((i) & 3) * 1024 + 512)); SBAR(); } while (0)
  #define KRD(G, j) do { if (G) { kload2(kf, kp0 + sl_next, j); SBAR(); } } while (0)
  #define STEP(C0, C1, P0, P1, t, GK, GV, GL) do { SBAR(); \
    const lds_cptr vp_ = vp0 + 2 * sl_prev; \
    VRD(0); SBAR(); float sacc = (P0[0] + P0[1]); \
    GAPA(C0 = __builtin_amdgcn_mfma_f32_32x32x16_bf16(kf[0], qr[0], zc, 0, 0, 0), P0[2], P0[3], P0[4], P0[5],     pw0[0] = PKW(P0, 0), pw0[1] = PKW(P0, 2), pw0); \
    VRD(4); SBAR(); GAPA(C1 = __builtin_amdgcn_mfma_f32_32x32x16_bf16(kf[1], qr[0], zc, 0, 0, 0), P0[6], P0[7], P0[8], P0[9],     pw0[2] = PKW(P0, 4), pw0[3] = PKW(P0, 6), pw0); \
    VRD(1); SBAR(); GAPA(C0 = __builtin_amdgcn_mfma_f32_32x32x16_bf16(kf[2], qr[1], C0, 0, 0, 0),   P0[10], P0[11], P0[12], P0[13], pw1[0] = PKW(P0, 8), pw1[1] = PKW(P0, 10), pw1); \
    VRD(5); SBAR(); GAPA(C1 = __builtin_amdgcn_mfma_f32_32x32x16_bf16(kf[3], qr[1], C1, 0, 0, 0),   P0[14], P0[15], P1[0], P1[1],   pw1[2] = PKW(P0, 12), pw1[3] = PKW(P0, 14), pw1); \
    VRD(2); SBAR(); GAPA(C0 = __builtin_amdgcn_mfma_f32_32x32x16_bf16(kf[4], qr[2], C0, 0, 0, 0),   P1[2], P1[3], P1[4], P1[5],     pw2[0] = PKW(P1, 0), pw2[1] = PKW(P1, 2), pw2); \
    VRD(6); SBAR(); GAPA(C1 = __builtin_amdgcn_mfma_f32_32x32x16_bf16(kf[5], qr[2], C1, 0, 0, 0),   P1[6], P1[7], P1[8], P1[9],     pw2[2] = PKW(P1, 4), pw2[3] = PKW(P1, 6), pw2); \
    VRD(3); SBAR(); GAPA(C0 = __builtin_amdgcn_mfma_f32_32x32x16_bf16(kf[6], qr[3], C0, 0, 0, 0),   P1[10], P1[11], P1[12], P1[13], pw3[0] = PKW(P1, 8), pw3[1] = PKW(P1, 10), pw3); \
    VRD(7); SBAR(); GAPA(C1 = __builtin_amdgcn_mfma_f32_32x32x16_bf16(kf[7], qr[3], C1, 0, 0, 0),   P1[14], P1[15], 0.f, 0.f,       pw3[2] = PKW(P1, 12), pw3[3] = PKW(P1, 14), pw3); \
    l_reg += sacc; \
    _Pragma("unroll") for (int r = 0; r < 16; ++r) { C0[r] -= mhat; C1[r] -= mhat; } \
    if (GK) { DMA_K((t) + 3, sl_cur); } if (GV) { DMA_V((t) + 1, sl_next); } \
    CMASK(C0, C1, t); \
    { float a = MX3(C0[0], C0[1], C1[0]), b = MX3(C0[2], C0[3], C1[1]); a = MX3(a, C1[2], C1[3]); \
      _Pragma("unroll") for (int r = 4; r < 16; r += 4) { a = MX3(a, C0[r], C0[r + 1]); b = MX3(b, C0[r + 2], C0[r + 3]); a = MX3(a, C1[r], C1[r + 1]); b = MX3(b, C1[r + 2], C1[r + 3]); } \
      float rm = __builtin_fmaxf(a, b); { auto rr = __builtin_amdgcn_permlane32_swap(__float_as_uint(rm), __float_as_uint(rm), false, false); rm = __builtin_fmaxf(__uint_as_float(rr[0]), __uint_as_float(rr[1])); } \
      resc = false; \
      if (__builtin_expect(__any(rm > (float)THRL), 0)) { const float dl = __builtin_fmaxf(rm, 0.f); mhat += dl; \
        _Pragma("unroll") for (int r = 0; r < 16; ++r) { C0[r] -= dl; C1[r] -= dl; } \
        const float f = __builtin_amdgcn_exp2f(-dl); l_reg *= f; if (hi == 0) wsf[r32] = f; resc = true; } } \
    SBAR(); \
    GAPB(o[0] = __builtin_amdgcn_mfma_f32_32x32x16_bf16(PAF(0), VFR(0), o[0], 0, 0, 0), C0, 0); VRD2(0); \
    GAPB(o[1] = __builtin_amdgcn_mfma_f32_32x32x16_bf16(PAF(0), VFR(4), o[1], 0, 0, 0), C0, 2); VRD2(4); \
    KRD(GL, 0); GAPB(o[0] = __builtin_amdgcn_mfma_f32_32x32x16_bf16(PAF(1), VFR(1), o[0], 0, 0, 0), C0, 4); VRD2(1); \
    KRD(GL, 1); GAPB(o[1] = __builtin_amdgcn_mfma_f32_32x32x16_bf16(PAF(1), VFR(5), o[1], 0, 0, 0), C0, 6); VRD2(5); \
    KRD(GL, 2); GAPB(o[0] = __builtin_amdgcn_mfma_f32_32x32x16_bf16(PAF(2), VFR(2), o[0], 0, 0, 0), C0, 8); VRD2(2); \
    KRD(GL, 3); GAPB(o[1] = __builtin_amdgcn_mfma_f32_32x32x16_bf16(PAF(2), VFR(6), o[1], 0, 0, 0), C0, 10); VRD2(6); \
    GAPB(o[0] = __builtin_amdgcn_mfma_f32_32x32x16_bf16(PAF(3), VFR(3), o[0], 0, 0, 0), C0, 12); VRD2(3); \
    GAPB(o[1] = __builtin_amdgcn_mfma_f32_32x32x16_bf16(PAF(3), VFR(7), o[1], 0, 0, 0), C0, 14); VRD2(7); \
    GAPB(o[2] = __builtin_amdgcn_mfma_f32_32x32x16_bf16(PAF(0), VFR(0), o[2], 0, 0, 0), C1, 0); \
    GAPB(o[3] = __builtin_amdgcn_mfma_f32_32x32x16_bf16(PAF(0), VFR(4), o[3], 0, 0, 0), C1, 2); \
    GAPB(o[2] = __builtin_amdgcn_mfma_f32_32x32x16_bf16(PAF(1), VFR(1), o[2], 0, 0, 0), C1, 4); \
    GAPB(o[3] = __builtin_amdgcn_mfma_f32_32x32x16_bf16(PAF(1), VFR(5), o[3], 0, 0, 0), C1, 6); \
    GAPB(o[2] = __builtin_amdgcn_mfma_f32_32x32x16_bf16(PAF(2), VFR(2), o[2], 0, 0, 0), C1, 8); \
    GAPB(o[3] = __builtin_amdgcn_mfma_f32_32x32x16_bf16(PAF(2), VFR(6), o[3], 0, 0, 0), C1, 10); \
    GAPB(o[2] = __builtin_amdgcn_mfma_f32_32x32x16_bf16(PAF(3), VFR(3), o[2], 0, 0, 0), C1, 12); \
    GAPB(o[3] = __builtin_amdgcn_mfma_f32_32x32x16_bf16(PAF(3), VFR(7), o[3], 0, 0, 0), C1, 14); \
    } while (0)
  int t = 1;
  #undef CMASK
  #define CMASK(P0, P1, t) do {} while (0)
  for (; t + 5 < NT; t += 2) {
    STEP(pB0, pB1, pA0, pA1, t, true, true, true);     WAIT_BAR(3); RESC(); ROT();
    STEP(pA0, pA1, pB0, pB1, t + 1, true, true, true); WAIT_BAR(3); RESC(); ROT();
  }
  #undef CMASK
  #define CMASK(P0, P1, t) do { int jb_ = (t) - (NT - 4); if (jb_ >= 0) { const int ln_ = opaque_tid() & 63; cmask(P0, P1, jb_, wid * QBLK + (ln_ & 31), ln_ >> 5); } } while (0)
  #define ENDW(tt) do { if ((tt) + 3 < NT) { WAIT_BAR(3); } else if ((tt) + 2 < NT) { WAIT_BAR(2); } else { WAIT_BAR(0); } } while (0)
  for (; t + 1 < NT; t += 2) {
    STEP(pB0, pB1, pA0, pA1, t, (t + 3 < NT), (t + 1 < NT), (t + 1 < NT));         ENDW(t);     RESC(); ROT();
    STEP(pA0, pA1, pB0, pB1, t + 1, (t + 4 < NT), (t + 2 < NT), (t + 2 < NT));     ENDW(t + 1); RESC(); ROT();
  }
  STEP(pB0, pB1, pA0, pA1, NT - 1, false, false, false); RESC();
  { float sacc = pB0[0] + pB0[1]; _Pragma("unroll") for (int r = 2; r < 16; ++r) sacc += pB0[r]; _Pragma("unroll") for (int r = 0; r < 16; ++r) sacc += pB1[r]; l_reg += sacc;
    pw0 = (u32x4){PKW(pB0, 0), PKW(pB0, 2), PKW(pB0, 4), PKW(pB0, 6)}; pw1 = (u32x4){PKW(pB0, 8), PKW(pB0, 10), PKW(pB0, 12), PKW(pB0, 14)}; pw2 = (u32x4){PKW(pB1, 0), PKW(pB1, 2), PKW(pB1, 4), PKW(pB1, 6)}; pw3 = (u32x4){PKW(pB1, 8), PKW(pB1, 10), PKW(pB1, 12), PKW(pB1, 14)};
    SBAR(); const int ln_ = opaque_tid() & 63; const int vb0 = (int)(lds0 + LDS2_V) + ((ln_ >> 4) & 1) * 32 + (ln_ & 3) * 8 + (4 * (ln_ >> 5) + ((ln_ & 15) >> 2)) * 64;
    pv(o, vb0 + 2 * sl_cur, PAF(0), PAF(1), PAF(2), PAF(3)); pv(o + 2, vb0 + 2 * sl_cur + 8192, PAF(0), PAF(1), PAF(2), PAF(3)); }
  asm volatile("s_waitcnt lgkmcnt(0)\n\ts_barrier" ::: "memory");
  if (Knext) { glds16s(Knext, koff, (unsigned)__builtin_amdgcn_readfirstlane(kdst)); glds16s(Vnext, voff, (unsigned)__builtin_amdgcn_readfirstlane(vdst)); glds16s(Vnext + 64, voff, (unsigned)__builtin_amdgcn_readfirstlane(vdst + 8192));
               glds16s(Knext + (long)KVBLK * DMP, koff, (unsigned)__builtin_amdgcn_readfirstlane(kdst + SLOTB)); }
  #undef PKW
  #undef PAF
  #undef VFR
  #undef PIN
  #undef MX3
  #undef GAPA
  #undef GAPB
  #undef EX
  #undef VRD
  #undef VRD2
  #undef KRD
  #undef STEP
  #undef ENDW
  { auto rr = __builtin_amdgcn_permlane32_swap(__float_as_uint(l_reg), __float_as_uint(l_reg), false, false); l_reg = __uint_as_float(rr[0]) + __uint_as_float(rr[1]); }
  if (hi == 0) wsf[32 + r32] = l_reg; asm volatile("s_waitcnt lgkmcnt(0)" ::: "memory");
  float rli[16];
  #pragma unroll
  for (int r = 0; r < 16; ++r) rli[r] = __builtin_amdgcn_rcpf(wsf[32 + crow(r, hi)]);
  bf16* Ow = O + (rowbase + q0 + wid * QBLK) * DMP + ocol;
  { bf16* stg = (bf16*)(shm + LDS2_OST) + wid * 4096;
    if (MODE == 1) {
      #pragma unroll
      for (int r = 0; r < 16; ++r) { const int orow = crow(r, hi);
        #pragma unroll
        for (int d0 = 0; d0 < 4; ++d0) stg[orow * 128 + d0 * 32 + r32] = __float2bfloat16(o[d0][r] * rli[r]); }
      asm volatile("s_waitcnt lgkmcnt(0)" ::: "memory");
    } else {
      const float* gain = (const float*)(shm + LDS2_GTAB);
      const float lam = gain[128];
      float gn[4];
      #pragma unroll
      for (int d0 = 0; d0 < 4; ++d0) gn[d0] = gain[d0 * 32 + r32];
      #pragma unroll
      for (int r = 0; r < 16; ++r) { const int orow = crow(r, hi); float sq = 0.f;
        #pragma unroll
        for (int d0 = 0; d0 < 4; ++d0) { const float d = __bfloat162float(stg[orow * 128 + d0 * 32 + r32]) - lam * (o[d0][r] * rli[r]); o[d0][r] = d; sq += d * d; }
        sq += __shfl_xor(sq, 1); sq += __shfl_xor(sq, 2); sq += __shfl_xor(sq, 4); sq += __shfl_xor(sq, 8); sq += __shfl_xor(sq, 16);
        const float rs = rsqrtf(sq * (1.0f / 128.0f) + 1e-5f);
        #pragma unroll
        for (int d0 = 0; d0 < 4; ++d0) stg[orow * 128 + d0 * 32 + r32] = __float2bfloat16(o[d0][r] * rs * gn[d0]); }
      asm volatile("s_waitcnt lgkmcnt(0)" ::: "memory");
      #pragma unroll
      for (int i = 0; i < 8; ++i) { const int row = i * 4 + (lane >> 4), ch = lane & 15; const u32x4 v = *(const u32x4*)(stg + row * 128 + ch * 8); *(u32x4*)(Ow + (long)row * DMP + ch * 8) = v; } } }
  asm volatile("s_waitcnt lgkmcnt(0)" ::: "memory");
  #undef DMA_K
  #undef DMA_V
  #undef CMASK
  #undef START
  #undef RESC
  #undef ROT
}
#undef SBAR
#undef WAIT_BAR
}

#define XB_TMO      128
#define XB_XCNT(j)  (256  + 64 * (j))
#define XB_XSUB(j)  (1280 + 64 * (j))
#define XB_XGEN(j)  (2304 + 64 * (j))
#define XB_TOP      3328
#define XB_TOPGEN   3392
#define XCD_BAR_WORDS 3456
#define XB_SPIN_CAP (1u << 18)
__device__ __forceinline__ unsigned xb_ld(unsigned* p)              { return __hip_atomic_load(p, __ATOMIC_RELAXED, __HIP_MEMORY_SCOPE_AGENT); }
__device__ __forceinline__ unsigned xb_add(unsigned* p, unsigned v) { return __hip_atomic_fetch_add(p, v, __ATOMIC_RELAXED, __HIP_MEMORY_SCOPE_AGENT); }
__device__ __forceinline__ unsigned xb_xcc_id() { return (unsigned)__builtin_amdgcn_s_getreg((3 << 11) | 20) & 0xFu; }
#define XB_SPIN(cond, bar) do { unsigned _sp = 0; while (cond) { __builtin_amdgcn_s_sleep(1); \
    if ((++_sp & 255u) == 0u) { if (xb_ld(&(bar)[XB_TMO])) break; if (_sp > XB_SPIN_CAP) { atomicAdd(&(bar)[XB_TMO], 1u); break; } } } } while (0)
struct XcdBarrier { unsigned* bar; unsigned x; volatile LAS unsigned* st; };
__device__ __forceinline__ XcdBarrier xcd_barrier_post(unsigned* bar, volatile LAS unsigned* st) {
    XcdBarrier b; b.bar = bar; b.x = xb_xcc_id(); b.st = st;
    if (threadIdx.x == 0) (void)xb_add(&bar[XB_XCNT(b.x)], 1u);
    return b;
}
__device__ __forceinline__ void xcd_barrier_complete(unsigned* bar, unsigned x, unsigned& nloc, unsigned& nx) {
    const unsigned G = gridDim.x * gridDim.y * gridDim.z;
    unsigned sum, cnt, mine, sp = 0u;
    for (;;) {
        sum = 0u; cnt = 0u; mine = 0u;
#pragma unroll
        for (unsigned j = 0; j < 16; ++j) { const unsigned c = xb_ld(&bar[XB_XCNT(j)]); sum += c; cnt += (c > 0u) ? 1u : 0u; mine = (j == x) ? c : mine; }
        if (sum == G) break;
        __builtin_amdgcn_s_sleep(1);
        if ((++sp & 255u) == 0u) { if (xb_ld(&bar[XB_TMO])) break; if (sp > XB_SPIN_CAP) { atomicAdd(&bar[XB_TMO], 1u); break; } }
    }
    nloc = mine > 0u ? mine : 1u; nx = cnt > 0u ? cnt : 1u;
}
__device__ __forceinline__ void xcd_barrier(const XcdBarrier& b) {
    asm volatile("s_waitcnt vmcnt(0)" ::: "memory");
    __syncthreads();
    if (threadIdx.x == 0) {
        unsigned* bar = b.bar;
        __builtin_amdgcn_s_waitcnt(0);
        unsigned nloc = b.st[0], nx = b.st[1];
        if (nloc == 0u) { xcd_barrier_complete(bar, b.x, nloc, nx); b.st[0] = nloc; b.st[1] = nx; }
        const unsigned old = xb_add(&bar[XB_XSUB(b.x)], 1u);
        const unsigned gen = old / nloc;
        if (old + 1u == (gen + 1u) * nloc) {
            __builtin_amdgcn_fence(__ATOMIC_RELEASE, "agent");
            asm volatile("s_waitcnt vmcnt(0)" ::: "memory");
            const unsigned og = xb_add(&bar[XB_TOP], 1u);
            const unsigned tg = og / nx;
            if (og + 1u == (tg + 1u) * nx) xb_add(&bar[XB_TOPGEN], 1u);
            else XB_SPIN(xb_ld(&bar[XB_TOPGEN]) == tg, bar);
            __builtin_amdgcn_fence(__ATOMIC_ACQUIRE, "agent");
            xb_add(&bar[XB_XGEN(b.x)], 1u);
            asm volatile("s_waitcnt vmcnt(0)" ::: "memory");
        } else {
            XB_SPIN(xb_ld(&bar[XB_XGEN(b.x)]) == gen, bar);
            __builtin_amdgcn_fence(__ATOMIC_ACQUIRE, "agent");
            asm volatile("s_waitcnt vmcnt(0)" ::: "memory");
        }
    }
    __syncthreads();
}

__device__ __forceinline__ int map_row(int n, int mode, int arg) {
    if (mode == 1) return (n >> 7) * 256 + arg * 128 + (n & 127);
    if (mode == 2) { const int d = n & 63; if (d < 16) { const int dp = d < 8 ? 2 * d : 2 * (d - 8) + 1; return n - d + dp; } return n; }
    return n;
}
__device__ __forceinline__ void cvt_item(const float* W, int ldw, int K, int ncols, bf16_t* WT, const float* g, float scale, int mode, int arg, LAS float* scr, int item, int lane, int f16 = 0) {
    const int nblk = ncols / 64, kb = item / nblk, nb = item % nblk, k0 = 64 * kb, n0 = 64 * nb;
#pragma unroll
    for (int i = 0; i < 16; ++i) { const int kk = 4 * i + (lane >> 4); const float gs = g ? g[k0 + kk] * scale : scale;
        const f32x4 v = *(const f32x4*)(W + (size_t)(k0 + kk) * ldw + n0 + (lane & 15) * 4) * gs;
        LAS float* d = scr + kk * 65 + (lane & 15) * 4; d[0] = v[0]; d[1] = v[1]; d[2] = v[2]; d[3] = v[3]; }
    asm volatile("s_waitcnt lgkmcnt(0)" ::: "memory");
    const int c = lane & 7;
#pragma unroll
    for (int j = 0; j < 8; ++j) { const int n = (lane >> 3) + 8 * j; const LAS float* s = scr + (8 * c) * 65 + n;
        u32x4 o;
        if (f16) { o.x = cvt_pk_f16(s[0 * 65], s[1 * 65]); o.y = cvt_pk_f16(s[2 * 65], s[3 * 65]); o.z = cvt_pk_f16(s[4 * 65], s[5 * 65]); o.w = cvt_pk_f16(s[6 * 65], s[7 * 65]); }
        else { o.x = cvt_pk_bf16(s[0 * 65], s[1 * 65]); o.y = cvt_pk_bf16(s[2 * 65], s[3 * 65]); o.z = cvt_pk_bf16(s[4 * 65], s[5 * 65]); o.w = cvt_pk_bf16(s[6 * 65], s[7 * 65]); }
        *(u32x4*)(WT + (size_t)map_row(n0 + n, mode, arg) * K + k0 + 8 * c) = o; }
    asm volatile("s_waitcnt lgkmcnt(0)" ::: "memory");
}

struct Args { const void* in[34]; int ph_lo, ph_hi; };
__device__ __forceinline__ const void* ldarg(const Args& a, int k) { asm volatile("" : "+s"(k)); return a.in[k]; }
#define FARG(k) ((const float*)ldarg(args, k))
#define WSP(off) ((bf16_t*)((unsigned char*)ldarg(args, 33) + (off)))

__device__ __forceinline__ void convert_layer(const Args& args, int l, int parts, LAS float* scr, int gw, int NGW, int lane, int gtid, int NGT) {
    const int I1K = 16 * 16;
    const int IGU = 16 * (FF / 64), IDN = (FF / 64) * 16;
    const int n0 = 4 * I1K + I1K, n1 = n0 + 2 * IGU, total = n1 + IDN;
    for (int seg = 0; seg < 3; ++seg) {
        const int bit = seg == 0 ? 1 : (seg == 1 ? 4 : 2); if (!(parts & bit)) continue;
        const int it_lo = seg == 0 ? 0 : (seg == 1 ? n0 : n1), it_hi = seg == 0 ? n0 : (seg == 1 ? n1 : total);
    for (int it = it_lo + gw; it < it_hi; it += NGW) {
        int r = it;
#define CVT(Wp, ldw, K, ncols, WTp, gp, sc, mode, arg, F16_) { const int ni = ((K) / 64) * ((ncols) / 64); if (r >= 0 && r < ni) cvt_item(Wp, ldw, K, ncols, WTp, gp, sc, mode, arg, scr, r, lane, F16_); r -= ni; }
        if (l < 2) {
            CVT(FARG(7) + (size_t)l * DM * 2 * DM, 2 * DM, DM, DM, WSP(WS_WMIX), FARG(3) + l * DM, 1.f, 1, 0, 1);
            CVT(FARG(7) + (size_t)l * DM * 2 * DM + DM, 2 * DM, DM, DM, WSP(WS_WMIX), FARG(3) + l * DM, 1.f, 1, 1, 1);
            CVT(FARG(13) + (size_t)l * DM * DM, DM, DM, DM, WSP(WS_WMIX) + (size_t)2 * DM * DM, nullptr, 1.f, 0, 0, 0);
            r -= I1K;
        } else {
            const int b = l - 2;
            CVT(FARG(18) + (size_t)b * DM * DM, DM, DM, DM, WSP(WS_WMIX), FARG(3) + l * DM, 1.f, 2, 0, 1);
            CVT(FARG(24) + (size_t)b * DM * DM, DM, DM, DM, WSP(WS_WMIX) + (size_t)3 * DM * DM, nullptr, 1.f, 0, 0, 0);
            if (l == 2) {
                CVT(FARG(16), DM, DM, DM, WSP(WS_WMIX) + (size_t)DM * DM, FARG(15), 1.f, 2, 0, 1);
                CVT(FARG(17), DM, DM, DM, WSP(WS_WMIX) + (size_t)2 * DM * DM, FARG(15), 1.f, 0, 0, 1);
            } else r -= 2 * I1K;
        }
        CVT(FARG(28) + (size_t)l * DM * DM, DM, DM, DM, WSP(WS_WOT), nullptr, 1.f, 0, 0, 0);
        CVT(FARG(29) + (size_t)l * DM * FF, FF, DM, FF, WSP(WS_WGU), FARG(5) + l * DM, 1.f, 1, 0, 1);
        CVT(FARG(30) + (size_t)l * DM * FF, FF, DM, FF, WSP(WS_WGU), FARG(5) + l * DM, 1.f, 1, 1, 1);
        CVT(FARG(31) + (size_t)l * FF * DM, DM, FF, DM, WSP(WS_WD), nullptr, 1.f, 0, 0, 0);
#undef CVT
    } }
    if (parts & 1) { const float* wq = FARG(25) + (size_t)l * DM * DM; bf16_t* o = WSP(WS_WQS); const float* norm_mem = FARG(4) + l * DM;
      for (int i = gtid; i < DM * DM / 8; i += NGT) { const int k = i >> 7; const float gs = norm_mem[k] * (0.0625f * LOG2E);
          const f32x4 v0 = *(const f32x4*)(wq + (size_t)i * 8) * gs, v1 = *(const f32x4*)(wq + (size_t)i * 8 + 4) * gs;
          u32x4 w; w.x = cvt_pk_bf16(v0[0], v0[1]); w.y = cvt_pk_bf16(v0[2], v0[3]); w.z = cvt_pk_bf16(v1[0], v1[1]); w.w = cvt_pk_bf16(v1[2], v1[3]);
          *(u32x4*)(o + (size_t)i * 8) = w; } }
}

__device__ __forceinline__ void conv_phase(const bf16_t* Gin, bf16_t* CV, const float* wdw, const float* bdw, const float* lng, const float* lnb, LAS unsigned char* lds, int G, int c) {
    constexpr int CT = 16;
    const int tid = opaque_tid(), lane = tid & 63, wid = tid >> 6, ch = 2 * tid;
    LAS float* red = (LAS float*)lds;
    LAS float* st = (LAS float*)(lds + 4096);
    f32x2 w2[31];
#pragma unroll
    for (int j = 0; j < 31; ++j) w2[j] = *(const f32x2*)(wdw + j * DM + ch);
    const f32x2 bd = *(const f32x2*)(bdw + ch), gg = *(const f32x2*)(lng + ch), bb = *(const f32x2*)(lnb + ch);
    for (int unit = c; unit < TR / CT; unit += G) {
        const int row0 = unit * CT, t0 = row0 & (SEQ - 1);
        f32x2 x2[CT + 30];
#pragma unroll
        for (int j = 0; j < CT + 30; ++j) { const bool ok = (t0 - 30 + j) >= 0; const unsigned v = ok ? *(const unsigned*)(Gin + (size_t)(row0 - 30 + j) * DM + ch) : 0u; x2[j] = (f32x2){bf_lo(v), bf_hi(v)}; }
        float u0[CT], u1[CT];
#pragma unroll
        for (int t = 0; t < CT; ++t) { f32x2 a = bd;
#pragma unroll
            for (int j = 0; j < 31; ++j) a = __builtin_elementwise_fma(w2[j], x2[t + j], a);
            u0[t] = a[0]; u1[t] = a[1]; }
#pragma unroll
        for (int t = 0; t < CT; ++t) { float s = u0[t] + u1[t], q = u0[t] * u0[t] + u1[t] * u1[t]; s = wave_sum(s); q = wave_sum(q);
            if (lane == 0) { red[(wid * CT + t) * 2] = s; red[(wid * CT + t) * 2 + 1] = q; } }
        __syncthreads();
        if (tid < CT) { float s = 0.f, q = 0.f;
#pragma unroll
            for (int w = 0; w < 8; ++w) { s += red[(w * CT + tid) * 2]; q += red[(w * CT + tid) * 2 + 1]; }
            const float mean = s * (1.0f / DM), var = q * (1.0f / DM) - mean * mean;
            st[tid * 2] = mean; st[tid * 2 + 1] = rsqrtf(fmaxf(var, 0.f) + LN_EPS); }
        __syncthreads();
#pragma unroll
        for (int t = 0; t < CT; ++t) { const float mean = st[t * 2], rstd = st[t * 2 + 1];
            float y0 = (u0[t] - mean) * rstd * gg[0] + bb[0], y1 = (u1[t] - mean) * rstd * gg[1] + bb[1];
            y0 *= fast_sigmoid(y0); y1 *= fast_sigmoid(y1);
            *(unsigned*)(CV + (size_t)(row0 + t) * DM + ch) = cvt_pk_bf16(y0, y1); }
        __syncthreads();
    }
}

__global__ void __launch_bounds__(512, 2) yoco_fwd(Args args) {
    extern __shared__ __attribute__((aligned(16))) unsigned char lds_raw[];
    LAS unsigned char* lds = (LAS unsigned char*)lds_raw;
    cg::grid_group grid = cg::this_grid();
    const int G = gridDim.x, bx = blockIdx.x;
#define THIN_IDS const int tid = opaque_tid(), lane = tid & 63, wave = __builtin_amdgcn_readfirstlane(tid >> 6); const int gw = bx * 8 + wave, NGW = G * 8, gtid = bx * 512 + tid, NGT = G * 512; LAS float* scr = (LAS float*)(lds + wave * 16640); (void)lane; (void)gw; (void)NGW; (void)gtid; (void)NGT; (void)scr;
#define XRES ((float*)ldarg(args, 32))
#define SSP  ((float*)WSP(WS_SS))
#define HB   WSP(WS_HB)

    { const int t0 = opaque_tid(); if (t0 < 4) ((LAS unsigned*)(lds + LDS_BARST))[t0] = 0u; }
    __syncthreads();
    (void)xcd_barrier_post((unsigned*)WSP(WS_BAR), (volatile LAS unsigned*)(lds + LDS_BARST));
#define SEAM() do { if (args.ph_hi < 0) grid.sync();     \
        XcdBarrier xb_; xb_.bar = (unsigned*)WSP(WS_BAR); xb_.x = xb_xcc_id(); xb_.st = (volatile LAS unsigned*)(lds + LDS_BARST); xcd_barrier(xb_); } while (0)
#ifndef PROBE_MASK
#define PROBE_MASK 0u
#endif
    bool last_phase_ = false;
#define PH_BEGIN(kind) { const bool probe_ = (PROBE_MASK >> (kind)) & 1u; const unsigned long long pt0_ = probe_ ? __builtin_amdgcn_s_memrealtime() : 0ull;
#define PH_END   if (probe_) { __syncthreads(); const unsigned long long pt1_ = __builtin_amdgcn_s_memrealtime(); while (__builtin_amdgcn_s_memrealtime() - pt1_ < 3ull * (pt1_ - pt0_)) __builtin_amdgcn_s_sleep(8); } \
                 if (!last_phase_) SEAM(); }

    PH_BEGIN(0)
    {   THIN_IDS
        const float* x = FARG(0); const float* mem = FARG(1); const int* pos = (const int*)ldarg(args, 2);
        float* ss = SSP; bf16_t* xb = WSP(WS_XB); bf16_t* memb = WSP(WS_MEMB);
        for (int m0 = gw; m0 < TR + NBATCH * NMEM; m0 += 2 * NGW) {
            f32x4 v[2][4]; bool ok[2];
#pragma unroll
            for (int q = 0; q < 2; ++q) { const int m = m0 + q * NGW; ok[q] = m < TR + NBATCH * NMEM; const bool isx = m < TR;
                const float* src = isx ? x + (size_t)m * DM : mem + (size_t)(m - TR) * DM;
#pragma unroll
                for (int j = 0; j < 4; ++j) v[q][j] = ok[q] ? *((const f32x4*)src + lane + 64 * j) : (f32x4){0.f, 0.f, 0.f, 0.f}; }
#pragma unroll
            for (int q = 0; q < 2; ++q) { const int m = m0 + q * NGW; if (!ok[q]) continue; const bool isx = m < TR;
                bf16_t* dst = isx ? xb + (size_t)m * DM : memb + (size_t)(m - TR) * DM; float sq = 0.f;
#pragma unroll
                for (int j = 0; j < 4; ++j) { const f32x4 w4 = v[q][j]; sq += (w4[0] * w4[0] + w4[1] * w4[1]) + (w4[2] * w4[2] + w4[3] * w4[3]);
                    u32x2 w; if (isx) { w.x = cvt_pk_f16(w4[0], w4[1]); w.y = cvt_pk_f16(w4[2], w4[3]); } else { w.x = cvt_pk_bf16(w4[0], w4[1]); w.y = cvt_pk_bf16(w4[2], w4[3]); } *((u32x2*)dst + lane + 64 * j) = w; }
                sq = wave_sum(sq);
                if (isx && lane < 4) ss[(size_t)m * 4 + lane] = lane == 0 ? sq : 0.f; }
        }
        float* cosT = (float*)WSP(WS_COS); float* sinT = (float*)WSP(WS_SIN);
        for (int i = gtid; i < TR * 8; i += NGT) { const int row = i >> 3, k = i & 7; const float inv = powf(500000.0f, -(float)(2 * k) / 16.0f); const float ang = (float)pos[row] * inv;
            cosT[i] = cosf(ang); sinT[i] = sinf(ang); }
        for (int it = gw; it < 8 * 256; it += NGW) { const int j = it >> 8, l = j >> 1, kv = j & 1;
            cvt_item(FARG(kv ? 27 : 26) + (size_t)l * DM * DM, DM, DM, DM, HB + (size_t)j * DM * DM, nullptr, 1.f, 0, 0, scr, it & 255, lane); }
        convert_layer(args, 0, 7, scr, gw, NGW, lane, gtid, NGT);
    }
    PH_END

    PH_BEGIN(1)
    {   pg8::Gemm g{WSP(WS_MEMB), HB, DM, DM, DM, 0, (long)NMEM * DM, (long)DM * DM, 0, 0, 4};
        pg8::Order S; S.init(1, 4, 32, G, bx);
        pg8::EpiPlain E{WSP(WS_KV), DM, (long)4 * NMEM * DM, (long)NMEM * DM, 4, 0};
        pg8::gemm_phase(lds, g, S, E);
    }
    PH_END

    for (int l = 0; l < 4; ++l) {
        const bool is_conv = l < 2;

        PH_BEGIN(3)
        if (is_conv) {
            pg8::Gemm g{WSP(WS_XB), WSP(WS_WMIX), DM, DM, DM, 0, 0, 0, 0, 0, 1}; pg8::Order S; S.init(TR / 256, 8, 1, G, bx);
            pg8::EpiGated<0> E{WSP(WS_R1), DM, SSP, FARG(8) + l * 2 * DM, DM};
            pg8::gemm_phase<pg8::EpiGated<0>, true>(lds, g, S, E);
        } else {
            pg8::Gemm g{WSP(WS_XB), WSP(WS_WMIX), DM, DM, DM, 0, 0, 0, 0, 0, 1}; pg8::Order S; S.init(TR / 256, l == 2 ? 12 : 4, 1, G, bx);
            pg8::EpiQKV E{WSP(WS_R1), (size_t)(WS_KSH - WS_R1) / 2, SSP, (const float*)WSP(WS_COS), (const float*)WSP(WS_SIN)};
            pg8::gemm_phase<pg8::EpiQKV, true>(lds, g, S, E);
        }
        {
            pg8::Gemm g1{WSP(WS_KV) + (size_t)(l * 2 + 0) * 4 * NMEM * DM, WSP(WS_WQS), DM, DM, 256, (long)NMEM * DM, 256, 0, 256, 0, 4}; pg8::Order S1; S1.init(1, 4, 16, G, bx);
            pg8::EpiPlain E1{WSP(WS_BTS), DM, (long)DM * DM, (long)256 * DM, 4, 1};
            pg8::gemm_phase(lds, g1, S1, E1);
            pg8::Gemm g2{WSP(WS_WOT), WSP(WS_KV) + (size_t)(l * 2 + 1) * 4 * NMEM * DM, DM, DM, 256, 0, 256, (long)NMEM * DM, 256, 0, 4}; pg8::Order S2; S2.init(4, 1, 16, G, G - 1 - bx);
            pg8::EpiPlain E2{WSP(WS_BTO), DM, (long)DM * DM, 256, 4, 0};
            pg8::gemm_phase(lds, g2, S2, E2);
        }
        PH_END

        PH_BEGIN((is_conv ? 4 : 5))
        if (is_conv) {
#ifndef NO_CONV
            conv_phase(WSP(WS_R1), HB, FARG(9) + l * 31 * DM, FARG(10) + l * DM, FARG(11) + l * DM, FARG(12) + l * DM, lds, G, bx);
#endif
        } else {
#ifndef NO_ATTN
            const attn_body::bf16* qd = (const attn_body::bf16*)WSP(WS_R1); const attn_body::bf16* kd = (const attn_body::bf16*)WSP(WS_KSH); const attn_body::bf16* vd = (const attn_body::bf16*)WSP(WS_VSH);
            attn_body::bf16* od = (attn_body::bf16*)WSP(WS_R1);
            float lam, li1;
            {   const int ln = opaque_tid() & 63; const int bb = l - 2; const float lambda_init = 0.8f - 0.6f * expf(-0.3f * (float)l);
                const float d1 = wave_sum(FARG(19)[bb * 64 + ln] * FARG(20)[bb * 64 + ln]), d2 = wave_sum(FARG(21)[bb * 64 + ln] * FARG(22)[bb * 64 + ln]);
                lam = expf(d1) - expf(d2) + lambda_init; li1 = 1.0f - lambda_init; }
            float* gtab = (float*)((char*)lds_raw + LDS_GTAB);
            { const int t = opaque_tid(); if (t < 128) gtab[t] = FARG(23)[(l - 2) * 128 + t] * li1; if (t == 128) gtab[128] = lam; }
            __syncthreads();
#define ATT_PAIR(B_, H_, QB_, PRE_, KN_, VN_) do { const attn_body::bf16* kb_ = kd + (size_t)(B_) * SEQ * DM + (H_) * 128; const attn_body::bf16* vb_ = vd + (size_t)(B_) * SEQ * DM + (H_) * 128; \
                attn_body::attn_unit2<8, 1>(B_, (H_) * 128, (H_) * 128, (H_) * 128, (H_) * 128, QB_, qd, kd, vd, od, (char*)lds_raw, PRE_, kb_ + 64, vb_); \
                attn_body::attn_unit2<8, 2>(B_, (H_) * 128 + 64, (H_) * 128 + 64, (H_) * 128, (H_) * 128, QB_, qd, kd, vd, od, (char*)lds_raw, true, KN_, VN_); } while (0)
            bool pre = false;
            for (int i = 0;; ++i) { int b, h, qb; const attn_body::bf16* kn = nullptr; const attn_body::bf16* vn = nullptr;
                if (G == 256) {
                    if (i >= 2) break; const int xk = bx >> 3, bh = (bx & 7) * 4 + (xk >> 3), p = xk & 7; b = bh >> 3; h = bh & 7; qb = i == 0 ? 15 - p : p;
                    if (i == 0) { kn = kd + (size_t)b * SEQ * DM + h * 128; vn = vd + (size_t)b * SEQ * DM + h * 128; }
                } else {
                    const int pp = (i & 1) ? (G - 1 - bx) : bx; const int idx = i * G + pp; if (idx >= 512) break; qb = 15 - (idx >> 5); const int j = idx & 31; b = j >> 3; h = j & 7; }
                ATT_PAIR(b, h, qb, pre, kn, vn); pre = kn != nullptr; }
#undef ATT_PAIR
            __syncthreads();
#endif
        }
        if (l > 0) { THIN_IDS convert_layer(args, l, 2, scr, gw, NGW, lane, gtid, NGT); }
        PH_END

        PH_BEGIN(7)
        {   pg8::Gemm g{is_conv ? HB : WSP(WS_R1), WSP(WS_WMIX) + (size_t)(is_conv ? 2 : 3) * DM * DM, DM, DM, DM, 0, 0, 0, 0, 0, 1}; pg8::Order S; S.init(TR / 256, 4, 1, G, bx);
            pg8::EpiResid E{WSP(WS_XB), SSP, is_conv ? FARG(14) + l * DM : nullptr};
            pg8::gemm_phase(lds, g, S, E);
        }
        PH_END

        PH_BEGIN(8)
        {   pg8::Gemm g{WSP(WS_XB), WSP(WS_BTS), DM, DM, DM, 0, 0, 0, 0, (long)DM * DM, 1}; pg8::Order S; S.init(TR / 256, 4, 1, G, bx);
            pg8::EpiSoftmax E{WSP(WS_R1), SSP};
            pg8::gemm_phase<pg8::EpiSoftmax, true>(lds, g, S, E);
        }
        PH_END

        PH_BEGIN(9)
        {   pg8::Gemm g{WSP(WS_R1), WSP(WS_BTO), DM, DM, DM, 0, 0, 0, 0, (long)DM * DM, 1}; pg8::Order S; S.init(TR / 256, 4, 1, G, bx);
            pg8::EpiResid E{WSP(WS_XB), SSP, nullptr};
            pg8::gemm_phase(lds, g, S, E);
        }
        PH_END

        PH_BEGIN(10)
        {   pg8::Gemm g{WSP(WS_XB), WSP(WS_WGU), DM, DM, DM, 0, 0, 0, 0, 0, 1}; pg8::Order S; S.init(TR / 256, 2 * FF / 256, 1, G, bx);
            pg8::EpiGated<1> E{HB, FF, SSP, nullptr, 0};
            pg8::gemm_phase<pg8::EpiGated<1>, true>(lds, g, S, E);
            {   const int nun = (TR / 256) * (2 * FF / 256), tail = nun % G;
                if (l < 3) { if (tail > 0 && bx >= tail) { const int tid = opaque_tid(), lane = tid & 63, wave = __builtin_amdgcn_readfirstlane(tid >> 6); LAS float* scr = (LAS float*)(lds + wave * 16640);
                        convert_layer(args, l + 1, 1, scr, (bx - tail) * 8 + wave, (G - tail) * 8, lane, (bx - tail) * 512 + tid, (G - tail) * 512); }
                    else if (tail == 0) { THIN_IDS convert_layer(args, l + 1, 1, scr, gw, NGW, lane, gtid, NGT); } } }
        }
        PH_END

        PH_BEGIN(11)
        {   pg8::Gemm g{HB, WSP(WS_WD), FF, FF, FF, 0, 0, 0, 0, 0, 1}; pg8::Order S; S.init(TR / 256, 4, 1, G, bx);
            pg8::EpiResid E{WSP(WS_XB), SSP, nullptr};
            pg8::gemm_phase(lds, g, S, E);
            if (l < 3) { THIN_IDS convert_layer(args, l + 1, 4, scr, gw, NGW, lane, gtid, NGT); }
        }
        PH_END
    }

    last_phase_ = true;
    PH_BEGIN(12)
    {   THIN_IDS
        const float* gfin = FARG(6); float* outp = XRES; const bf16_t* xb = WSP(WS_XB);
        for (int m0 = gw; m0 < TR; m0 += 2 * NGW) {
            u32x4 ra[2][2]; bool ok[2];
#pragma unroll
            for (int q = 0; q < 2; ++q) { const int m = m0 + q * NGW; ok[q] = m < TR; const u32x4* p = (const u32x4*)(xb + (size_t)(ok[q] ? m : m0) * DM); ra[q][0] = p[lane]; ra[q][1] = p[64 + lane]; }
#pragma unroll
            for (int q = 0; q < 2; ++q) { const int m = m0 + q * NGW; if (!ok[q]) continue; const u32x4 a = ra[q][0], b = ra[q][1];
            float v[16];
#pragma unroll
            for (int j = 0; j < 4; ++j) { v[2 * j] = h_lo(a[j]); v[2 * j + 1] = h_hi(a[j]); v[8 + 2 * j] = h_lo(b[j]); v[8 + 2 * j + 1] = h_hi(b[j]); }
            float sq = 0.f;
#pragma unroll
            for (int j = 0; j < 16; ++j) sq += v[j] * v[j];
            const float rs = rsqrtf(wave_sum(sq) * (1.0f / DM) + RMS_EPS);
            float* orow = outp + (size_t)m * DM;
#pragma unroll
            for (int h = 0; h < 2; ++h) { const int c0 = h * 512 + lane * 8; const f32x4 g0 = *(const f32x4*)(gfin + c0), g1 = *(const f32x4*)(gfin + c0 + 4);
                *(f32x4*)(orow + c0) = (f32x4){v[8 * h + 0] * rs * g0[0], v[8 * h + 1] * rs * g0[1], v[8 * h + 2] * rs * g0[2], v[8 * h + 3] * rs * g0[3]};
                *(f32x4*)(orow + c0 + 4) = (f32x4){v[8 * h + 4] * rs * g1[0], v[8 * h + 5] * rs * g1[1], v[8 * h + 6] * rs * g1[2], v[8 * h + 7] * rs * g1[3]}; } } }
    }
    PH_END
#undef PH_BEGIN
#undef PH_END
}

extern "C" void kernel_launch(void* const* d_in, const int* in_sizes, int n_in, void* d_out, int out_size, void* d_ws, size_t ws_size, hipStream_t stream) {
    static int grid = 0;
    if (grid == 0) {
        if (n_in != 32 || out_size != TR * DM || ws_size < WS_END) { fprintf(stderr, "kernel_launch: unexpected shapes (n_in %d out %d ws %zu)\n", n_in, out_size, ws_size); grid = -1; return; }
        int dev = 0, cus = 0, per_cu = 0;
        hipGetDevice(&dev); hipDeviceGetAttribute(&cus, hipDeviceAttributeMultiprocessorCount, dev);
        if (hipFuncSetAttribute((const void*)yoco_fwd, hipFuncAttributeMaxDynamicSharedMemorySize, LDS_BYTES) != hipSuccess) { fprintf(stderr, "kernel_launch: hipFuncSetAttribute failed\n"); grid = -1; return; }
        if (hipOccupancyMaxActiveBlocksPerMultiprocessor(&per_cu, (const void*)yoco_fwd, 512, LDS_BYTES) != hipSuccess || per_cu < 1) { fprintf(stderr, "kernel_launch: occupancy query gave %d\n", per_cu); per_cu = 1; (void)hipGetLastError(); }
        grid = cus * per_cu;
    }
    if (grid < 0) return;
    if (hipMemsetAsync((char*)d_ws + WS_BAR, 0, XCD_BAR_WORDS * 4, stream) != hipSuccess) { fprintf(stderr, "kernel_launch: memset failed\n"); return; }
    Args a{};
    for (int i = 0; i < 32; ++i) a.in[i] = d_in[i];
    a.in[32] = d_out; a.in[33] = d_ws;
    a.ph_lo = 0; a.ph_hi = 1;
    void* kargs[] = {&a};
    hipError_t e = hipLaunchCooperativeKernel((const void*)yoco_fwd, dim3(grid), dim3(512), kargs, LDS_BYTES, stream);
    if (e != hipSuccess) fprintf(stderr, "kernel_launch: cooperative launch failed: %s (grid %d)\n", hipGetErrorString(e), grid);
}
```

```cpp
#include <hip/hip_runtime.h>
#include <hip/hip_cooperative_groups.h>
#include <hip/hip_bf16.h>
#include <cstdio>
#include <cstdint>
#include <cmath>
namespace cg = cooperative_groups;

#define LAS __attribute__((address_space(3)))
typedef unsigned short bf16_t;
typedef short bf16x8 __attribute__((ext_vector_type(8)));
typedef float f32x4 __attribute__((ext_vector_type(4)));
typedef float f32x2 __attribute__((ext_vector_type(2)));
typedef unsigned u32x4 __attribute__((ext_vector_type(4)));
typedef unsigned u32x2 __attribute__((ext_vector_type(2)));

constexpr int TR = 16384, DM = 1024, FF = 2816, SEQ = 4096, NBATCH = 4, NMEM = 256;
constexpr float RMS_EPS = 1e-6f, LN_EPS = 1e-5f, SUBLN_EPS = 1e-5f;
constexpr float LOG2E = 1.4426950408889634f;
constexpr float C2 = 0.125f * LOG2E;

constexpr size_t MiB = 1u << 20;
constexpr size_t WS_SS = 0;
constexpr size_t WS_BAR = 512 * 1024;
constexpr size_t WS_COS = 1 * MiB;
constexpr size_t WS_SIN = 1 * MiB + 512 * 1024;
constexpr size_t WS_MEMB = 2 * MiB;
constexpr size_t WS_W = 4 * MiB;
constexpr size_t WS_WMIX = WS_W;
constexpr size_t WS_WQS = WS_W + 8 * MiB;
constexpr size_t WS_WOT = WS_W + 10 * MiB;
constexpr size_t WS_WGU = WS_W + 12 * MiB;
constexpr size_t WS_WD = WS_W + 24 * MiB;
constexpr size_t WS_BTS = 36 * MiB;
constexpr size_t WS_BTO = 44 * MiB;
constexpr size_t WS_KV = 52 * MiB;
constexpr size_t WS_XB = 68 * MiB;
constexpr size_t WS_R1 = 100 * MiB;
constexpr size_t WS_KSH = 132 * MiB;
constexpr size_t WS_VSH = 164 * MiB;
constexpr size_t WS_HB = 196 * MiB;
constexpr size_t WS_END = 284 * MiB;
static_assert(WS_KSH - WS_R1 == WS_VSH - WS_KSH, "q | k | v buffers equally spaced");

constexpr int LDS_STAGE = 131072, LDS_XCH = 131072, LDS_RS = 139264, LDS_GTAB = 142336, LDS_BARST = 143360, LDS_BYTES = 147456;

typedef __bf16 bf16x2_hw __attribute__((ext_vector_type(2)));
__device__ __forceinline__ unsigned cvt_pk_bf16(float lo, float hi) { const f32x2 v = {lo, hi}; const bf16x2_hw b = __builtin_convertvector(v, bf16x2_hw); return __builtin_bit_cast(unsigned, b); }
__device__ __forceinline__ int opaque_tid() { int t = threadIdx.x; asm volatile("" : "+v"(t)); return t; }
typedef _Float16 f16x8 __attribute__((ext_vector_type(8)));
typedef _Float16 f16x2 __attribute__((ext_vector_type(2)));
__device__ __forceinline__ unsigned cvt_pk_bf16(float lo, float hi);
__device__ __forceinline__ unsigned cvt_pk_f16(float lo, float hi) { return cvt_pk_bf16(lo, hi); }
__device__ __forceinline__ float h_lo(unsigned u) { return __uint_as_float(u << 16); }
__device__ __forceinline__ float h_hi(unsigned u) { return __uint_as_float(u & 0xffff0000u); }
__device__ __forceinline__ float bf_lo(unsigned u) { return __uint_as_float(u << 16); }
__device__ __forceinline__ float bf_hi(unsigned u) { return __uint_as_float(u & 0xffff0000u); }
__device__ __forceinline__ float wave_sum(float v) {
#pragma unroll
    for (int o = 1; o < 64; o <<= 1) v += __shfl_xor(v, o);
    return v;
}
__device__ __forceinline__ float fast_sigmoid(float x) { return __builtin_amdgcn_rcpf(1.0f + __builtin_amdgcn_exp2f(-x * LOG2E)); }
__device__ __forceinline__ float row_rs_lds(LAS unsigned char* lds, int r) {
    const f32x4 a = *(const LAS f32x4*)(lds + LDS_RS + r * 16);
    return rsqrtf(((a[0] + a[1]) + (a[2] + a[3])) * (1.0f / DM) + RMS_EPS);
}
__device__ __forceinline__ float row_rs(const float* ss, int row) {
    const f32x4 a = *(const f32x4*)(ss + (size_t)row * 4);
    return rsqrtf(((a[0] + a[1]) + (a[2] + a[3])) * (1.0f / DM) + RMS_EPS);
}

namespace pg8 {
constexpr int BM = 256, BK = 64, HALF = 128, HTB = HALF * BK * 2, NXCD = 8, WGM = 8;
__host__ __device__ __forceinline__ int lds_byte(int r, int c) { const int st = (r >> 4) * 2 + (c >> 5), rr = r & 15, cc = c & 31, ob = rr * 64 + cc * 2; return st * 1024 + (ob ^ (((ob >> 9) & 1) << 5)); }
__host__ __device__ __forceinline__ void stage_rc(int b, int& R, int& C) { const int st = b / 1024, sb = b % 1024, swz = sb ^ (((sb >> 9) & 1) << 5); R = (st >> 1) * 16 + swz / 64; C = (st & 1) * 32 + (swz % 64) / 2; }
__host__ __device__ __forceinline__ int perm32(int rho) { const int n = rho >> 4, i = rho & 15; return 8 * (i >> 2) + 4 * n + (i & 3); }

struct Unit { int pm, pn, z; };
struct Gemm { const bf16_t* A; const bf16_t* Bt; int lda, ldb, K; long a_s1, a_s0, b_s1, b_s0, b_sb; int nz0; };
__device__ __forceinline__ const char* a_ptr(const Gemm& g, const Unit& u) { const int z1 = u.z / g.nz0, z0 = u.z % g.nz0; return (const char*)(g.A + z1 * g.a_s1 + z0 * g.a_s0 + (long)u.pm * BM * g.lda); }
__device__ __forceinline__ const char* b_ptr(const Gemm& g, const Unit& u) { const int z1 = u.z / g.nz0, z0 = u.z % g.nz0; return (const char*)(g.Bt + z1 * g.b_s1 + z0 * g.b_s0 + (long)(u.pm >> 4) * g.b_sb + (long)u.pn * BM * g.ldb); }

struct Order {
    int nM, nN, nz, nwg, G, c;
    __device__ void init(int nM_, int nN_, int nz_, int G_, int c_) { nM = nM_; nN = nN_; nz = nz_; nwg = nM * nN; G = G_; c = c_; }
    __device__ bool next(int i, Unit& u) const {
        const long L = (long)i * G + c; if (L >= (long)nwg * nz) return false;
        if (nz == 1) {
            int wgid = (int)L; { const int q = nwg / NXCD, r = nwg % NXCD, xcd = wgid % NXCD, off = wgid / NXCD; wgid = (xcd < r ? xcd * (q + 1) : r * (q + 1) + (xcd - r) * q) + off; }
            const int nig = WGM * nN, gid = wgid / nig, fm = gid * WGM, gsz = (nM - fm) < WGM ? (nM - fm) : WGM;
            u.pm = fm + ((wgid % nig) % gsz); u.pn = (wgid % nig) / gsz; u.z = 0;
        } else {
            const int l = (int)L; u.z = l / nwg; const int r = l % nwg; u.pm = r / nN; u.pn = r % nN;
        }
        return true;
    }
};

template <bool F16> __device__ __forceinline__ f32x4 mma16(bf16x8 a, bf16x8 b, f32x4 c) {
    return __builtin_amdgcn_mfma_f32_16x16x32_bf16(a, b, c, 0, 0, 0);
}
template <class Epi, bool F16 = false>
__device__ __forceinline__ void gemm_phase(LAS unsigned char* lds, const Gemm g, const Order& S, const Epi& E) {
    const int tid = opaque_tid(), wid = __builtin_amdgcn_readfirstlane(tid >> 6), lane = tid & 63, wr = wid >> 2, wc = wid & 3, fr = lane & 15, fq = lane >> 4;
    const int K = g.K, nt = K / BK;
    unsigned voffA[2], voffB[2];
#pragma unroll
    for (int i = 0; i < 2; ++i) { int R, C; stage_rc(tid * 16 + i * 8192, R, C); const int Rb = (R & ~31) + perm32(R & 31);
        voffA[i] = (unsigned)(R * g.lda + C) * 2u; voffB[i] = (unsigned)(Rb * g.ldb + C) * 2u; }
    const size_t kstep = (size_t)(BK * 2);
    const size_t hstepA = (size_t)HALF * g.lda * 2, hstepB = (size_t)HALF * g.ldb * 2;
    const unsigned ldsw = (unsigned)wid * 1024u;
    const int aoff = lds_byte(wr * 64 + fr, fq * 8), boff = lds_byte(wc * 32 + fr, fq * 8);
#define PG8_SA(b, h) (((b) * 2 + (h)) * HTB)
#define PG8_SB(b, h) ((4 + (b) * 2 + (h)) * HTB)
#define PG8_STAGE(bufoff, gbase, voff) do { _Pragma("unroll") for (int _i = 0; _i < 2; ++_i) \
        __builtin_amdgcn_global_load_lds((const unsigned*)((const char*)(gbase) + (voff)[_i]), (LAS unsigned*)(lds + (bufoff) + ldsw + _i * 8192), 16, 0, 0); } while (0)
#define PG8_LDA(dst, b, h) do { _Pragma("unroll") for (int m = 0; m < 4; ++m) _Pragma("unroll") for (int k = 0; k < 2; ++k) dst[m][k] = *(const LAS bf16x8*)(lds + PG8_SA(b, h) + aoff + m * 2048 + k * 1024); } while (0)
#define PG8_LDB(dst, b, h) do { _Pragma("unroll") for (int n = 0; n < 2; ++n) _Pragma("unroll") for (int k = 0; k < 2; ++k) dst[n][k] = *(const LAS bf16x8*)(lds + PG8_SB(b, h) + boff + n * 2048 + k * 1024); } while (0)
#define PG8_MMA(ai, bj, At, Bt) do { __builtin_amdgcn_s_setprio(1); _Pragma("unroll") for (int m = 0; m < 4; ++m) _Pragma("unroll") for (int n = 0; n < 2; ++n) _Pragma("unroll") for (int k = 0; k < 2; ++k) \
        acc[ai][bj][m][n] = mma16<F16>(Bt[n][k], At[m][k], acc[ai][bj][m][n]); __builtin_amdgcn_s_setprio(0); } while (0)
#define PG8_WAIT_V(n) asm volatile("s_waitcnt vmcnt(" #n ")" ::: "memory")
#define PG8_WAIT_L(n) asm volatile("s_waitcnt lgkmcnt(" #n ")" ::: "memory")
#define PG8_BAR __builtin_amdgcn_s_barrier()
#define PG8_SCHED __builtin_amdgcn_sched_barrier(0)
    Unit cur, nxt; int ui = 0;
    if (!S.next(0, cur)) return;
    f32x4 acc[2][2][4][2];
#pragma unroll
    for (int a = 0; a < 2; ++a)
#pragma unroll
        for (int b = 0; b < 2; ++b)
#pragma unroll
            for (int m = 0; m < 4; ++m)
#pragma unroll
                for (int n = 0; n < 2; ++n) acc[a][b][m][n] = (f32x4){0.f, 0.f, 0.f, 0.f};
    bf16x8 At[4][2], B0[2][2], B1[2][2];
    const char* cA = a_ptr(g, cur); const char* cB = b_ptr(g, cur);
    PG8_STAGE(PG8_SB(0, 0), cB, voffB); PG8_STAGE(PG8_SB(0, 1), cB + hstepB, voffB); PG8_STAGE(PG8_SA(0, 0), cA, voffA); PG8_STAGE(PG8_SA(0, 1), cA + hstepA, voffA);
    if (wr == 1) PG8_BAR;
    PG8_WAIT_V(2); PG8_BAR;
    PG8_STAGE(PG8_SB(1, 0), cB + kstep, voffB); PG8_STAGE(PG8_SA(1, 0), cA + kstep, voffA); PG8_STAGE(PG8_SB(1, 1), cB + hstepB + kstep, voffB);
    PG8_WAIT_V(6); PG8_BAR;
    for (;;) {
        const bool has_next = S.next(ui + 1, nxt);
        const char* nA = has_next ? a_ptr(g, nxt) : cA; const char* nB = has_next ? b_ptr(g, nxt) : cB;
        for (int t = 0; t < nt; t += 2) {
            const bool last = (t == nt - 2);
            const char* a1 = cA + (size_t)(t + 1) * kstep;
            const char* a2 = last ? nA : cA + (size_t)(t + 2) * kstep; const char* b2 = last ? nB : cB + (size_t)(t + 2) * kstep;
            const char* a3 = a2 + kstep; const char* b3 = b2 + kstep;
            if constexpr (Epi::NEEDS_RS) { if (last && wid < 4) __builtin_amdgcn_global_load_lds((const unsigned*)(E.ss + ((size_t)cur.pm * BM + wid * 64 + lane) * 4), (LAS unsigned*)(lds + LDS_RS + wid * 1024), 16, 0, 0); }
            PG8_LDB(B0, 0, 0); PG8_LDB(B1, 0, 1); PG8_SCHED; PG8_LDA(At, 0, 0); PG8_STAGE(PG8_SA(1, 1), a1 + hstepA, voffA);
            PG8_WAIT_V(8); PG8_WAIT_L(0); PG8_BAR; PG8_MMA(0, 0, At, B0); PG8_MMA(0, 1, At, B1); PG8_BAR; PG8_SCHED;
            PG8_LDA(At, 0, 1); PG8_STAGE(PG8_SB(0, 0), b2, voffB); PG8_STAGE(PG8_SB(0, 1), b2 + hstepB, voffB); PG8_STAGE(PG8_SA(0, 0), a2, voffA);
            PG8_WAIT_V(8); PG8_WAIT_L(0); PG8_BAR; PG8_MMA(1, 0, At, B0); PG8_MMA(1, 1, At, B1); PG8_BAR; PG8_SCHED;
            PG8_LDB(B0, 1, 0); PG8_LDB(B1, 1, 1); PG8_SCHED; PG8_LDA(At, 1, 0); PG8_STAGE(PG8_SA(0, 1), a2 + hstepA, voffA);
            PG8_WAIT_V(8); PG8_WAIT_L(0); PG8_BAR; PG8_MMA(0, 0, At, B0); PG8_MMA(0, 1, At, B1); PG8_BAR; PG8_SCHED;
            PG8_LDA(At, 1, 1); PG8_STAGE(PG8_SB(1, 0), b3, voffB); PG8_STAGE(PG8_SB(1, 1), b3 + hstepB, voffB); PG8_STAGE(PG8_SA(1, 0), a3, voffA);
            PG8_WAIT_V(8); PG8_WAIT_L(0); PG8_BAR; PG8_MMA(1, 0, At, B0); PG8_MMA(1, 1, At, B1); PG8_BAR; PG8_SCHED;
        }
        if (wr == 0) PG8_BAR;
        E(acc, cur, wr, wc, fr, fq, lds);
        if (!has_next) break;
#pragma unroll
        for (int a = 0; a < 2; ++a)
#pragma unroll
            for (int b = 0; b < 2; ++b)
#pragma unroll
                for (int m = 0; m < 4; ++m)
#pragma unroll
                    for (int n = 0; n < 2; ++n) acc[a][b][m][n] = (f32x4){0.f, 0.f, 0.f, 0.f};
        cur = nxt; cA = nA; cB = nB; ++ui;
        if (wr == 1) PG8_BAR;
    }
    PG8_WAIT_V(0);
    PG8_BAR;
#undef PG8_SA
#undef PG8_SB
#undef PG8_STAGE
#undef PG8_LDA
#undef PG8_LDB
#undef PG8_MMA
#undef PG8_WAIT_V
#undef PG8_WAIT_L
#undef PG8_BAR
#undef PG8_SCHED
}

typedef f32x4 Acc[2][2][4][2];

struct EpiPlain {
    static constexpr bool NEEDS_RS = false;
    bf16_t* O; int ldc; long c_s1, c_s0; int nz0; int f16;
    __device__ __forceinline__ void operator()(Acc& acc, const Unit& u, int wr, int wc, int fr, int fq, LAS unsigned char*) const {
        const int z1 = u.z / nz0, z0 = u.z % nz0;
        bf16_t* base = O + z1 * c_s1 + z0 * c_s0;
        const int row0 = u.pm * BM + wr * 64 + fr, col0 = u.pn * BM + wc * 32 + 8 * fq;
#pragma unroll
        for (int ai = 0; ai < 2; ++ai)
#pragma unroll
            for (int m = 0; m < 4; ++m) { bf16_t* rowp = base + (size_t)(row0 + ai * HALF + m * 16) * ldc + col0;
#pragma unroll
                for (int bj = 0; bj < 2; ++bj) { const f32x4 v0 = acc[ai][bj][m][0], v1 = acc[ai][bj][m][1];
                    u32x4 w;
                    if (f16) { w.x = cvt_pk_f16(v0[0], v0[1]); w.y = cvt_pk_f16(v0[2], v0[3]); w.z = cvt_pk_f16(v1[0], v1[1]); w.w = cvt_pk_f16(v1[2], v1[3]); }
                    else { w.x = cvt_pk_bf16(v0[0], v0[1]); w.y = cvt_pk_bf16(v0[2], v0[3]); w.z = cvt_pk_bf16(v1[0], v1[1]); w.w = cvt_pk_bf16(v1[2], v1[3]); }
                    *(u32x4*)(rowp + bj * HALF) = w; } }
    }
};

template <int MODE> struct EpiGated {
    static constexpr bool NEEDS_RS = true;
    bf16_t* O; int ldc; const float* ss; const float* bias; int bias_half;
    __device__ __forceinline__ void operator()(Acc& acc, const Unit& u, int wr, int wc, int fr, int fq, LAS unsigned char* lds) const {
        const int row0 = u.pm * BM + wr * 64 + fr, col0 = u.pn * HALF + wc * 32 + 8 * fq;
        f32x4 ba[2], bg[2];
#pragma unroll
        for (int n = 0; n < 2; ++n) { if (MODE == 0) { ba[n] = *(const f32x4*)(bias + col0 + 4 * n); bg[n] = *(const f32x4*)(bias + bias_half + col0 + 4 * n); } else { ba[n] = (f32x4){0.f, 0.f, 0.f, 0.f}; bg[n] = ba[n]; } }
        float rsv[2][4];
#pragma unroll
        for (int ai = 0; ai < 2; ++ai)
#pragma unroll
            for (int m = 0; m < 4; ++m) rsv[ai][m] = row_rs_lds(lds, ai * HALF + wr * 64 + m * 16 + fr);
#pragma unroll
        for (int ai = 0; ai < 2; ++ai)
#pragma unroll
            for (int m = 0; m < 4; ++m) { const int row = row0 + ai * HALF + m * 16; const float rs = rsv[ai][m];
                float o[8];
                const f32x2 rs2 = (f32x2){rs, rs};
#pragma unroll
                for (int n = 0; n < 2; ++n)
#pragma unroll
                    for (int p = 0; p < 2; ++p) {
                        const f32x2 a2 = (f32x2){acc[ai][0][m][n][2 * p], acc[ai][0][m][n][2 * p + 1]}, g2 = (f32x2){acc[ai][1][m][n][2 * p], acc[ai][1][m][n][2 * p + 1]};
                        const f32x2 va = __builtin_elementwise_fma(a2, rs2, (f32x2){ba[n][2 * p], ba[n][2 * p + 1]}), vg = __builtin_elementwise_fma(g2, rs2, (f32x2){bg[n][2 * p], bg[n][2 * p + 1]});
                        const f32x2 sx = (MODE == 0 ? vg : va) * (f32x2){-LOG2E, -LOG2E};
                        f32x2 e; e[0] = __builtin_amdgcn_exp2f(sx[0]); e[1] = __builtin_amdgcn_exp2f(sx[1]);
                        const f32x2 den = e + (f32x2){1.0f, 1.0f};
                        f32x2 rc; rc[0] = __builtin_amdgcn_rcpf(den[0]); rc[1] = __builtin_amdgcn_rcpf(den[1]);
                        const f32x2 res = (MODE == 0) ? va * rc : (va * vg) * rc;
                        o[4 * n + 2 * p] = res[0]; o[4 * n + 2 * p + 1] = res[1]; }
                u32x4 w; w.x = cvt_pk_bf16(o[0], o[1]); w.y = cvt_pk_bf16(o[2], o[3]); w.z = cvt_pk_bf16(o[4], o[5]); w.w = cvt_pk_bf16(o[6], o[7]);
                *(u32x4*)(O + (size_t)row * ldc + col0) = w; }
    }
};

struct EpiResid {
    static constexpr bool NEEDS_RS = false;
    bf16_t* xb; float* ss; const float* bias;
    __device__ __forceinline__ void operator()(Acc& acc, const Unit& u, int wr, int wc, int fr, int fq, LAS unsigned char* lds) const {
        LAS float* X = (LAS float*)(lds + LDS_XCH);
        const int row0 = u.pm * BM + wr * 64 + fr, col0 = u.pn * BM + wc * 32 + 8 * fq;
        f32x4 bv[2][2];
#pragma unroll
        for (int bj = 0; bj < 2; ++bj)
#pragma unroll
            for (int n = 0; n < 2; ++n) bv[bj][n] = bias ? *(const f32x4*)(bias + col0 + bj * HALF + 4 * n) : (f32x4){0.f, 0.f, 0.f, 0.f};
#pragma unroll
        for (int ai = 0; ai < 2; ++ai) {
            u32x4 xpre[1][4][2];
#pragma unroll
            for (int m = 0; m < 4; ++m)
#pragma unroll
                for (int bj = 0; bj < 2; ++bj) xpre[0][m][bj] = *(const u32x4*)(xb + (size_t)(row0 + ai * HALF + m * 16) * DM + col0 + bj * HALF);
#pragma unroll
            for (int m = 0; m < 4; ++m) { const int row = row0 + ai * HALF + m * 16; const size_t ro = (size_t)row * DM + col0; float sq = 0.f;
#pragma unroll
                for (int bj = 0; bj < 2; ++bj) {
                    const u32x4 xin = xpre[0][m][bj];
                    const f32x4 x0 = (f32x4){h_lo(xin.x), h_hi(xin.x), h_lo(xin.y), h_hi(xin.y)}, x1 = (f32x4){h_lo(xin.z), h_hi(xin.z), h_lo(xin.w), h_hi(xin.w)};
                    const f32x4 v0 = acc[ai][bj][m][0] + bv[bj][0] + x0, v1 = acc[ai][bj][m][1] + bv[bj][1] + x1;
                    u32x4 w; w.x = cvt_pk_f16(v0[0], v0[1]); w.y = cvt_pk_f16(v0[2], v0[3]); w.z = cvt_pk_f16(v1[0], v1[1]); w.w = cvt_pk_f16(v1[2], v1[3]);
                    *(u32x4*)(xb + ro + bj * HALF) = w;
                    sq += (v0[0] * v0[0] + v0[1] * v0[1]) + (v0[2] * v0[2] + v0[3] * v0[3]) + (v1[0] * v1[0] + v1[1] * v1[1]) + (v1[2] * v1[2] + v1[3] * v1[3]); }
                sq += __shfl_xor(sq, 16); sq += __shfl_xor(sq, 32);
                if (fq == 0) X[(ai * HALF + wr * 64 + m * 16 + fr) * 4 + wc] = sq; } }
        asm volatile("s_waitcnt lgkmcnt(0)" ::: "memory"); __builtin_amdgcn_s_barrier(); asm volatile("" ::: "memory");
        { const int t = opaque_tid(); if (t < 256) { const f32x4 v = *(const LAS f32x4*)(X + t * 4); ss[(size_t)(u.pm * BM + t) * 4 + u.pn] = (v[0] + v[1]) + (v[2] + v[3]); } }
    }
};

struct EpiSoftmax {
    static constexpr bool NEEDS_RS = true;
    bf16_t* P; const float* ss;
    __device__ __forceinline__ void operator()(Acc& acc, const Unit& u, int wr, int wc, int fr, int fq, LAS unsigned char* lds) const {
        LAS f32x2* X = (LAS f32x2*)(lds + LDS_XCH);
        float mloc[2][4];
#pragma unroll
        for (int ai = 0; ai < 2; ++ai)
#pragma unroll
            for (int m = 0; m < 4; ++m) mloc[ai][m] = row_rs_lds(lds, ai * HALF + wr * 64 + m * 16 + fr);
#pragma unroll
        for (int ai = 0; ai < 2; ++ai)
#pragma unroll
            for (int m = 0; m < 4; ++m) { const int r = ai * HALF + wr * 64 + m * 16 + fr; const float rs = mloc[ai][m];
                float mx = -INFINITY;
#pragma unroll
                for (int bj = 0; bj < 2; ++bj)
#pragma unroll
                    for (int n = 0; n < 2; ++n) { f32x4 v = acc[ai][bj][m][n] * rs; acc[ai][bj][m][n] = v; mx = fmaxf(mx, fmaxf(fmaxf(v[0], v[1]), fmaxf(v[2], v[3]))); }
                mx = fmaxf(mx, __shfl_xor(mx, 16)); mx = fmaxf(mx, __shfl_xor(mx, 32));
                float sum = 0.f;
#pragma unroll
                for (int bj = 0; bj < 2; ++bj)
#pragma unroll
                    for (int n = 0; n < 2; ++n) { f32x4 v = acc[ai][bj][m][n];
#pragma unroll
                        for (int j = 0; j < 4; ++j) { v[j] = __builtin_amdgcn_exp2f(v[j] - mx); sum += v[j]; }
                        acc[ai][bj][m][n] = v; }
                sum += __shfl_xor(sum, 16); sum += __shfl_xor(sum, 32);
                if (fq == 0) X[r * 4 + wc] = (f32x2){mx, sum};
                mloc[ai][m] = mx; }
        asm volatile("s_waitcnt lgkmcnt(0)" ::: "memory"); __builtin_amdgcn_s_barrier(); asm volatile("" ::: "memory");
        const int col0 = u.pn * BM + wc * 32 + 8 * fq;
#pragma unroll
        for (int ai = 0; ai < 2; ++ai)
#pragma unroll
            for (int m = 0; m < 4; ++m) { const int r = ai * HALF + wr * 64 + m * 16 + fr;
                const f32x2 a = X[r * 4 + 0], b = X[r * 4 + 1], c = X[r * 4 + 2], d = X[r * 4 + 3];
                const float M = fmaxf(fmaxf(a[0], b[0]), fmaxf(c[0], d[0]));
                const float L = a[1] * __builtin_amdgcn_exp2f(a[0] - M) + b[1] * __builtin_amdgcn_exp2f(b[0] - M) + c[1] * __builtin_amdgcn_exp2f(c[0] - M) + d[1] * __builtin_amdgcn_exp2f(d[0] - M);
                const float f = __builtin_amdgcn_exp2f(mloc[ai][m] - M) / L;
                bf16_t* rowp = P + (size_t)(u.pm * BM + r) * DM + col0;
#pragma unroll
                for (int bj = 0; bj < 2; ++bj) { const f32x4 v0 = acc[ai][bj][m][0] * f, v1 = acc[ai][bj][m][1] * f;
                    u32x4 w; w.x = cvt_pk_bf16(v0[0], v0[1]); w.y = cvt_pk_bf16(v0[2], v0[3]); w.z = cvt_pk_bf16(v1[0], v1[1]); w.w = cvt_pk_bf16(v1[2], v1[3]);
                    *(u32x4*)(rowp + bj * HALF) = w; } }
        asm volatile("s_waitcnt lgkmcnt(0)" ::: "memory"); __builtin_amdgcn_s_barrier(); asm volatile("" ::: "memory");
    }
};

struct EpiQKV {
    static constexpr bool NEEDS_RS = true;
    bf16_t* Q; size_t sel_stride; const float* ss; const float* cs; const float* sn;
    __device__ __forceinline__ void operator()(Acc& acc, const Unit& u, int wr, int wc, int fr, int fq, LAS unsigned char* lds) const {
        const int sel = u.pn >> 2; bf16_t* dst = Q + (size_t)sel * sel_stride;
        const float scl = sel == 0 ? C2 : 1.0f;
        const bool rot = (sel < 2) && ((wc & 1) == 0) && (fq < 2);
        const int row0 = u.pm * BM + wr * 64 + fr, col0 = (u.pn & 3) * BM + wc * 32 + 8 * fq;
        float rsv[2][4];
#pragma unroll
        for (int ai = 0; ai < 2; ++ai)
#pragma unroll
            for (int m = 0; m < 4; ++m) rsv[ai][m] = row_rs_lds(lds, ai * HALF + wr * 64 + m * 16 + fr) * scl;
#pragma unroll
        for (int ai = 0; ai < 2; ++ai) {
            f32x4 cpre[4], spre[4];
#pragma unroll
            for (int m = 0; m < 4; ++m) { cpre[m] = (f32x4){1.f, 1.f, 1.f, 1.f}; spre[m] = (f32x4){0.f, 0.f, 0.f, 0.f};
                if (rot) { const size_t ro = (size_t)(row0 + ai * HALF + m * 16) * 8 + 4 * fq; cpre[m] = *(const f32x4*)(cs + ro); spre[m] = *(const f32x4*)(sn + ro); } }
#pragma unroll
            for (int m = 0; m < 4; ++m) { const int row = row0 + ai * HALF + m * 16; const float rs = rsv[ai][m];
                const f32x4 c4 = cpre[m], s4 = spre[m];
                bf16_t* rowp = dst + (size_t)row * DM + col0;
#pragma unroll
                for (int bj = 0; bj < 2; ++bj) { const f32x4 a0 = acc[ai][bj][m][0] * rs, a1 = acc[ai][bj][m][1] * rs;
                    f32x4 v0, v1;
                    v0[0] = a0[0] * c4[0] - a0[1] * s4[0]; v0[1] = a0[0] * s4[0] + a0[1] * c4[0];
                    v0[2] = a0[2] * c4[1] - a0[3] * s4[1]; v0[3] = a0[2] * s4[1] + a0[3] * c4[1];
                    v1[0] = a1[0] * c4[2] - a1[1] * s4[2]; v1[1] = a1[0] * s4[2] + a1[1] * c4[2];
                    v1[2] = a1[2] * c4[3] - a1[3] * s4[3]; v1[3] = a1[2] * s4[3] + a1[3] * c4[3];
                    u32x4 w; w.x = cvt_pk_bf16(v0[0], v0[1]); w.y = cvt_pk_bf16(v0[2], v0[3]); w.z = cvt_pk_bf16(v1[0], v1[1]); w.w = cvt_pk_bf16(v1[2], v1[3]);
                    *(u32x4*)(rowp + bj * HALF) = w; } } }
    }
};
}

namespace attn_body {
using bf16 = __hip_bfloat16;
using s16x4 = __attribute__((ext_vector_type(4))) short;
using f32x16 = __attribute__((ext_vector_type(16))) float;
constexpr int PITCH = 1024;
constexpr int NW = 8, QBLK = 32, QB = QBLK * NW, KVBLK = 64;
__device__ __forceinline__ int crow(int r, int hi) { return (r & 3) + 8 * (r >> 2) + 4 * hi; }
#define SBAR() __builtin_amdgcn_sched_barrier(0)
__device__ __forceinline__ void cmask(f32x16& p0, f32x16& p1, int jb, int qrel, int hi) {
  const float NEG = -INFINITY; int kb = 64 * jb + 4 * hi;
  #pragma unroll
  for (int r = 0; r < 16; ++r) { int kv = kb + (r & 3) + 8 * (r >> 2); if (kv > qrel) p0[r] = NEG; if (kv + 32 > qrel) p1[r] = NEG; }
}
constexpr int NSLOT = 3, SLOTB = 8192;
constexpr int LDS_K = 0, LDS_V = NSLOT * SLOTB, LDS_WS = 2 * NSLOT * SLOTB, LDS_OST = LDS_WS + NW * 64 * 4, LDS_ATT_BYTES = LDS_OST + NW * 4096;
__device__ __forceinline__ void glds16(const void* gsrc, unsigned lds_dst) { unsigned keep;
  asm volatile("s_mov_b32 %0, m0\n\ts_mov_b32 m0, %2\n\ts_nop 0\n\tglobal_load_lds_dwordx4 %1, off\n\ts_mov_b32 m0, %0" : "=&s"(keep) : "v"(gsrc), "s"(lds_dst) : "memory"); }
__device__ __forceinline__ void glds16s(const void* sbase, unsigned voff, unsigned lds_dst) { unsigned keep;
  asm volatile("s_mov_b32 %0, m0\n\ts_mov_b32 m0, %3\n\ts_nop 0\n\tglobal_load_lds_dwordx4 %1, %2\n\ts_mov_b32 m0, %0" : "=&s"(keep) : "v"(voff), "s"(sbase), "s"(lds_dst) : "memory"); }
__device__ __forceinline__ float max3f(float a, float b, float c) { float r; asm("v_max3_f32 %0, %1, %2, %3" : "=v"(r) : "v"(a), "v"(b), "v"(c)); return r; }
__device__ __forceinline__ float max2f(float a, float b) { float r; asm("v_max_f32_e32 %0, %1, %2" : "=v"(r) : "v"(a), "v"(b)); return r; }
__device__ __forceinline__ float fadd_s(float a, float b) { float r; asm("v_add_f32_e32 %0, %1, %2" : "=v"(r) : "v"(a), "v"(b)); return r; }
__device__ __forceinline__ float fsub_s(float a, float b) { float r; asm("v_sub_f32_e32 %0, %1, %2" : "=v"(r) : "v"(a), "v"(b)); return r; }
typedef float f32x2_t __attribute__((ext_vector_type(2))); typedef __bf16 bf16x2_t __attribute__((ext_vector_type(2)));
__device__ __forceinline__ unsigned cvtpk_s(float lo, float hi) { f32x2_t v = {lo, hi}; bf16x2_t b = __builtin_convertvector(v, bf16x2_t); return __builtin_bit_cast(unsigned, b); }
#define WAIT_BAR(N) asm volatile("s_waitcnt vmcnt(" #N ") lgkmcnt(0)\n\ts_barrier" ::: "memory")

__device__ __forceinline__ void qkt(f32x16& p0, f32x16& p1, const char* Kslot, const bf16x8* qr, const f32x16& negm, int r32, int hi) {
  const char* kb = Kslot + hi * 1024 + r32 * 16;
  #pragma unroll
  for (int d0 = 0; d0 < 4; ++d0) {
    const bf16x8 b0 = *reinterpret_cast<const bf16x8*>(kb + d0 * 2048);
    const bf16x8 b1 = *reinterpret_cast<const bf16x8*>(kb + d0 * 2048 + 512);
    if (d0 == 0) { p0 = __builtin_amdgcn_mfma_f32_32x32x16_bf16(b0, qr[0], negm, 0, 0, 0); p1 = __builtin_amdgcn_mfma_f32_32x32x16_bf16(b1, qr[0], negm, 0, 0, 0); }
    else { p0 = __builtin_amdgcn_mfma_f32_32x32x16_bf16(b0, qr[d0], p0, 0, 0, 0); p1 = __builtin_amdgcn_mfma_f32_32x32x16_bf16(b1, qr[d0], p1, 0, 0, 0); } }
}
typedef __attribute__((address_space(3))) const char* lds_cptr;
typedef short v4i16_t __attribute__((ext_vector_type(4)));
__device__ __forceinline__ void kload8(bf16x8* kf, lds_cptr kp) {
  kf[0] = *(const __attribute__((address_space(3))) bf16x8*)(kp);        kf[1] = *(const __attribute__((address_space(3))) bf16x8*)(kp + 512);
  kf[2] = *(const __attribute__((address_space(3))) bf16x8*)(kp + 2048); kf[3] = *(const __attribute__((address_space(3))) bf16x8*)(kp + 2560);
  kf[4] = *(const __attribute__((address_space(3))) bf16x8*)(kp + 4096); kf[5] = *(const __attribute__((address_space(3))) bf16x8*)(kp + 4608);
  kf[6] = *(const __attribute__((address_space(3))) bf16x8*)(kp + 6144); kf[7] = *(const __attribute__((address_space(3))) bf16x8*)(kp + 6656);
}
__device__ __forceinline__ void kload2(bf16x8* kf, lds_cptr kp, int j) { kf[2 * j] = *(const __attribute__((address_space(3))) bf16x8*)(kp + j * 2048); kf[2 * j + 1] = *(const __attribute__((address_space(3))) bf16x8*)(kp + j * 2048 + 512); }
__device__ __forceinline__ s16x4 vtr(lds_cptr p) { return __builtin_bit_cast(s16x4, __builtin_amdgcn_ds_read_tr16_b64_v4i16((__attribute__((address_space(3))) v4i16_t*)p)); }
__device__ __forceinline__ float rowmax(const f32x16& p0, const f32x16& p1) {
  float a = max3f(p0[0], p0[1], p1[0]), b = max3f(p0[2], p0[3], p1[1]); a = max3f(a, p1[2], p1[3]);
  #pragma unroll
  for (int r = 4; r < 16; r += 4) { a = max3f(a, p0[r], p0[r + 1]); b = max3f(b, p0[r + 2], p0[r + 3]); a = max3f(a, p1[r], p1[r + 1]); b = max3f(b, p1[r + 2], p1[r + 3]); }
  const float m = max2f(a, b);
  auto rr = __builtin_amdgcn_permlane32_swap(__float_as_uint(m), __float_as_uint(m), false, false);
  return max2f(__uint_as_float(rr[0]), __uint_as_float(rr[1]));
}
__device__ __forceinline__ void pv(f32x16* o, int vb, bf16x8 pa0, bf16x8 pa1, bf16x8 pa2, bf16x8 pa3) {
  #pragma unroll
  for (int d0 = 0; d0 < 2; ++d0) { s16x4 lo[4], hi[4];
    #pragma unroll
    for (int ks = 0; ks < 4; ++ks) {
      asm volatile("ds_read_b64_tr_b16 %0,%1 offset:%c2" : "=&v"(lo[ks]) : "v"(vb), "i"(d0 * 4096 + ks * 1024) : "memory");
      asm volatile("ds_read_b64_tr_b16 %0,%1 offset:%c2" : "=&v"(hi[ks]) : "v"(vb), "i"(d0 * 4096 + ks * 1024 + 512) : "memory"); }
    asm volatile("s_waitcnt lgkmcnt(0)" ::: "memory"); SBAR();
    #define PK(k) (bf16x8){lo[k][0], lo[k][1], lo[k][2], lo[k][3], hi[k][0], hi[k][1], hi[k][2], hi[k][3]}
    o[d0] = __builtin_amdgcn_mfma_f32_32x32x16_bf16(pa0, PK(0), o[d0], 0, 0, 0);
    o[d0] = __builtin_amdgcn_mfma_f32_32x32x16_bf16(pa1, PK(1), o[d0], 0, 0, 0);
    o[d0] = __builtin_amdgcn_mfma_f32_32x32x16_bf16(pa2, PK(2), o[d0], 0, 0, 0);
    o[d0] = __builtin_amdgcn_mfma_f32_32x32x16_bf16(pa3, PK(3), o[d0], 0, 0, 0);
    #undef PK
  }
}

constexpr int LDS2_GTAB = 142336;
static_assert(LDS2_GTAB == LDS_GTAB, "attention gain table offset");
constexpr int LDS2_V = NSLOT * SLOTB, LDS2_WS = LDS2_V + NSLOT * 2 * SLOTB, LDS2_OST = LDS2_WS + NW * 64 * 4, LDS_ATT2_BYTES = LDS2_OST + NW * 8192;
template<int THRL, int MODE> __device__ __forceinline__ void attn_unit2(int b, int qcol, int kcol, int vcol, int ocol, int qb, const bf16* Q, const bf16* __restrict__ K, const bf16* __restrict__ V, bf16* O, char* shm, bool pre, const bf16* Knext, const bf16* Vnext) {
  constexpr int DMP = PITCH;
  const int tid = opaque_tid(), lane = tid & 63, r32 = lane & 31, hi = lane >> 5; const int wid = __builtin_amdgcn_readfirstlane(tid >> 6);
  const long rowbase = (long)b * SEQ; const int q0 = qb * QB;
  const bf16* Qw = Q + (rowbase + q0 + wid * QBLK) * DMP + qcol;
  const bf16* Kh = K + rowbase * DMP + kcol, *Vh = V + rowbase * DMP + vcol;
  const unsigned lds0 = (unsigned)(uintptr_t)shm;
  float* wsf = (float*)(shm + LDS2_WS) + wid * 64;
  const unsigned koff = (unsigned)(lane * DMP + wid * 8) * 2u;
  const unsigned voff = (unsigned)((16 * (wid & 3) + (lane >> 2)) * DMP + (wid >> 2) * 32 + (lane & 3) * 8) * 2u;
  const unsigned kdst = lds0 + LDS_K + wid * 1024, vdst = lds0 + LDS2_V + wid * 1024;
  #define DMA_K(t, slot) glds16s(Kh + (long)(t) * KVBLK * DMP, koff, (unsigned)__builtin_amdgcn_readfirstlane(kdst + (slot)))
  #define DMA_V(t, slot) do { glds16s(Vh + (long)(t) * KVBLK * DMP, voff, (unsigned)__builtin_amdgcn_readfirstlane(vdst + 2 * (slot))); \
    glds16s(Vh + (long)(t) * KVBLK * DMP + 64, voff, (unsigned)__builtin_amdgcn_readfirstlane(vdst + 2 * (slot) + 8192)); } while (0)
  const char* Kbase = shm + LDS_K; bf16x8 kf[8];
  const lds_cptr shm3 = (lds_cptr)shm; const lds_cptr kp0 = shm3 + LDS_K + hi * 1024 + r32 * 16; const lds_cptr vp0 = shm3 + LDS2_V + ((lane >> 4) & 1) * 32 + (lane & 3) * 8 + (4 * hi + ((lane & 15) >> 2)) * 64;
  const int NT = (q0 + QB) / KVBLK;
  if (!pre) { DMA_K(0, 0); DMA_V(0, 0); DMA_K(1, SLOTB); }
  bf16x8 qr[4];
  #pragma unroll
  for (int d0 = 0; d0 < 4; ++d0) qr[d0] = *reinterpret_cast<const bf16x8*>(&Qw[(long)r32 * DMP + d0 * 16 + hi * 8]);
  float mhat = 0.f, l_reg = 0.f; f32x16 o[4]; o[0] = f32x16{}; o[1] = f32x16{}; o[2] = f32x16{}; o[3] = f32x16{}; const f32x16 zc = f32x16{};
  #define CMASK(P0, P1, t) do { int jb_ = (t) - (NT - 4); if (jb_ >= 0) { const int ln_ = opaque_tid() & 63; cmask(P0, P1, jb_, wid * QBLK + (ln_ & 31), ln_ >> 5); } } while (0)
  bool resc = false;
  #define START(P0, P1) do { const float rm = rowmax(P0, P1); resc = false; \
    { const float dl = rm; mhat = fadd_s(mhat, dl); \
      _Pragma("unroll") for (int r = 0; r < 16; ++r) { P0[r] = fsub_s(P0[r], dl); P1[r] = fsub_s(P1[r], dl); } \
      } \
    _Pragma("unroll") for (int r = 0; r < 16; ++r) P0[r] = __builtin_amdgcn_exp2f(P0[r]); } while (0)
  #define RESC() do { if (resc) { asm volatile("s_waitcnt lgkmcnt(0)" ::: "memory"); \
      _Pragma("unroll") for (int d_ = 0; d_ < 4; ++d_) _Pragma("unroll") for (int r = 0; r < 16; ++r) o[d_][r] *= wsf[crow(r, hi)]; } } while (0)
  f32x16 pA0, pA1, pB0, pB1;
  int sl_prev = 0, sl_cur = 0, sl_next = SLOTB;
  #define ROT() do { sl_prev = sl_cur; sl_cur = sl_next; sl_next = (sl_next == (NSLOT - 1) * SLOTB) ? 0 : sl_next + SLOTB; } while (0)
  DMA_K(2, 2 * SLOTB);
  WAIT_BAR(3);
  qkt(pA0, pA1, Kbase, qr, zc, r32, hi); asm volatile("s_nop 15\n\ts_nop 7" : "+v"(pA0), "+v"(pA1)); CMASK(pA0, pA1, 0);
  START(pA0, pA1);
  _Pragma("unroll") for (int r = 0; r < 16; ++r) pA1[r] = __builtin_amdgcn_exp2f(pA1[r]);
  WAIT_BAR(0);
  DMA_K(3, 0); DMA_V(1, SLOTB);
  ROT();
  kload8(kf, kp0 + sl_cur);
  WAIT_BAR(3);
  s16x4 vlo[8], vhi[8]; u32x4 pw0, pw1, pw2, pw3;
  #define PKW(P, B) cvtpk_s(P[B], P[B + 1])
  #define PAF(k) __builtin_bit_cast(bf16x8, pw##k)
  #define VFR(i) (bf16x8){vlo[i][0], vlo[i][1], vlo[i][2], vlo[i][3], vhi[i][0], vhi[i][1], vhi[i][2], vhi[i][3]}
  #define PIN(x) asm volatile("" : "+v"(x))
  #define MX3(a, b, c) __builtin_fmaxf(__builtin_fmaxf((a), (b)), (c))
  #define GAPA(MF, A0, A1, A2, A3, W0, W1, PW) do { MF; sacc += A0; sacc += A1; sacc += A2; sacc += A3; PIN(sacc); W0; W1; PIN(PW); SBAR(); } while (0)
  #define EX(v) __builtin_amdgcn_exp2f(v)
  #define GAPB(MF, X, B) do { MF; X[B] = EX(X[B]); X[B + 1] = EX(X[B + 1]); PIN(X); SBAR(); } while (0)
  #define VRD(i) do { vlo[i] = vtr(vp_ + (((i) >> 2) * 4096 + ((i) & 3) * 1024)); vhi[i] = vtr(vp_ + (((i) >> 2) * 4096 + ((i) & 3) * 1024 + 512)); } while (0)
  #define VRD2(i) do { vlo[i] = vtr(vp_ + (8192 + ((i) >> 2) * 4096 + ((i) & 3) * 1024)); vhi[i] = vtr(vp_ + (8192 + ((i) >> 2) * 4096 + ((i) & 3) * 1024 + 512)); SBAR(); } while (0)
  #define KRD(G, j) do { if (G) { kload2(kf, kp0 + sl_next, j); SBAR(); } } while (0)
  #define STEP(C0, C1, P0, P1, t, GK, GV, GL) do { SBAR(); \
    const lds_cptr vp_ = vp0 + 2 * sl_prev; \
    VRD(0); SBAR(); float sacc = (P0[0] + P0[1]); \
    GAPA(C0 = __builtin_amdgcn_mfma_f32_32x32x16_bf16(kf[0], qr[0], zc, 0, 0, 0), P0[2], P0[3], P0[4], P0[5],     pw0[0] = PKW(P0, 0), pw0[1] = PKW(P0, 2), pw0); \
    VRD(4); SBAR(); GAPA(C1 = __builtin_amdgcn_mfma_f32_32x32x16_bf16(kf[1], qr[0], zc, 0, 0, 0), P0[6], P0[7], P0[8], P0[9],     pw0[2] = PKW(P0, 4), pw0[3] = PKW(P0, 6), pw0); \
    VRD(1); SBAR(); GAPA(C0 = __builtin_amdgcn_mfma_f32_32x32x16_bf16(kf[2], qr[1], C0, 0, 0, 0),   P0[10], P0[11], P0[12], P0[13], pw1[0] = PKW(P0, 8), pw1[1] = PKW(P0, 10), pw1); \
    VRD(5); SBAR(); GAPA(C1 = __builtin_amdgcn_mfma_f32_32x32x16_bf16(kf[3], qr[1], C1, 0, 0, 0),   P0[14], P0[15], P1[0], P1[1],   pw1[2] = PKW(P0, 12), pw1[3] = PKW(P0, 14), pw1); \
    VRD(2); SBAR(); GAPA(C0 = __builtin_amdgcn_mfma_f32_32x32x16_bf16(kf[4], qr[2], C0, 0, 0, 0),   P1[2], P1[3], P1[4], P1[5],     pw2[0] = PKW(P1, 0), pw2[1] = PKW(P1, 2), pw2); \
    VRD(6); SBAR(); GAPA(C1 = __builtin_amdgcn_mfma_f32_32x32x16_bf16(kf[5], qr[2], C1, 0, 0, 0),   P1[6], P1[7], P1[8], P1[9],     pw2[2] = PKW(P1, 4), pw2[3] = PKW(P1, 6), pw2); \
    VRD(3); SBAR(); GAPA(C0 = __builtin_amdgcn_mfma_f32_32x32x16_bf16(kf[6], qr[3], C0, 0, 0, 0),   P1[10], P1[11], P1[12], P1[13], pw3[0] = PKW(P1, 8), pw3[1] = PKW(P1, 10), pw3); \
    VRD(7); SBAR(); GAPA(C1 = __builtin_amdgcn_mfma_f32_32x32x16_bf16(kf[7], qr[3], C1, 0, 0, 0),   P1[14], P1[15], 0.f, 0.f,       pw3[2] = PKW(P1, 12), pw3[3] = PKW(P1, 14), pw3); \
    l_reg += sacc; \
    _Pragma("unroll") for (int r = 0; r < 16; ++r) { C0[r] -= mhat; C1[r] -= mhat; } \
    if (GK) { DMA_K((t) + 3, sl_cur); } if (GV) { DMA_V((t) + 1, sl_next); } \
    CMASK(C0, C1, t); \
    { float a = MX3(C0[0], C0[1], C1[0]), b = MX3(C0[2], C0[3], C1[1]); a = MX3(a, C1[2], C1[3]); \
      _Pragma("unroll") for (int r = 4; r < 16; r += 4) { a = MX3(a, C0[r], C0[r + 1]); b = MX3(b, C0[r + 2], C0[r + 3]); a = MX3(a, C1[r], C1[r + 1]); b = MX3(b, C1[r + 2], C1[r + 3]); } \
      float rm = __builtin_fmaxf(a, b); { auto rr = __builtin_amdgcn_permlane32_swap(__float_as_uint(rm), __float_as_uint(rm), false, false); rm = __builtin_fmaxf(__uint_as_float(rr[0]), __uint_as_float(rr[1])); } \
      resc = false; \
      if (__builtin_expect(__any(rm > (float)THRL), 0)) { const float dl = __builtin_fmaxf(rm, 0.f); mhat += dl; \
        _Pragma("unroll") for (int r = 0; r < 16; ++r) { C0[r] -= dl; C1[r] -= dl; } \
        const float f = __builtin_amdgcn_exp2f(-dl); l_reg *= f; if (hi == 0) wsf[r32] = f; resc = true; } } \
    SBAR(); \
    GAPB(o[0] = __builtin_amdgcn_mfma_f32_32x32x16_bf16(PAF(0), VFR(0), o[0], 0, 0, 0), C0, 0); VRD2(0); \
    GAPB(o[1] = __builtin_amdgcn_mfma_f32_32x32x16_bf16(PAF(0), VFR(4), o[1], 0, 0, 0), C0, 2); VRD2(4); \
    KRD(GL, 0); GAPB(o[0] = __builtin_amdgcn_mfma_f32_32x32x16_bf16(PAF(1), VFR(1), o[0], 0, 0, 0), C0, 4); VRD2(1); \
    KRD(GL, 1); GAPB(o[1] = __builtin_amdgcn_mfma_f32_32x32x16_bf16(PAF(1), VFR(5), o[1], 0, 0, 0), C0, 6); VRD2(5); \
    KRD(GL, 2); GAPB(o[0] = __builtin_amdgcn_mfma_f32_32x32x16_bf16(PAF(2), VFR(2), o[0], 0, 0, 0), C0, 8); VRD2(2); \
    KRD(GL, 3); GAPB(o[1] = __builtin_amdgcn_mfma_f32_32x32x16_bf16(PAF(2), VFR(6), o[1], 0, 0, 0), C0, 10); VRD2(6); \
    GAPB(o[0] = __builtin_amdgcn_mfma_f32_32x32x16_bf16(PAF(3), VFR(3), o[0], 0, 0, 0), C0, 12); VRD2(3); \
    GAPB(o[1] = __builtin_amdgcn_mfma_f32_32x32x16_bf16(PAF(3), VFR(7), o[1], 0, 0, 0), C0, 14); VRD2(7); \
    GAPB(o[2] = __builtin_amdgcn_mfma_f32_32x32x16_bf16(PAF(0), VFR(0), o[2], 0, 0, 0), C1, 0); \
    GAPB(o[3] = __builtin_amdgcn_mfma_f32_32x32x16_bf16(PAF(0), VFR(4), o[3], 0, 0, 0), C1, 2); \
    GAPB(o[2] = __builtin_amdgcn_mfma_f32_32x32x16_bf16(PAF(1), VFR(1), o[2], 0, 0, 0), C1, 4); \
    GAPB(o[3] = __builtin_amdgcn_mfma_f32_32x32x16_bf16(PAF(1), VFR(5), o[3], 0, 0, 0), C1, 6); \
    GAPB(o[2] = __builtin_amdgcn_mfma_f32_32x32x16_bf16(PAF(2), VFR(2), o[2], 0, 0, 0), C1, 8); \
    GAPB(o[3] = __builtin_amdgcn_mfma_f32_32x32x16_bf16(PAF(2), VFR(6), o[3], 0, 0, 0), C1, 10); \
    GAPB(o[2] = __builtin_amdgcn_mfma_f32_32x32x16_bf16(PAF(3), VFR(3), o[2], 0, 0, 0), C1, 12); \
    GAPB(o[3] = __builtin_amdgcn_mfma_f32_32x32x16_bf16(PAF(3), VFR(7), o[3], 0, 0, 0), C1, 14); \
    } while (0)
  int t = 1;
  #undef CMASK
  #define CMASK(P0, P1, t) do {} while (0)
  for (; t + 5 < NT; t += 2) {
    STEP(pB0, pB1, pA0, pA1, t, true, true, true);     WAIT_BAR(3); RESC(); ROT();
    STEP(pA0, pA1, pB0, pB1, t + 1, true, true, true); WAIT_BAR(3); RESC(); ROT();
  }
  #undef CMASK
  #define CMASK(P0, P1, t) do { int jb_ = (t) - (NT - 4); if (jb_ >= 0) { const int ln_ = opaque_tid() & 63; cmask(P0, P1, jb_, wid * QBLK + (ln_ & 31), ln_ >> 5); } } while (0)
  #define ENDW(tt) do { if ((tt) + 3 < NT) { WAIT_BAR(3); } else if ((tt) + 2 < NT) { WAIT_BAR(2); } else { WAIT_BAR(0); } } while (0)
  for (; t + 1 < NT; t += 2) {
    STEP(pB0, pB1, pA0, pA1, t, (t + 3 < NT), (t + 1 < NT), (t + 1 < NT));         ENDW(t);     RESC(); ROT();
    STEP(pA0, pA1, pB0, pB1, t + 1, (t + 4 < NT), (t + 2 < NT), (t + 2 < NT));     ENDW(t + 1); RESC(); ROT();
  }
  STEP(pB0, pB1, pA0, pA1, NT - 1, false, false, false); RESC();
  { float sacc = pB0[0] + pB0[1]; _Pragma("unroll") for (int r = 2; r < 16; ++r) sacc += pB0[r]; _Pragma("unroll") for (int r = 0; r < 16; ++r) sacc += pB1[r]; l_reg += sacc;
    pw0 = (u32x4){PKW(pB0, 0), PKW(pB0, 2), PKW(pB0, 4), PKW(pB0, 6)}; pw1 = (u32x4){PKW(pB0, 8), PKW(pB0, 10), PKW(pB0, 12), PKW(pB0, 14)}; pw2 = (u32x4){PKW(pB1, 0), PKW(pB1, 2), PKW(pB1, 4), PKW(pB1, 6)}; pw3 = (u32x4){PKW(pB1, 8), PKW(pB1, 10), PKW(pB1, 12), PKW(pB1, 14)};
    SBAR(); const int ln_ = opaque_tid() & 63; const int vb0 = (int)(lds0 + LDS2_V) + ((ln_ >> 4) & 1) * 32 + (ln_ & 3) * 8 + (4 * (ln_ >> 5) + ((ln_ & 15) >> 2)) * 64;
    pv(o, vb0 + 2 * sl_cur, PAF(0), PAF(1), PAF(2), PAF(3)); pv(o + 2, vb0 + 2 * sl_cur + 8192, PAF(0), PAF(1), PAF(2), PAF(3)); }
  asm volatile("s_waitcnt lgkmcnt(0)\n\ts_barrier" ::: "memory");
  if (Knext) { glds16s(Knext, koff, (unsigned)__builtin_amdgcn_readfirstlane(kdst)); glds16s(Vnext, voff, (unsigned)__builtin_amdgcn_readfirstlane(vdst)); glds16s(Vnext + 64, voff, (unsigned)__builtin_amdgcn_readfirstlane(vdst + 8192));
               glds16s(Knext + (long)KVBLK * DMP, koff, (unsigned)__builtin_amdgcn_readfirstlane(kdst + SLOTB)); }
  #undef PKW
  #undef PAF
  #undef VFR
  #undef PIN
  #undef MX3
  #undef GAPA
  #undef GAPB
  #undef EX
  #undef VRD
  #undef VRD2
  #undef KRD
  #undef STEP
  #undef ENDW
  { auto rr = __builtin_amdgcn_permlane32_swap(__float_as_uint(l_reg), __float_as_uint(l_reg), false, false); l_reg = __uint_as_float(rr[0]) + __uint_as_float(rr[1]); }
  if (hi == 0) wsf[32 + r32] = l_reg; asm volatile("s_waitcnt lgkmcnt(0)" ::: "memory");
  float rli[16];
  #pragma unroll
  for (int r = 0; r < 16; ++r) rli[r] = __builtin_amdgcn_rcpf(wsf[32 + crow(r, hi)]);
  bf16* Ow = O + (rowbase + q0 + wid * QBLK) * DMP + ocol;
  { bf16* stg = (bf16*)(shm + LDS2_OST) + wid * 4096;
    if (MODE == 1) {
      #pragma unroll
      for (int r = 0; r < 16; ++r) { const int orow = crow(r, hi);
        #pragma unroll
        for (int d0 = 0; d0 < 4; ++d0) stg[orow * 128 + d0 * 32 + r32] = __float2bfloat16(o[d0][r] * rli[r]); }
      asm volatile("s_waitcnt lgkmcnt(0)" ::: "memory");
    } else {
      const float* gain = (const float*)(shm + LDS2_GTAB);
      const float lam = gain[128];
      float gn[4];
      #pragma unroll
      for (int d0 = 0; d0 < 4; ++d0) gn[d0] = gain[d0 * 32 + r32];
      #pragma unroll
      for (int r = 0; r < 16; ++r) { const int orow = crow(r, hi); float sq = 0.f;
        #pragma unroll
        for (int d0 = 0; d0 < 4; ++d0) { const float d = __bfloat162float(stg[orow * 128 + d0 * 32 + r32]) - lam * (o[d0][r] * rli[r]); o[d0][r] = d; sq += d * d; }
        sq += __shfl_xor(sq, 1); sq += __shfl_xor(sq, 2); sq += __shfl_xor(sq, 4); sq += __shfl_xor(sq, 8); sq += __shfl_xor(sq, 16);
        const float rs = rsqrtf(sq * (1.0f / 128.0f) + 1e-5f);
        #pragma unroll
        for (int d0 = 0; d0 < 4; ++d0) stg[orow * 128 + d0 * 32 + r32] = __float2bfloat16(o[d0][r] * rs * gn[d0]); }
      asm volatile("s_waitcnt lgkmcnt(0)" ::: "memory");
      #pragma unroll
      for (int i = 0; i < 8; ++i) { const int row = i * 4 + (lane >> 4), ch = lane & 15; const u32x4 v = *(const u32x4*)(stg + row * 128 + ch * 8); *(u32x4*)(Ow + (long)row * DMP + ch * 8) = v; } } }
  asm volatile("s_waitcnt lgkmcnt(0)" ::: "memory");
  #undef DMA_K
  #undef DMA_V
  #undef CMASK
  #undef START
  #undef RESC
  #undef ROT
}
#undef SBAR
#undef WAIT_BAR
}

#define XB_TMO      128
#define XB_XCNT(j)  (256  + 64 * (j))
#define XB_XSUB(j)  (1280 + 64 * (j))
#define XB_XGEN(j)  (2304 + 64 * (j))
#define XB_TOP      3328
#define XB_TOPGEN   3392
#define XCD_BAR_WORDS 3456
#define XB_SPIN_CAP (1u << 18)
__device__ __forceinline__ unsigned xb_ld(unsigned* p)              { return __hip_atomic_load(p, __ATOMIC_RELAXED, __HIP_MEMORY_SCOPE_AGENT); }
__device__ __forceinline__ unsigned xb_add(unsigned* p, unsigned v) { return __hip_atomic_fetch_add(p, v, __ATOMIC_RELAXED, __HIP_MEMORY_SCOPE_AGENT); }
__device__ __forceinline__ unsigned xb_xcc_id() { return (unsigned)__builtin_amdgcn_s_getreg((3 << 11) | 20) & 0xFu; }
#define XB_SPIN(cond, bar) do { unsigned _sp = 0; while (cond) { __builtin_amdgcn_s_sleep(1); \
    if ((++_sp & 255u) == 0u) { if (xb_ld(&(bar)[XB_TMO])) break; if (_sp > XB_SPIN_CAP) { atomicAdd(&(bar)[XB_TMO], 1u); break; } } } } while (0)
struct XcdBarrier { unsigned* bar; unsigned x; volatile LAS unsigned* st; };
__device__ __forceinline__ XcdBarrier xcd_barrier_post(unsigned* bar, volatile LAS unsigned* st) {
    XcdBarrier b; b.bar = bar; b.x = xb_xcc_id(); b.st = st;
    if (threadIdx.x == 0) (void)xb_add(&bar[XB_XCNT(b.x)], 1u);
    return b;
}
__device__ __forceinline__ void xcd_barrier_complete(unsigned* bar, unsigned x, unsigned& nloc, unsigned& nx) {
    const unsigned G = gridDim.x * gridDim.y * gridDim.z;
    unsigned sum, cnt, mine, sp = 0u;
    for (;;) {
        sum = 0u; cnt = 0u; mine = 0u;
#pragma unroll
        for (unsigned j = 0; j < 16; ++j) { const unsigned c = xb_ld(&bar[XB_XCNT(j)]); sum += c; cnt += (c > 0u) ? 1u : 0u; mine = (j == x) ? c : mine; }
        if (sum == G) break;
        __builtin_amdgcn_s_sleep(1);
        if ((++sp & 255u) == 0u) { if (xb_ld(&bar[XB_TMO])) break; if (sp > XB_SPIN_CAP) { atomicAdd(&bar[XB_TMO], 1u); break; } }
    }
    nloc = mine > 0u ? mine : 1u; nx = cnt > 0u ? cnt : 1u;
}
__device__ __forceinline__ void xcd_barrier(const XcdBarrier& b) {
    asm volatile("s_waitcnt vmcnt(0)" ::: "memory");
    __syncthreads();
    if (threadIdx.x == 0) {
        unsigned* bar = b.bar;
        __builtin_amdgcn_s_waitcnt(0);
        unsigned nloc = b.st[0], nx = b.st[1];
        if (nloc == 0u) { xcd_barrier_complete(bar, b.x, nloc, nx); b.st[0] = nloc; b.st[1] = nx; }
        const unsigned old = xb_add(&bar[XB_XSUB(b.x)], 1u);
        const unsigned gen = old / nloc;
        if (old + 1u == (gen + 1u) * nloc) {
            __builtin_amdgcn_fence(__ATOMIC_RELEASE, "agent");
            asm volatile("s_waitcnt vmcnt(0)" ::: "memory");
            const unsigned og = xb_add(&bar[XB_TOP], 1u);
            const unsigned tg = og / nx;
            if (og + 1u == (tg + 1u) * nx) xb_add(&bar[XB_TOPGEN], 1u);
            else XB_SPIN(xb_ld(&bar[XB_TOPGEN]) == tg, bar);
            __builtin_amdgcn_fence(__ATOMIC_ACQUIRE, "agent");
            xb_add(&bar[XB_XGEN(b.x)], 1u);
            asm volatile("s_waitcnt vmcnt(0)" ::: "memory");
        } else {
            XB_SPIN(xb_ld(&bar[XB_XGEN(b.x)]) == gen, bar);
            __builtin_amdgcn_fence(__ATOMIC_ACQUIRE, "agent");
            asm volatile("s_waitcnt vmcnt(0)" ::: "memory");
        }
    }
    __syncthreads();
}

__device__ __forceinline__ int map_row(int n, int mode, int arg) {
    if (mode == 1) return (n >> 7) * 256 + arg * 128 + (n & 127);
    if (mode == 2) { const int d = n & 63; if (d < 16) { const int dp = d < 8 ? 2 * d : 2 * (d - 8) + 1; return n - d + dp; } return n; }
    return n;
}
__device__ __forceinline__ void cvt_item(const float* W, int ldw, int K, int ncols, bf16_t* WT, const float* g, float scale, int mode, int arg, LAS float* scr, int item, int lane, int f16 = 0) {
    const int nblk = ncols / 64, kb = item / nblk, nb = item % nblk, k0 = 64 * kb, n0 = 64 * nb;
#pragma unroll
    for (int i = 0; i < 16; ++i) { const int kk = 4 * i + (lane >> 4); const float gs = g ? g[k0 + kk] * scale : scale;
        const f32x4 v = *(const f32x4*)(W + (size_t)(k0 + kk) * ldw + n0 + (lane & 15) * 4) * gs;
        LAS float* d = scr + kk * 65 + (lane & 15) * 4; d[0] = v[0]; d[1] = v[1]; d[2] = v[2]; d[3] = v[3]; }
    asm volatile("s_waitcnt lgkmcnt(0)" ::: "memory");
    const int c = lane & 7;
#pragma unroll
    for (int j = 0; j < 8; ++j) { const int n = (lane >> 3) + 8 * j; const LAS float* s = scr + (8 * c) * 65 + n;
        u32x4 o;
        if (f16) { o.x = cvt_pk_f16(s[0 * 65], s[1 * 65]); o.y = cvt_pk_f16(s[2 * 65], s[3 * 65]); o.z = cvt_pk_f16(s[4 * 65], s[5 * 65]); o.w = cvt_pk_f16(s[6 * 65], s[7 * 65]); }
        else { o.x = cvt_pk_bf16(s[0 * 65], s[1 * 65]); o.y = cvt_pk_bf16(s[2 * 65], s[3 * 65]); o.z = cvt_pk_bf16(s[4 * 65], s[5 * 65]); o.w = cvt_pk_bf16(s[6 * 65], s[7 * 65]); }
        *(u32x4*)(WT + (size_t)map_row(n0 + n, mode, arg) * K + k0 + 8 * c) = o; }
    asm volatile("s_waitcnt lgkmcnt(0)" ::: "memory");
}

struct Args { const void* in[34]; int ph_lo, ph_hi; };
__device__ __forceinline__ const void* ldarg(const Args& a, int k) { asm volatile("" : "+s"(k)); return a.in[k]; }
#define FARG(k) ((const float*)ldarg(args, k))
#define WSP(off) ((bf16_t*)((unsigned char*)ldarg(args, 33) + (off)))

__device__ __forceinline__ void convert_layer(const Args& args, int l, int parts, LAS float* scr, int gw, int NGW, int lane, int gtid, int NGT) {
    const int I1K = 16 * 16;
    const int IGU = 16 * (FF / 64), IDN = (FF / 64) * 16;
    const int n0 = 4 * I1K + I1K, n1 = n0 + 2 * IGU, total = n1 + IDN;
    for (int seg = 0; seg < 3; ++seg) {
        const int bit = seg == 0 ? 1 : (seg == 1 ? 4 : 2); if (!(parts & bit)) continue;
        const int it_lo = seg == 0 ? 0 : (seg == 1 ? n0 : n1), it_hi = seg == 0 ? n0 : (seg == 1 ? n1 : total);
    for (int it = it_lo + gw; it < it_hi; it += NGW) {
        int r = it;
#define CVT(Wp, ldw, K, ncols, WTp, gp, sc, mode, arg, F16_) { const int ni = ((K) / 64) * ((ncols) / 64); if (r >= 0 && r < ni) cvt_item(Wp, ldw, K, ncols, WTp, gp, sc, mode, arg, scr, r, lane, F16_); r -= ni; }
        if (l < 2) {
            CVT(FARG(7) + (size_t)l * DM * 2 * DM, 2 * DM, DM, DM, WSP(WS_WMIX), FARG(3) + l * DM, 1.f, 1, 0, 1);
            CVT(FARG(7) + (size_t)l * DM * 2 * DM + DM, 2 * DM, DM, DM, WSP(WS_WMIX), FARG(3) + l * DM, 1.f, 1, 1, 1);
            CVT(FARG(13) + (size_t)l * DM * DM, DM, DM, DM, WSP(WS_WMIX) + (size_t)2 * DM * DM, nullptr, 1.f, 0, 0, 0);
            r -= I1K;
        } else {
            const int b = l - 2;
            CVT(FARG(18) + (size_t)b * DM * DM, DM, DM, DM, WSP(WS_WMIX), FARG(3) + l * DM, 1.f, 2, 0, 1);
            CVT(FARG(24) + (size_t)b * DM * DM, DM, DM, DM, WSP(WS_WMIX) + (size_t)3 * DM * DM, nullptr, 1.f, 0, 0, 0);
            if (l == 2) {
                CVT(FARG(16), DM, DM, DM, WSP(WS_WMIX) + (size_t)DM * DM, FARG(15), 1.f, 2, 0, 1);
                CVT(FARG(17), DM, DM, DM, WSP(WS_WMIX) + (size_t)2 * DM * DM, FARG(15), 1.f, 0, 0, 1);
            } else r -= 2 * I1K;
        }
        CVT(FARG(28) + (size_t)l * DM * DM, DM, DM, DM, WSP(WS_WOT), nullptr, 1.f, 0, 0, 0);
        CVT(FARG(29) + (size_t)l * DM * FF, FF, DM, FF, WSP(WS_WGU), FARG(5) + l * DM, 1.f, 1, 0, 1);
        CVT(FARG(30) + (size_t)l * DM * FF, FF, DM, FF, WSP(WS_WGU), FARG(5) + l * DM, 1.f, 1, 1, 1);
        CVT(FARG(31) + (size_t)l * FF * DM, DM, FF, DM, WSP(WS_WD), nullptr, 1.f, 0, 0, 0);
#undef CVT
    } }
    if (parts & 1) { const float* wq = FARG(25) + (size_t)l * DM * DM; bf16_t* o = WSP(WS_WQS); const float* norm_mem = FARG(4) + l * DM;
      for (int i = gtid; i < DM * DM / 8; i += NGT) { const int k = i >> 7; const float gs = norm_mem[k] * (0.0625f * LOG2E);
          const f32x4 v0 = *(const f32x4*)(wq + (size_t)i * 8) * gs, v1 = *(const f32x4*)(wq + (size_t)i * 8 + 4) * gs;
          u32x4 w; w.x = cvt_pk_bf16(v0[0], v0[1]); w.y = cvt_pk_bf16(v0[2], v0[3]); w.z = cvt_pk_bf16(v1[0], v1[1]); w.w = cvt_pk_bf16(v1[2], v1[3]);
          *(u32x4*)(o + (size_t)i * 8) = w; } }
}

__device__ __forceinline__ void conv_phase(const bf16_t* Gin, bf16_t* CV, const float* wdw, const float* bdw, const float* lng, const float* lnb, LAS unsigned char* lds, int G, int c) {
    constexpr int CT = 16;
    const int tid = opaque_tid(), lane = tid & 63, wid = tid >> 6, ch = 2 * tid;
    LAS float* red = (LAS float*)lds;
    LAS float* st = (LAS float*)(lds + 4096);
    f32x2 w2[31];
#pragma unroll
    for (int j = 0; j < 31; ++j) w2[j] = *(const f32x2*)(wdw + j * DM + ch);
    const f32x2 bd = *(const f32x2*)(bdw + ch), gg = *(const f32x2*)(lng + ch), bb = *(const f32x2*)(lnb + ch);
    for (int unit = c; unit < TR / CT; unit += G) {
        const int row0 = unit * CT, t0 = row0 & (SEQ - 1);
        f32x2 x2[CT + 30];
#pragma unroll
        for (int j = 0; j < CT + 30; ++j) { const bool ok = (t0 - 30 + j) >= 0; const unsigned v = ok ? *(const unsigned*)(Gin + (size_t)(row0 - 30 + j) * DM + ch) : 0u; x2[j] = (f32x2){bf_lo(v), bf_hi(v)}; }
        float u0[CT], u1[CT];
#pragma unroll
        for (int t = 0; t < CT; ++t) { f32x2 a = bd;
#pragma unroll
            for (int j = 0; j < 31; ++j) a = __builtin_elementwise_fma(w2[j], x2[t + j], a);
            u0[t] = a[0]; u1[t] = a[1]; }
#pragma unroll
        for (int t = 0; t < CT; ++t) { float s = u0[t] + u1[t], q = u0[t] * u0[t] + u1[t] * u1[t]; s = wave_sum(s); q = wave_sum(q);
            if (lane == 0) { red[(wid * CT + t) * 2] = s; red[(wid * CT + t) * 2 + 1] = q; } }
        __syncthreads();
        if (tid < CT) { float s = 0.f, q = 0.f;
#pragma unroll
            for (int w = 0; w < 8; ++w) { s += red[(w * CT + tid) * 2]; q += red[(w * CT + tid) * 2 + 1]; }
            const float mean = s * (1.0f / DM), var = q * (1.0f / DM) - mean * mean;
            st[tid * 2] = mean; st[tid * 2 + 1] = rsqrtf(fmaxf(var, 0.f) + LN_EPS); }
        __syncthreads();
#pragma unroll
        for (int t = 0; t < CT; ++t) { const float mean = st[t * 2], rstd = st[t * 2 + 1];
            float y0 = (u0[t] - mean) * rstd * gg[0] + bb[0], y1 = (u1[t] - mean) * rstd * gg[1] + bb[1];
            y0 *= fast_sigmoid(y0); y1 *= fast_sigmoid(y1);
            *(unsigned*)(CV + (size_t)(row0 + t) * DM + ch) = cvt_pk_bf16(y0, y1); }
        __syncthreads();
    }
}

__global__ void __launch_bounds__(512, 2) yoco_fwd(Args args) {
    extern __shared__ __attribute__((aligned(16))) unsigned char lds_raw[];
    LAS unsigned char* lds = (LAS unsigned char*)lds_raw;
    cg::grid_group grid = cg::this_grid();
    const int G = gridDim.x, bx = blockIdx.x;
#define THIN_IDS const int tid = opaque_tid(), lane = tid & 63, wave = __builtin_amdgcn_readfirstlane(tid >> 6); const int gw = bx * 8 + wave, NGW = G * 8, gtid = bx * 512 + tid, NGT = G * 512; LAS float* scr = (LAS float*)(lds + wave * 16640); (void)lane; (void)gw; (void)NGW; (void)gtid; (void)NGT; (void)scr;
#define XRES ((float*)ldarg(args, 32))
#define SSP  ((float*)WSP(WS_SS))
#define HB   WSP(WS_HB)

    { const int t0 = opaque_tid(); if (t0 < 4) ((LAS unsigned*)(lds + LDS_BARST))[t0] = 0u; }
    __syncthreads();
    (void)xcd_barrier_post((unsigned*)WSP(WS_BAR), (volatile LAS unsigned*)(lds + LDS_BARST));
#define SEAM() do { if (args.ph_hi < 0) grid.sync();     \
        XcdBarrier xb_; xb_.bar = (unsigned*)WSP(WS_BAR); xb_.x = xb_xcc_id(); xb_.st = (volatile LAS unsigned*)(lds + LDS_BARST); xcd_barrier(xb_); } while (0)
#ifndef PROBE_MASK
#define PROBE_MASK 0u
#endif
    bool last_phase_ = false;
#define PH_BEGIN(kind) { const bool probe_ = (PROBE_MASK >> (kind)) & 1u; const unsigned long long pt0_ = probe_ ? __builtin_amdgcn_s_memrealtime() : 0ull;
#define PH_END   if (probe_) { __syncthreads(); const unsigned long long pt1_ = __builtin_amdgcn_s_memrealtime(); while (__builtin_amdgcn_s_memrealtime() - pt1_ < 3ull * (pt1_ - pt0_)) __builtin_amdgcn_s_sleep(8); } \
                 if (!last_phase_) SEAM(); }

    PH_BEGIN(0)
    {   THIN_IDS
        const float* x = FARG(0); const float* mem = FARG(1); const int* pos = (const int*)ldarg(args, 2);
        float* ss = SSP; bf16_t* xb = WSP(WS_XB); bf16_t* memb = WSP(WS_MEMB);
        for (int m0 = gw; m0 < TR + NBATCH * NMEM; m0 += 2 * NGW) {
            f32x4 v[2][4]; bool ok[2];
#pragma unroll
            for (int q = 0; q < 2; ++q) { const int m = m0 + q * NGW; ok[q] = m < TR + NBATCH * NMEM; const bool isx = m < TR;
                const float* src = isx ? x + (size_t)m * DM : mem + (size_t)(m - TR) * DM;
#pragma unroll
                for (int j = 0; j < 4; ++j) v[q][j] = ok[q] ? *((const f32x4*)src + lane + 64 * j) : (f32x4){0.f, 0.f, 0.f, 0.f}; }
#pragma unroll
            for (int q = 0; q < 2; ++q) { const int m = m0 + q * NGW; if (!ok[q]) continue; const bool isx = m < TR;
                bf16_t* dst = isx ? xb + (size_t)m * DM : memb + (size_t)(m - TR) * DM; float sq = 0.f;
#pragma unroll
                for (int j = 0; j < 4; ++j) { const f32x4 w4 = v[q][j]; sq += (w4[0] * w4[0] + w4[1] * w4[1]) + (w4[2] * w4[2] + w4[3] * w4[3]);
                    u32x2 w; if (isx) { w.x = cvt_pk_f16(w4[0], w4[1]); w.y = cvt_pk_f16(w4[2], w4[3]); } else { w.x = cvt_pk_bf16(w4[0], w4[1]); w.y = cvt_pk_bf16(w4[2], w4[3]); } *((u32x2*)dst + lane + 64 * j) = w; }
                sq = wave_sum(sq);
                if (isx && lane < 4) ss[(size_t)m * 4 + lane] = lane == 0 ? sq : 0.f; }
        }
        float* cosT = (float*)WSP(WS_COS); float* sinT = (float*)WSP(WS_SIN);
        for (int i = gtid; i < TR * 8; i += NGT) { const int row = i >> 3, k = i & 7; const float inv = powf(500000.0f, -(float)(2 * k) / 16.0f); const float ang = (float)pos[row] * inv;
            cosT[i] = cosf(ang); sinT[i] = sinf(ang); }
        for (int it = gw; it < 8 * 256; it += NGW) { const int j = it >> 8, l = j >> 1, kv = j & 1;
            cvt_item(FARG(kv ? 27 : 26) + (size_t)l * DM * DM, DM, DM, DM, HB + (size_t)j * DM * DM, nullptr, 1.f, 0, 0, scr, it & 255, lane); }
        convert_layer(args, 0, 7, scr, gw, NGW, lane, gtid, NGT);
    }
    PH_END

    PH_BEGIN(1)
    {   pg8::Gemm g{WSP(WS_MEMB), HB, DM, DM, DM, 0, (long)NMEM * DM, (long)DM * DM, 0, 0, 4};
        pg8::Order S; S.init(1, 4, 32, G, bx);
        pg8::EpiPlain E{WSP(WS_KV), DM, (long)4 * NMEM * DM, (long)NMEM * DM, 4, 0};
        pg8::gemm_phase(lds, g, S, E);
    }
    PH_END

    for (int l = 0; l < 4; ++l) {
        const bool is_conv = l < 2;

        PH_BEGIN(3)
        if (is_conv) {
            pg8::Gemm g{WSP(WS_XB), WSP(WS_WMIX), DM, DM, DM, 0, 0, 0, 0, 0, 1}; pg8::Order S; S.init(TR / 256, 8, 1, G, bx);
            pg8::EpiGated<0> E{WSP(WS_R1), DM, SSP, FARG(8) + l * 2 * DM, DM};
            pg8::gemm_phase<pg8::EpiGated<0>, true>(lds, g, S, E);
        } else {
            pg8::Gemm g{WSP(WS_XB), WSP(WS_WMIX), DM, DM, DM, 0, 0, 0, 0, 0, 1}; pg8::Order S; S.init(TR / 256, l == 2 ? 12 : 4, 1, G, bx);
            pg8::EpiQKV E{WSP(WS_R1), (size_t)(WS_KSH - WS_R1) / 2, SSP, (const float*)WSP(WS_COS), (const float*)WSP(WS_SIN)};
            pg8::gemm_phase<pg8::EpiQKV, true>(lds, g, S, E);
        }
        {
            pg8::Gemm g1{WSP(WS_KV) + (size_t)(l * 2 + 0) * 4 * NMEM * DM, WSP(WS_WQS), DM, DM, 256, (long)NMEM * DM, 256, 0, 256, 0, 4}; pg8::Order S1; S1.init(1, 4, 16, G, bx);
            pg8::EpiPlain E1{WSP(WS_BTS), DM, (long)DM * DM, (long)256 * DM, 4, 1};
            pg8::gemm_phase(lds, g1, S1, E1);
            pg8::Gemm g2{WSP(WS_WOT), WSP(WS_KV) + (size_t)(l * 2 + 1) * 4 * NMEM * DM, DM, DM, 256, 0, 256, (long)NMEM * DM, 256, 0, 4}; pg8::Order S2; S2.init(4, 1, 16, G, G - 1 - bx);
            pg8::EpiPlain E2{WSP(WS_BTO), DM, (long)DM * DM, 256, 4, 0};
            pg8::gemm_phase(lds, g2, S2, E2);
        }
        PH_END

        PH_BEGIN((is_conv ? 4 : 5))
        if (is_conv) {
#ifndef NO_CONV
            conv_phase(WSP(WS_R1), HB, FARG(9) + l * 31 * DM, FARG(10) + l * DM, FARG(11) + l * DM, FARG(12) + l * DM, lds, G, bx);
#endif
        } else {
#ifndef NO_ATTN
            const attn_body::bf16* qd = (const attn_body::bf16*)WSP(WS_R1); const attn_body::bf16* kd = (const attn_body::bf16*)WSP(WS_KSH); const attn_body::bf16* vd = (const attn_body::bf16*)WSP(WS_VSH);
            attn_body::bf16* od = (attn_body::bf16*)WSP(WS_R1);
            float lam, li1;
            {   const int ln = opaque_tid() & 63; const int bb = l - 2; const float lambda_init = 0.8f - 0.6f * expf(-0.3f * (float)l);
                const float d1 = wave_sum(FARG(19)[bb * 64 + ln] * FARG(20)[bb * 64 + ln]), d2 = wave_sum(FARG(21)[bb * 64 + ln] * FARG(22)[bb * 64 + ln]);
                lam = expf(d1) - expf(d2) + lambda_init; li1 = 1.0f - lambda_init; }
            float* gtab = (float*)((char*)lds_raw + LDS_GTAB);
            { const int t = opaque_tid(); if (t < 128) gtab[t] = FARG(23)[(l - 2) * 128 + t] * li1; if (t == 128) gtab[128] = lam; }
            __syncthreads();
#define ATT_PAIR(B_, H_, QB_, PRE_, KN_, VN_) do { const attn_body::bf16* kb_ = kd + (size_t)(B_) * SEQ * DM + (H_) * 128; const attn_body::bf16* vb_ = vd + (size_t)(B_) * SEQ * DM + (H_) * 128; \
                attn_body::attn_unit2<8, 1>(B_, (H_) * 128, (H_) * 128, (H_) * 128, (H_) * 128, QB_, qd, kd, vd, od, (char*)lds_raw, PRE_, kb_ + 64, vb_); \
                attn_body::attn_unit2<8, 2>(B_, (H_) * 128 + 64, (H_) * 128 + 64, (H_) * 128, (H_) * 128, QB_, qd, kd, vd, od, (char*)lds_raw, true, KN_, VN_); } while (0)
            bool pre = false;
            for (int i = 0;; ++i) { int b, h, qb; const attn_body::bf16* kn = nullptr; const attn_body::bf16* vn = nullptr;
                if (G == 256) {
                    if (i >= 2) break; const int xk = bx >> 3, bh = (bx & 7) * 4 + (xk >> 3), p = xk & 7; b = bh >> 3; h = bh & 7; qb = i == 0 ? 15 - p : p;
                    if (i == 0) { kn = kd + (size_t)b * SEQ * DM + h * 128; vn = vd + (size_t)b * SEQ * DM + h * 128; }
                } else {
                    const int pp = (i & 1) ? (G - 1 - bx) : bx; const int idx = i * G + pp; if (idx >= 512) break; qb = 15 - (idx >> 5); const int j = idx & 31; b = j >> 3; h = j & 7; }
                ATT_PAIR(b, h, qb, pre, kn, vn); pre = kn != nullptr; }
#undef ATT_PAIR
            __syncthreads();
#endif
        }
        if (l > 0) { THIN_IDS convert_layer(args, l, 2, scr, gw, NGW, lane, gtid, NGT); }
        PH_END

        PH_BEGIN(7)
        {   pg8::Gemm g{is_conv ? HB : WSP(WS_R1), WSP(WS_WMIX) + (size_t)(is_conv ? 2 : 3) * DM * DM, DM, DM, DM, 0, 0, 0, 0, 0, 1}; pg8::Order S; S.init(TR / 256, 4, 1, G, bx);
            pg8::EpiResid E{WSP(WS_XB), SSP, is_conv ? FARG(14) + l * DM : nullptr};
            pg8::gemm_phase(lds, g, S, E);
        }
        PH_END

        PH_BEGIN(8)
        {   pg8::Gemm g{WSP(WS_XB), WSP(WS_BTS), DM, DM, DM, 0, 0, 0, 0, (long)DM * DM, 1}; pg8::Order S; S.init(TR / 256, 4, 1, G, bx);
            pg8::EpiSoftmax E{WSP(WS_R1), SSP};
            pg8::gemm_phase<pg8::EpiSoftmax, true>(lds, g, S, E);
        }
        PH_END

        PH_BEGIN(9)
        {   pg8::Gemm g{WSP(WS_R1), WSP(WS_BTO), DM, DM, DM, 0, 0, 0, 0, (long)DM * DM, 1}; pg8::Order S; S.init(TR / 256, 4, 1, G, bx);
            pg8::EpiResid E{WSP(WS_XB), SSP, nullptr};
            pg8::gemm_phase(lds, g, S, E);
        }
        PH_END

        PH_BEGIN(10)
        {   pg8::Gemm g{WSP(WS_XB), WSP(WS_WGU), DM, DM, DM, 0, 0, 0, 0, 0, 1}; pg8::Order S; S.init(TR / 256, 2 * FF / 256, 1, G, bx);
            pg8::EpiGated<1> E{HB, FF, SSP, nullptr, 0};
            pg8::gemm_phase<pg8::EpiGated<1>, true>(lds, g, S, E);
            {   const int nun = (TR / 256) * (2 * FF / 256), tail = nun % G;
                if (l < 3) { if (tail > 0 && bx >= tail) { const int tid = opaque_tid(), lane = tid & 63, wave = __builtin_amdgcn_readfirstlane(tid >> 6); LAS float* scr = (LAS float*)(lds + wave * 16640);
                        convert_layer(args, l + 1, 1, scr, (bx - tail) * 8 + wave, (G - tail) * 8, lane, (bx - tail) * 512 + tid, (G - tail) * 512); }
                    else if (tail == 0) { THIN_IDS convert_layer(args, l + 1, 1, scr, gw, NGW, lane, gtid, NGT); } } }
        }
        PH_END

        PH_BEGIN(11)
        {   pg8::Gemm g{HB, WSP(WS_WD), FF, FF, FF, 0, 0, 0, 0, 0, 1}; pg8::Order S; S.init(TR / 256, 4, 1, G, bx);
            pg8::EpiResid E{WSP(WS_XB), SSP, nullptr};
            pg8::gemm_phase(lds, g, S, E);
            if (l < 3) { THIN_IDS convert_layer(args, l + 1, 4, scr, gw, NGW, lane, gtid, NGT); }
        }
        PH_END
    }

    last_phase_ = true;
    PH_BEGIN(12)
    {   THIN_IDS
        const float* gfin = FARG(6); float* outp = XRES; const bf16_t* xb = WSP(WS_XB);
        for (int m0 = gw; m0 < TR; m0 += 2 * NGW) {
            u32x4 ra[2][2]; bool ok[2];
#pragma unroll
            for (int q = 0; q < 2; ++q) { const int m = m0 + q * NGW; ok[q] = m < TR; const u32x4* p = (const u32x4*)(xb + (size_t)(ok[q] ? m : m0) * DM); ra[q][0] = p[lane]; ra[q][1] = p[64 + lane]; }
#pragma unroll
            for (int q = 0; q < 2; ++q) { const int m = m0 + q * NGW; if (!ok[q]) continue; const u32x4 a = ra[q][0], b = ra[q][1];
            float v[16];
#pragma unroll
            for (int j = 0; j < 4; ++j) { v[2 * j] = h_lo(a[j]); v[2 * j + 1] = h_hi(a[j]); v[8 + 2 * j] = h_lo(b[j]); v[8 + 2 * j + 1] = h_hi(b[j]); }
            float sq = 0.f;
#pragma unroll
            for (int j = 0; j < 16; ++j) sq += v[j] * v[j];
            const float rs = rsqrtf(wave_sum(sq) * (1.0f / DM) + RMS_EPS);
            float* orow = outp + (size_t)m * DM;
#pragma unroll
            for (int h = 0; h < 2; ++h) { const int c0 = h * 512 + lane * 8; const f32x4 g0 = *(const f32x4*)(gfin + c0), g1 = *(const f32x4*)(gfin + c0 + 4);
                *(f32x4*)(orow + c0) = (f32x4){v[8 * h + 0] * rs * g0[0], v[8 * h + 1] * rs * g0[1], v[8 * h + 2] * rs * g0[2], v[8 * h + 3] * rs * g0[3]};
                *(f32x4*)(orow + c0 + 4) = (f32x4){v[8 * h + 4] * rs * g1[0], v[8 * h + 5] * rs * g1[1], v[8 * h + 6] * rs * g1[2], v[8 * h + 7] * rs * g1[3]}; } } }
    }
    PH_END
#undef PH_BEGIN
#undef PH_END
}

extern "C" void kernel_launch(void* const* d_in, const int* in_sizes, int n_in, void* d_out, int out_size, void* d_ws, size_t ws_size, hipStream_t stream) {
    static int grid = 0;
    if (grid == 0) {
        if (n_in != 32 || out_size != TR * DM || ws_size < WS_END) { fprintf(stderr, "kernel_launch: unexpected shapes (n_in %d out %d ws %zu)\n", n_in, out_size, ws_size); grid = -1; return; }
        int dev = 0, cus = 0, per_cu = 0;
        hipGetDevice(&dev); hipDeviceGetAttribute(&cus, hipDeviceAttributeMultiprocessorCount, dev);
        if (hipFuncSetAttribute((const void*)yoco_fwd, hipFuncAttributeMaxDynamicSharedMemorySize, LDS_BYTES) != hipSuccess) { fprintf(stderr, "kernel_launch: hipFuncSetAttribute failed\n"); grid = -1; return; }
        if (hipOccupancyMaxActiveBlocksPerMultiprocessor(&per_cu, (const void*)yoco_fwd, 512, LDS_BYTES) != hipSuccess || per_cu < 1) { fprintf(stderr, "kernel_launch: occupancy query gave %d\n", per_cu); per_cu = 1; (void)hipGetLastError(); }
        grid = cus * per_cu;
    }
    if (grid < 0) return;
    if (hipMemsetAsync((char*)d_ws + WS_BAR, 0, XCD_BAR_WORDS * 4, stream) != hipSuccess) { fprintf(stderr, "kernel_launch: memset failed\n"); return; }
    Args a{};
    for (int i = 0; i < 32; ++i) a.in[i] = d_in[i];
    a.in[32] = d_out; a.in[33] = d_ws;
    a.ph_lo = 0; a.ph_hi = 1;
    void* kargs[] = {&a};
    hipError_t e = hipLaunchCooperativeKernel((const void*)yoco_fwd, dim3(grid), dim3(512), kargs, LDS_BYTES, stream);
    if (e != hipSuccess) fprintf(stderr, "kernel_launch: cooperative launch failed: %s (grid %d)\n", hipGetErrorString(e), grid);
}
```
